# Optimizing an MI355X kernel written in HIP

```python
import math
import jax
import jax.numpy as jnp
from jax import lax
import numpy as np

D_MODEL = 1024
BATCH = 2
SEQ = 16384
DEPTH = 2

SSD_HEADS = 16
SSD_HEAD_DIM = 64
SSD_INNER = SSD_HEADS * SSD_HEAD_DIM
SSD_GROUPS = 4
SSD_STATE = 128
SSD_CONV = 4
SSD_CHUNK = 128
SSD_XBC = SSD_INNER + 2 * SSD_GROUPS * SSD_STATE

MOBA_HEADS = 8
MOBA_HEAD_DIM = 128
MOBA_INNER = MOBA_HEADS * MOBA_HEAD_DIM
MOBA_BLOCK = 256
MOBA_TOPK = 3
MOBA_QCHUNK = 32

REL_BUCKETS = 32
REL_MAX_DIST = 1024

RWKV_HEADS = 16
RWKV_HEAD_DIM = 64
RWKV_INNER = RWKV_HEADS * RWKV_HEAD_DIM
RWKV_DECAY_LORA = 64
RWKV_ICLR_LORA = 64
RWKV_GATE_LORA = 128
RWKV_IN = 3 * RWKV_INNER + RWKV_DECAY_LORA + RWKV_ICLR_LORA + RWKV_GATE_LORA
RWKV_LN_EPS = 64e-5

PEER_HEADS = 8
PEER_KEYS = 128
PEER_EXPERTS = PEER_KEYS * PEER_KEYS
PEER_TOPK = 16
PEER_KEY_DIM = 256
PEER_CHUNK = 128

N_BRANCH = 3
IN_SSD = SSD_INNER + SSD_XBC + SSD_HEADS
IN_MOBA = 3 * MOBA_INNER
IN_TOTAL = IN_SSD + IN_MOBA + RWKV_IN
NORM_EPS = 1e-6
NEG = -1e30

kernel_name = "hybrid_ssd_moba_rwkv7_peer"


def rms_norm(x, g, eps=NORM_EPS):
    xf = x.astype(jnp.float32)
    return xf * lax.rsqrt(jnp.mean(xf * xf, axis=-1, keepdims=True) + eps) * g.astype(jnp.float32)


def t5_bucket(dist):
    max_exact = REL_BUCKETS // 2
    d = jnp.maximum(dist, 0)
    df = jnp.maximum(d, 1).astype(jnp.float32)
    large = max_exact + (jnp.log(df / max_exact) / math.log(REL_MAX_DIST / max_exact)
                         * (REL_BUCKETS - max_exact)).astype(jnp.int32)
    large = jnp.minimum(large, REL_BUCKETS - 1)
    return jnp.where(d < max_exact, d, large)


def ssd_mixer(zxbcdt, conv_w, conv_b, dt_bias, a_log, d_skip, norm_g):
    f32 = jnp.float32
    bsz, slen, _ = zxbcdt.shape
    G, E, P, N, Lc = SSD_GROUPS, SSD_HEADS // SSD_GROUPS, SSD_HEAD_DIM, SSD_STATE, SSD_CHUNK
    nc = slen // Lc
    zxbcdt = zxbcdt.astype(f32)
    z = zxbcdt[..., :SSD_INNER]
    xbc = zxbcdt[..., SSD_INNER:SSD_INNER + SSD_XBC]
    dt = zxbcdt[..., SSD_INNER + SSD_XBC:]
    xbc = lax.conv_general_dilated(xbc, conv_w.astype(f32)[:, None, :], window_strides=(1,),
                                   padding=[(SSD_CONV - 1, 0)], dimension_numbers=("NWC", "WIO", "NWC"),
                                   feature_group_count=SSD_XBC)
    xbc = jax.nn.silu(xbc + conv_b.astype(f32))
    xs = xbc[..., :SSD_INNER]
    b_in = xbc[..., SSD_INNER:SSD_INNER + G * N].reshape(bsz, nc, Lc, G, N)
    c_in = xbc[..., SSD_INNER + G * N:].reshape(bsz, nc, Lc, G, N)
    dt = jax.nn.softplus(dt + dt_bias.astype(f32))
    a = -jnp.exp(a_log.astype(f32))
    xdt = xs.reshape(bsz, nc, Lc, G, E, P) * dt.reshape(bsz, nc, Lc, G, E)[..., None]
    acs = jnp.cumsum((dt * a).reshape(bsz, nc, Lc, G, E).transpose(0, 1, 3, 4, 2), axis=-1)
    causal = jnp.tril(jnp.ones((Lc, Lc), dtype=bool))
    seg = jnp.exp(jnp.where(causal, acs[..., :, None] - acs[..., None, :], -jnp.inf))
    cb = jnp.einsum("bclgn,bcsgn->bcgls", c_in, b_in)
    y_diag = jnp.einsum("bcgels,bcsgep->bclgep", cb[:, :, :, None] * seg, xdt)
    decay_to_end = jnp.exp(acs[..., -1:] - acs)
    chunk_states = jnp.einsum("bclgn,bcgel,bclgep->bcgepn", b_in, decay_to_end, xdt)
    chunk_decay = jnp.exp(acs[..., -1])

    def carry_state(h, inp):
        st, dec = inp
        return h * dec[..., None, None] + st, h

    h0 = jnp.zeros((bsz, G, E, P, N), f32)
    _, h_in = lax.scan(carry_state, h0, (jnp.moveaxis(chunk_states, 1, 0), jnp.moveaxis(chunk_decay, 1, 0)))
    h_in = jnp.moveaxis(h_in, 0, 1)
    y_off = jnp.einsum("bclgn,bcgepn,bcgel->bclgep", c_in, h_in, jnp.exp(acs))
    y = (y_diag + y_off).reshape(bsz, slen, SSD_INNER) + xs * jnp.repeat(d_skip.astype(f32), P)
    y = y * jax.nn.silu(z)
    yg = y.reshape(bsz, slen, G, SSD_INNER // G)
    yg = yg * lax.rsqrt(jnp.mean(yg * yg, axis=-1, keepdims=True) + NORM_EPS)
    return yg.reshape(bsz, slen, SSD_INNER) * norm_g.astype(f32)


def moba_mixer(qkv, q_norm_g, k_norm_g, rel_bias):
    f32 = jnp.float32
    bsz, slen, _ = qkv.shape
    H, Dh, BLK, QC = MOBA_HEADS, MOBA_HEAD_DIM, MOBA_BLOCK, MOBA_QCHUNK
    qkv = qkv.astype(f32)

    def heads(t):
        return t.reshape(bsz, slen, H, Dh).transpose(0, 2, 1, 3)

    q = rms_norm(heads(qkv[..., :MOBA_INNER]), q_norm_g)
    k = rms_norm(heads(qkv[..., MOBA_INNER:2 * MOBA_INNER]), k_norm_g)
    v = heads(qkv[..., 2 * MOBA_INNER:])
    nb = -(-slen // BLK)
    s_pad = nb * BLK
    padw = ((0, 0), (0, 0), (0, s_pad - slen), (0, 0))
    q, k, v = jnp.pad(q, padw), jnp.pad(k, padw), jnp.pad(v, padw)
    kb = k.reshape(bsz, H, nb, BLK, Dh)
    vb = v.reshape(bsz, H, nb, BLK, Dh)
    kmean = jnp.mean(kb, axis=3)
    n_sel = min(MOBA_TOPK, nb)
    nqc = s_pad // QC
    q_chunks = q.reshape(bsz, H, nqc, QC, Dh).transpose(2, 0, 1, 3, 4)
    bias_t = rel_bias.astype(f32).T
    scale = Dh ** -0.5
    b_idx = jnp.arange(bsz)[:, None, None, None]
    h_idx = jnp.arange(H)[None, :, None, None]

    def one_chunk(args):
        qi, c = args
        q_pos = c * QC + jnp.arange(QC, dtype=jnp.int32)
        qblk = (c * QC) // BLK
        gate = jnp.einsum("bhqd,bhnd->bhqn", qi, kmean)
        gate = jnp.where(jnp.arange(nb) < qblk, gate, NEG)
        _, sel = lax.top_k(gate, n_sel)
        sel_valid = jnp.arange(n_sel) < qblk
        k_sel = kb[b_idx, h_idx, sel]
        v_sel = vb[b_idx, h_idx, sel]
        s_past = jnp.einsum("bhqd,bhqjkd->bhqjk", qi, k_sel) * scale
        k_pos_past = sel[..., None] * BLK + jnp.arange(BLK, dtype=jnp.int32)
        bias_past = bias_t[h_idx[..., None], t5_bucket(q_pos[:, None, None] - k_pos_past)]
        s_past = jnp.where(sel_valid[:, None], s_past + bias_past, NEG)
        k_own = lax.dynamic_slice_in_dim(kb, qblk, 1, axis=2)[:, :, 0]
        v_own = lax.dynamic_slice_in_dim(vb, qblk, 1, axis=2)[:, :, 0]
        dist = q_pos[:, None] - (qblk * BLK + jnp.arange(BLK, dtype=jnp.int32))[None, :]
        s_own = jnp.einsum("bhqd,bhkd->bhqk", qi, k_own) * scale + bias_t[:, t5_bucket(dist)]
        s_own = jnp.where(dist >= 0, s_own, NEG)
        logits = jnp.concatenate([s_own, s_past.reshape(bsz, H, QC, n_sel * BLK)], axis=-1)
        p = jax.nn.softmax(logits, axis=-1)
        p_past = p[..., BLK:].reshape(bsz, H, QC, n_sel, BLK)
        return (jnp.einsum("bhqk,bhkd->bhqd", p[..., :BLK], v_own)
                + jnp.einsum("bhqjk,bhqjkd->bhqd", p_past, v_sel))

    out = lax.map(one_chunk, (q_chunks, jnp.arange(nqc, dtype=jnp.int32)))
    out = out.transpose(1, 2, 0, 3, 4).reshape(bsz, H, s_pad, Dh)[:, :, :slen]
    return out.transpose(0, 2, 1, 3).reshape(bsz, slen, MOBA_INNER)


def rwkv7_mixer(proj, mu, w0, w_w2, a0, w_a2, w_g2, k_k, k_a, r_k, lnx_g, lnx_b):
    f32 = jnp.float32
    bsz, slen, _ = proj.shape
    H, N, C = RWKV_HEADS, RWKV_HEAD_DIM, RWKV_INNER
    proj = proj.astype(f32)
    prev = jnp.pad(proj, ((0, 0), (1, 0), (0, 0)))[:, :-1]
    xs = proj + (prev - proj) * mu.astype(f32)
    o1, o2 = 3 * C + RWKV_DECAY_LORA, 3 * C + RWKV_DECAY_LORA + RWKV_ICLR_LORA
    r, k, v = xs[..., :C], xs[..., C:2 * C], xs[..., 2 * C:3 * C]
    wl, al, gl = xs[..., 3 * C:o1], xs[..., o1:o2], xs[..., o2:]
    w = -jax.nn.softplus(-(w0.astype(f32) + jnp.tanh(wl) @ w_w2.astype(f32))) - 0.5
    decay = jnp.exp(-jnp.exp(w))
    a = jax.nn.sigmoid(a0.astype(f32) + al @ w_a2.astype(f32))
    g = jax.nn.sigmoid(gl) @ w_g2.astype(f32)
    kk = (k * k_k.astype(f32)).reshape(bsz, slen, H, N)
    kk = kk * lax.rsqrt(jnp.maximum(jnp.sum(kk * kk, axis=-1, keepdims=True), 1e-12))
    kk = kk.reshape(bsz, slen, C)
    k = k * (1.0 + (a - 1.0) * k_a.astype(f32))

    def tm(t):
        return t.reshape(bsz, slen, H, N).transpose(1, 0, 2, 3)

    def step(state, inp):
        r_t, w_t, k_t, v_t, a_t, b_t = inp
        sa = jnp.einsum("bhvk,bhk->bhv", state, a_t)
        state = state * w_t[:, :, None, :] + sa[..., None] * b_t[:, :, None, :] + v_t[..., None] * k_t[:, :, None, :]
        return state, jnp.einsum("bhvk,bhk->bhv", state, r_t)

    s0 = jnp.zeros((bsz, H, N, N), f32)
    _, y = lax.scan(step, s0, (tm(r), tm(decay), tm(k), tm(v), tm(-kk), tm(kk * a)))
    y = y.transpose(1, 0, 2, 3)
    mean = jnp.mean(y, axis=-1, keepdims=True)
    var = jnp.mean(jnp.square(y - mean), axis=-1, keepdims=True)
    y = ((y - mean) * lax.rsqrt(var + RWKV_LN_EPS)).reshape(bsz, slen, C) * lnx_g.astype(f32) + lnx_b.astype(f32)
    rh, kh, vh = r.reshape(bsz, slen, H, N), k.reshape(bsz, slen, H, N), v.reshape(bsz, slen, H, N)
    bonus = jnp.sum(rh * kh * r_k.astype(f32), axis=-1, keepdims=True) * vh
    return (y + bonus.reshape(bsz, slen, C)) * g


def peer_ffn(h, wq, k1, k2, u, v):
    f32 = jnp.float32
    bsz, slen, dm = h.shape
    T, PH, half = PEER_CHUNK, PEER_HEADS, PEER_KEY_DIM // 2
    nc = slen // T
    h_chunks = h.astype(f32).reshape(bsz, nc, T, dm).transpose(1, 0, 2, 3)
    wq, k1, k2 = wq.astype(f32), k1.astype(f32), k2.astype(f32)

    def one_chunk(hi):
        q = (hi @ wq).reshape(bsz, T, PH, PEER_KEY_DIM)
        s1 = jnp.einsum("bthd,nd->bthn", q[..., :half], k1)
        s2 = jnp.einsum("bthd,nd->bthn", q[..., half:], k2)
        v1, i1 = lax.top_k(s1, PEER_TOPK)
        v2, i2 = lax.top_k(s2, PEER_TOPK)
        cand = (v1[..., :, None] + v2[..., None, :]).reshape(bsz, T, PH, PEER_TOPK * PEER_TOPK)
        cand_idx = (i1[..., :, None] * PEER_KEYS + i2[..., None, :]).reshape(bsz, T, PH, PEER_TOPK * PEER_TOPK)
        sc, pos = lax.top_k(cand, PEER_TOPK)
        idx = jnp.take_along_axis(cand_idx, pos, axis=-1)
        gate = jax.nn.softmax(sc, axis=-1)
        act = jax.nn.gelu(jnp.einsum("btd,bthkd->bthk", hi, u[idx].astype(f32)), approximate=False)
        return jnp.einsum("bthk,bthkd->btd", gate * act, v[idx].astype(f32))

    out = lax.map(one_chunk, h_chunks)
    return out.transpose(1, 0, 2, 3).reshape(bsz, slen, dm)


def setup_inputs(seed: int = 0) -> dict:
    key = jax.random.key(seed)
    ks = iter(jax.random.split(key, 48))
    L, D = DEPTH, D_MODEL
    f32 = jnp.float32

    def nrm(shape, scale):
        return jax.random.normal(next(ks), shape, f32) * scale

    def unif(shape, lo, hi):
        return jax.random.uniform(next(ks), shape, f32, lo, hi)

    def gain(shape):
        return 1.0 + nrm(shape, 0.05)

    dt0 = jnp.exp(unif((L, SSD_HEADS), math.log(1e-3), math.log(1e-1)))
    inp = {}
    inp["x"] = nrm((BATCH, SEQ, D), 1.0)
    inp["rel_bias"] = nrm((REL_BUCKETS, MOBA_HEADS), 0.5)
    inp["norm1_g"] = gain((L, D))
    inp["w_in"] = nrm((L, D, IN_TOTAL), D ** -0.5)
    inp["conv_w"] = nrm((L, SSD_CONV, SSD_XBC), 0.5)
    inp["conv_b"] = nrm((L, SSD_XBC), 0.02)
    inp["dt_bias"] = dt0 + jnp.log(-jnp.expm1(-dt0))
    inp["a_log"] = jnp.log(unif((L, SSD_HEADS), 1.0, 16.0))
    inp["d_skip"] = 1.0 + nrm((L, SSD_HEADS), 0.1)
    inp["ssd_norm_g"] = gain((L, SSD_INNER))
    inp["q_norm_g"] = gain((L, MOBA_HEAD_DIM))
    inp["k_norm_g"] = gain((L, MOBA_HEAD_DIM))
    inp["rwkv_mu"] = unif((L, RWKV_IN), 0.0, 1.0)
    inp["w0"] = unif((L, RWKV_INNER), -7.0, -1.0)
    inp["w_w2"] = nrm((L, RWKV_DECAY_LORA, RWKV_INNER), 0.1)
    inp["a0"] = nrm((L, RWKV_INNER), 0.5)
    inp["w_a2"] = nrm((L, RWKV_ICLR_LORA, RWKV_INNER), RWKV_ICLR_LORA ** -0.5)
    inp["w_g2"] = nrm((L, RWKV_GATE_LORA, RWKV_INNER), RWKV_GATE_LORA ** -0.5)
    inp["k_k"] = 0.85 + nrm((L, RWKV_INNER), 0.05)
    inp["k_a"] = 1.0 + nrm((L, RWKV_INNER), 0.05)
    inp["r_k"] = nrm((L, RWKV_HEADS, RWKV_HEAD_DIM), 0.1)
    inp["lnx_g"] = gain((L, RWKV_INNER))
    inp["lnx_b"] = nrm((L, RWKV_INNER), 0.02)
    inp["p_ssd"] = nrm((L, SSD_INNER, D), SSD_INNER ** -0.5)
    inp["p_moba"] = nrm((L, MOBA_INNER, D), MOBA_INNER ** -0.5)
    inp["p_rwkv"] = nrm((L, RWKV_INNER, D), RWKV_INNER ** -0.5)
    inp["w_gate"] = nrm((L, D, N_BRANCH * D), D ** -0.5)
    inp["b_gate"] = nrm((L, N_BRANCH * D), 0.02)
    inp["w_out"] = nrm((L, D, D), 0.5 * D ** -0.5)
    inp["norm2_g"] = gain((L, D))
    inp["peer_wq"] = nrm((L, D, PEER_HEADS * PEER_KEY_DIM), D ** -0.5)
    inp["peer_k1"] = nrm((L, PEER_KEYS, PEER_KEY_DIM // 2), (PEER_KEY_DIM // 2) ** -0.5)
    inp["peer_k2"] = nrm((L, PEER_KEYS, PEER_KEY_DIM // 2), (PEER_KEY_DIM // 2) ** -0.5)
    inp["peer_u"] = nrm((L, PEER_EXPERTS, D), D ** -0.5)
    inp["peer_v"] = nrm((L, PEER_EXPERTS, D), 0.1)
    return inp


def reference(x, rel_bias, norm1_g, w_in, conv_w, conv_b, dt_bias, a_log, d_skip, ssd_norm_g,
              q_norm_g, k_norm_g, rwkv_mu, w0, w_w2, a0, w_a2, w_g2, k_k, k_a, r_k, lnx_g, lnx_b,
              p_ssd, p_moba, p_rwkv, w_gate, b_gate, w_out, norm2_g,
              peer_wq, peer_k1, peer_k2, peer_u, peer_v):
    bsz, slen, dm = x.shape
    for l in range(DEPTH):
        h = rms_norm(x, norm1_g[l]).astype(x.dtype)
        proj = h @ w_in[l]
        u_ssd = proj[..., :IN_SSD]
        u_moba = proj[..., IN_SSD:IN_SSD + IN_MOBA]
        u_rwkv = proj[..., IN_SSD + IN_MOBA:]
        y_a = ssd_mixer(u_ssd, conv_w[l], conv_b[l], dt_bias[l], a_log[l], d_skip[l], ssd_norm_g[l])
        y_b = moba_mixer(u_moba, q_norm_g[l], k_norm_g[l], rel_bias)
        y_c = rwkv7_mixer(u_rwkv, rwkv_mu[l], w0[l], w_w2[l], a0[l], w_a2[l], w_g2[l],
                          k_k[l], k_a[l], r_k[l], lnx_g[l], lnx_b[l])
        gates = jax.nn.sigmoid((h @ w_gate[l] + b_gate[l]).astype(jnp.float32)).reshape(bsz, slen, N_BRANCH, dm)
        merged = (gates[..., 0, :] * (y_a @ p_ssd[l].astype(jnp.float32))
                  + gates[..., 1, :] * (y_b @ p_moba[l].astype(jnp.float32))
                  + gates[..., 2, :] * (y_c @ p_rwkv[l].astype(jnp.float32)))
        x = x + (merged.astype(x.dtype) @ w_out[l])
        h2 = rms_norm(x, norm2_g[l]).astype(x.dtype)
        x = x + peer_ffn(h2, peer_wq[l], peer_k1[l], peer_k2[l], peer_u[l], peer_v[l]).astype(x.dtype)
    return x
```

```cpp
#include <hip/hip_runtime.h>
#include <hip/hip_cooperative_groups.h>
#include <cstdio>
#include <cstdint>
namespace cg = cooperative_groups;
#define DI __device__ __forceinline__
#ifndef MULTI
#define MULTI 0
#endif
#ifndef SKIP_BR
#define SKIP_BR 0
#endif
#ifndef SKIP_PEER
#define SKIP_PEER 0
#ifndef DBG
#define DBG 0
#endif
#ifndef SSD_PROBE
#define SSD_PROBE 0
#endif
#endif
#ifndef NLAYERS
#define NLAYERS 2
#endif

typedef unsigned short bf16_t;
typedef __attribute__((ext_vector_type(8))) short bf16x8;
typedef __attribute__((ext_vector_type(16))) float f32x16;
typedef __attribute__((ext_vector_type(4))) float f32x4;
typedef __attribute__((ext_vector_type(4))) unsigned u32x4;
#define MFMA32(a, b, c) __builtin_amdgcn_mfma_f32_32x32x16_bf16((a), (b), (c), 0, 0, 0)
#define MFMA16(a, b, c) __builtin_amdgcn_mfma_f32_16x16x32_bf16((a), (b), (c), 0, 0, 0)

constexpr int T_ = 32768, S_ = 16384;
constexpr size_t SLAB = 67108864;
constexpr int LDS_BYTES = 73728;

struct Params { const float* in[35]; float* out; char* ws; };

enum { I_X = 0, I_RELB, I_N1G, I_WIN, I_CONVW, I_CONVB, I_DTB, I_ALOG, I_DSKIP, I_SSDNG, I_QNG, I_KNG, I_MU, I_W0, I_WW2, I_A0,
       I_WA2, I_WG2, I_KK, I_KA, I_RK, I_LNG, I_LNB, I_PSSD, I_PMOBA, I_PRWKV, I_WGATE, I_BGATE, I_WOUT, I_N2G, I_WQ, I_K1, I_K2, I_U, I_V };

constexpr size_t OFF_W = 7 * SLAB;
constexpr size_t O_WIN = OFF_W;
constexpr size_t O_WGATE = O_WIN + 19660800;
constexpr size_t O_PT = O_WGATE + 6291456;
constexpr size_t O_WOUT = O_PT + 6291456;
constexpr size_t O_WQ = O_WOUT + 2097152;
constexpr size_t O_WW2 = O_WQ + 4194304;
constexpr size_t O_WA2 = O_WW2 + 131072;
constexpr size_t O_WG2 = O_WA2 + 131072;
constexpr size_t O_K1 = O_WG2 + 262144;
constexpr size_t O_K2 = O_K1 + 32768;
constexpr size_t OFF_X = O_K2 + 32768;
constexpr size_t O_DT = OFF_X;
constexpr size_t O_LACT = O_DT + 2097152;
constexpr size_t O_RB = O_LACT + 16777216;
constexpr size_t O_CDEC = O_RB + 2097152;
constexpr size_t O_KMEAN = O_CDEC + 16384;
constexpr size_t O_MM = O_KMEAN + 524288;
constexpr size_t O_ML = O_MM + 1048576;
constexpr size_t O_SEL = O_ML + 1048576;
constexpr size_t O_CNT = O_SEL + 3145728;
constexpr size_t O_FILL = O_CNT + 12288;
constexpr size_t O_LISTS = O_FILL + 12288;
constexpr size_t WS_END = O_LISTS + 3145728;

DI bf16_t* slab(const Params& p, int i) { return (bf16_t*)(p.ws + (size_t)i * SLAB); }

DI bf16_t f2bf(float x) { unsigned u = __float_as_uint(x); u += 0x7fffu + ((u >> 16) & 1u); return (bf16_t)(u >> 16); }
DI float bf2f(bf16_t b) { return __uint_as_float(((unsigned)b) << 16); }
DI unsigned pack2(float a, float b) { return (unsigned)f2bf(a) | ((unsigned)f2bf(b) << 16); }
DI float lo16(unsigned u) { return __uint_as_float(u << 16); }
DI float hi16(unsigned u) { return __uint_as_float(u & 0xffff0000u); }
DI bf16_t get16(const uint4& v, int e) { const unsigned w = (e >> 1) == 0 ? v.x : ((e >> 1) == 1 ? v.y : ((e >> 1) == 2 ? v.z : v.w)); return (bf16_t)((e & 1) ? (w >> 16) : (w & 0xffffu)); }
DI void unpack8(const uint4& v, float* f) {
  f[0] = lo16(v.x); f[1] = hi16(v.x); f[2] = lo16(v.y); f[3] = hi16(v.y);
  f[4] = lo16(v.z); f[5] = hi16(v.z); f[6] = lo16(v.w); f[7] = hi16(v.w);
}
DI uint4 pack8(const float* f) { uint4 v; v.x = pack2(f[0], f[1]); v.y = pack2(f[2], f[3]); v.z = pack2(f[4], f[5]); v.w = pack2(f[6], f[7]); return v; }
DI float sigmoidf_(float x) { return 1.f / (1.f + __expf(-x)); }
DI float softplusf_(float x) { return fmaxf(x, 0.f) + log1pf(__expf(-fabsf(x))); }
DI float siluf_(float x) { return x / (1.f + __expf(-x)); }
DI float wave_sum(float v) { for (int o = 32; o > 0; o >>= 1) v += __shfl_xor(v, o); return v; }
template <int CTRL> DI float dpp_add(float x) {
  int y = __builtin_amdgcn_update_dpp(0, __float_as_int(x), CTRL, 0xf, 0xf, true);
  return x + __int_as_float(y);
}
DI float red8(float x) { x = dpp_add<0xB1>(x); x = dpp_add<0x4E>(x); x = dpp_add<0x141>(x); return x; }
DI float red16(float x) { x = red8(x); x = dpp_add<0x140>(x); return x; }
DI int tidx() { int t = __builtin_amdgcn_workitem_id_x(); asm volatile("" : "+v"(t)); return t; }
DI int crow(int i, int h) { return (i & 3) + 8 * (i >> 2) + 4 * h; }

constexpr int LDT = 72;
template <int MI>
DI void gemm_core(const bf16_t* __restrict__ A, int lda, const bf16_t* __restrict__ Bt, int ldb, int K,
                  bf16_t* sA, bf16_t* sB, f32x16 (&acc)[MI][2]) {
  const int tid = tidx(), lane = tid & 63, wave = tid >> 6, wm = wave >> 1, wn = wave & 1;
  u32x4 ra[2 * MI], rb[4];
#pragma unroll
  for (int j = 0; j < 2 * MI; ++j) { const int c = tid + 256 * j; ra[j] = *(const u32x4*)(A + (size_t)(c >> 3) * lda + (c & 7) * 8); }
#pragma unroll
  for (int j = 0; j < 4; ++j) { const int c = tid + 256 * j; rb[j] = *(const u32x4*)(Bt + (size_t)(c >> 3) * ldb + (c & 7) * 8); }
  for (int k0 = 0; k0 < K; k0 += 64) {
#pragma unroll
    for (int j = 0; j < 2 * MI; ++j) { const int c = tid + 256 * j; *(u32x4*)(sA + (c >> 3) * LDT + (c & 7) * 8) = ra[j]; }
#pragma unroll
    for (int j = 0; j < 4; ++j) { const int c = tid + 256 * j; *(u32x4*)(sB + (c >> 3) * LDT + (c & 7) * 8) = rb[j]; }
    __syncthreads();
    const int kn = (k0 + 64 < K) ? k0 + 64 : k0;
#pragma unroll
    for (int j = 0; j < 2 * MI; ++j) { const int c = tid + 256 * j; ra[j] = *(const u32x4*)(A + (size_t)(c >> 3) * lda + kn + (c & 7) * 8); }
#pragma unroll
    for (int j = 0; j < 4; ++j) { const int c = tid + 256 * j; rb[j] = *(const u32x4*)(Bt + (size_t)(c >> 3) * ldb + kn + (c & 7) * 8); }
#pragma unroll
    for (int kk = 0; kk < 4; ++kk) {
      bf16x8 af[MI], bfr[2];
#pragma unroll
      for (int mi = 0; mi < MI; ++mi) af[mi] = *(const bf16x8*)(sA + (wm * 32 * MI + mi * 32 + (lane & 31)) * LDT + kk * 16 + (lane >> 5) * 8);
#pragma unroll
      for (int ni = 0; ni < 2; ++ni) bfr[ni] = *(const bf16x8*)(sB + (wn * 64 + ni * 32 + (lane & 31)) * LDT + kk * 16 + (lane >> 5) * 8);
#pragma unroll
      for (int mi = 0; mi < MI; ++mi)
#pragma unroll
        for (int ni = 0; ni < 2; ++ni) acc[mi][ni] = MFMA32(af[mi], bfr[ni], acc[mi][ni]);
    }
    __syncthreads();
  }
}
template <int MI> DI void acc_zero(f32x16 (&acc)[MI][2]) {
#pragma unroll
  for (int mi = 0; mi < MI; ++mi)
#pragma unroll
    for (int ni = 0; ni < 2; ++ni)
#pragma unroll
      for (int i = 0; i < 16; ++i) acc[mi][ni][i] = 0.f;
}
#define ACC_FOREACH(MI, acc, BODY)                                                        \
  {                                                                                       \
    int lane_ = tidx() & 63; asm volatile("" : "+v"(lane_));                        \
    const int wave_ = tidx() >> 6, wm_ = wave_ >> 1, wn_ = wave_ & 1;                \
    _Pragma("unroll") for (int mi = 0; mi < MI; ++mi)                                     \
    _Pragma("unroll") for (int ni = 0; ni < 2; ++ni)                                      \
    _Pragma("unroll") for (int i = 0; i < 16; ++i) {                                      \
      const int r = wm_ * 32 * MI + mi * 32 + crow(i, lane_ >> 5);                        \
      const int c = wn_ * 64 + ni * 32 + (lane_ & 31);                                    \
      const float v = acc[mi][ni][i];                                                       \
      BODY                                                                                \
    }                                                                                     \
  }

DI void tconv_job(const float* __restrict__ src, int ld, int K, int c0, int ncols, bf16_t* __restrict__ dst, int bid, int nb, float* sT) {
  const int ntn = (ncols + 63) >> 6, ntk = K >> 6, tid = tidx();
  for (int t = bid; t < ntn * ntk; t += nb) {
    const int tk = t % ntk, tn = t / ntk;
    const int kr = tid >> 4, nx = (tid & 15) * 4;
#pragma unroll
    for (int j = 0; j < 4; ++j) {
      const int k = kr + 16 * j;
      const float* s = src + (size_t)(tk * 64 + k) * ld + c0 + tn * 64 + nx;
      float4 v;
      if (tn * 64 + nx + 3 < ncols) v = *(const float4*)s;
      else { v.x = (tn * 64 + nx < ncols) ? s[0] : 0.f; v.y = (tn * 64 + nx + 1 < ncols) ? s[1] : 0.f; v.z = (tn * 64 + nx + 2 < ncols) ? s[2] : 0.f; v.w = 0.f; }
      sT[k * 65 + nx] = v.x; sT[k * 65 + nx + 1] = v.y; sT[k * 65 + nx + 2] = v.z; sT[k * 65 + nx + 3] = v.w;
    }
    __syncthreads();
    const int n = tid >> 2, kq = tid & 3;
    if (tn * 64 + n < ncols) {
      float f[16];
#pragma unroll
      for (int j = 0; j < 16; ++j) f[j] = sT[(kq * 16 + j) * 65 + n];
      uint4* d = (uint4*)(dst + (size_t)(tn * 64 + n) * K + tk * 64 + kq * 16);
      d[0] = pack8(f); d[1] = pack8(f + 8);
    }
    __syncthreads();
  }
}
DI void conv_plain(const float* __restrict__ src, bf16_t* __restrict__ dst, size_t n, int bid, int nb) {
  size_t i = ((size_t)bid * 256 + tidx()), st = (size_t)nb * 256;
  for (; i < n / 8; i += st) {
    float4 a = ((const float4*)src)[2 * i], b = ((const float4*)src)[2 * i + 1];
    uint4 o; o.x = pack2(a.x, a.y); o.y = pack2(a.z, a.w); o.z = pack2(b.x, b.y); o.w = pack2(b.z, b.w);
    ((uint4*)dst)[i] = o;
  }
}
DI void rmsnorm_phase(const float* __restrict__ x, const float* __restrict__ g, bf16_t* __restrict__ h, int bid, int nb) {
  const int wave = tidx() >> 6, lane = tidx() & 63;
  for (int row = bid * 4 + wave; row < T_; row += nb * 4) {
    const float4* xr = (const float4*)(x + (size_t)row * 1024);
    float4 v[4]; float ss = 0.f;
#pragma unroll
    for (int j = 0; j < 4; ++j) { v[j] = xr[lane + 64 * j]; ss += v[j].x * v[j].x + v[j].y * v[j].y + v[j].z * v[j].z + v[j].w * v[j].w; }
    ss = wave_sum(ss);
    const float r = rsqrtf(ss * (1.f / 1024.f) + 1e-6f);
#pragma unroll
    for (int j = 0; j < 4; ++j) {
      float4 g4 = ((const float4*)g)[lane + 64 * j];
      uint2 o; o.x = pack2(v[j].x * r * g4.x, v[j].y * r * g4.y); o.y = pack2(v[j].z * r * g4.z, v[j].w * r * g4.w);
      ((uint2*)(h + (size_t)row * 1024))[lane + 64 * j] = o;
    }
  }
}
DI void phase_prep(const Params& p, int l, int bid, int nb, char* smem) {
  float* sT = (float*)smem;
  char* ws = p.ws;
  const float* win = p.in[I_WIN] + (size_t)l * 1024 * 9488;
  bf16_t* wt_in = (bf16_t*)(ws + O_WIN);
  tconv_job(win, 9488, 1024, 0, 3072, wt_in, bid, nb, sT);
  tconv_job(win, 9488, 1024, 3088, 6400, wt_in + (size_t)3072 * 1024, bid, nb, sT);
  tconv_job(win, 9488, 1024, 3072, 16, wt_in + (size_t)9472 * 1024, bid, nb, sT);
  {
    uint4 z = {0, 0, 0, 0};
    uint4* d = (uint4*)(wt_in + (size_t)9488 * 1024);
    for (int i = bid * 256 + tidx(); i < 112 * 1024 / 8; i += nb * 256) d[i] = z;
  }
  tconv_job(p.in[I_WGATE] + (size_t)l * 1024 * 3072, 3072, 1024, 0, 3072, (bf16_t*)(ws + O_WGATE), bid, nb, sT);
  tconv_job(p.in[I_PSSD] + (size_t)l * 1048576, 1024, 1024, 0, 1024, (bf16_t*)(ws + O_PT), bid, nb, sT);
  tconv_job(p.in[I_PMOBA] + (size_t)l * 1048576, 1024, 1024, 0, 1024, (bf16_t*)(ws + O_PT) + 1048576, bid, nb, sT);
  tconv_job(p.in[I_PRWKV] + (size_t)l * 1048576, 1024, 1024, 0, 1024, (bf16_t*)(ws + O_PT) + 2 * 1048576, bid, nb, sT);
  tconv_job(p.in[I_WOUT] + (size_t)l * 1048576, 1024, 1024, 0, 1024, (bf16_t*)(ws + O_WOUT), bid, nb, sT);
  tconv_job(p.in[I_WQ] + (size_t)l * 1024 * 2048, 2048, 1024, 0, 2048, (bf16_t*)(ws + O_WQ), bid, nb, sT);
  tconv_job(p.in[I_WW2] + (size_t)l * 64 * 1024, 1024, 64, 0, 1024, (bf16_t*)(ws + O_WW2), bid, nb, sT);
  tconv_job(p.in[I_WA2] + (size_t)l * 64 * 1024, 1024, 64, 0, 1024, (bf16_t*)(ws + O_WA2), bid, nb, sT);
  tconv_job(p.in[I_WG2] + (size_t)l * 128 * 1024, 1024, 128, 0, 1024, (bf16_t*)(ws + O_WG2), bid, nb, sT);
  conv_plain(p.in[I_K1] + (size_t)l * 16384, (bf16_t*)(ws + O_K1), 16384, bid, nb);
  conv_plain(p.in[I_K2] + (size_t)l * 16384, (bf16_t*)(ws + O_K2), 16384, bid, nb);
  { int* cz = (int*)(ws + O_CNT); for (int i = bid * 256 + tidx(); i < 2 * 3072; i += nb * 256) cz[i] = 0; }
  const float* xin = l == 0 ? p.in[I_X] : p.out;
  rmsnorm_phase(xin, p.in[I_N1G] + l * 1024, slab(p, 0), bid, nb);
}

struct Route { int packed; int seg0; };
DI void gemm_in_phase(const Params& p, int l, const Route rt, int nt, int t0a, int t0b_from, int t0b, int bid, int nb, char* smem) {
  bf16_t* sA = (bf16_t*)smem; bf16_t* sB = sA + 128 * LDT;
  const bf16_t* h = slab(p, 0);
  const bf16_t* wt = (const bf16_t*)(p.ws + O_WIN);
  bf16_t* lora = slab(p, 3); float* dtp = (float*)(p.ws + O_DT); const float* dtb = p.in[I_DTB] + l * 16;
  for (int t = bid; t < 256 * nt; t += nb) {
    const int tm = t / nt, tl = t % nt;
    const int tn = tl < t0b_from ? t0a + tl : t0b + (tl - t0b_from);
    f32x16 acc[2][2]; acc_zero<2>(acc);
    gemm_core<2>(h + (size_t)tm * 128 * 1024, 1024, wt + (size_t)tn * 128 * 1024, 1024, 1024, sA, sB, acc);
    const int row0 = tm * 128, col0 = tn * 128, seg = col0 >> 10;
    if (seg < 9) {
      bf16_t* d = slab(p, (rt.packed >> (4 * (seg - rt.seg0))) & 15) + (size_t)row0 * 1024 + (col0 & 1023);
      ACC_FOREACH(2, acc, { d[(size_t)r * 1024 + c] = f2bf(v); })
    } else {
      const int cc0 = col0 - 9216;
      ACC_FOREACH(2, acc, {
        const int cc = cc0 + c;
        if (cc < 256) lora[(size_t)(row0 + r) * 256 + cc] = f2bf(v);
        else if (cc < 272) dtp[(size_t)(row0 + r) * 16 + (cc - 256)] = softplusf_(v + dtb[cc - 256]);
      })
    }
  }
}

DI void phase_lora_prep(const Params& p, int l, int bid, int nb) {
  const bf16_t* raw = slab(p, 3);
  bf16_t* act = (bf16_t*)(p.ws + O_LACT);
  const float* mu = p.in[I_MU] + l * 3328 + 3072;
  for (int it = bid * 256 + tidx(); it < T_ * 32; it += nb * 256) {
    const int t = it >> 5, c8 = (it & 31) * 8;
    uint4 cur = *(const uint4*)(raw + (size_t)t * 256 + c8);
    uint4 prv = {0, 0, 0, 0};
    if (t & (S_ - 1)) prv = *(const uint4*)(raw + (size_t)(t - 1) * 256 + c8);
    float x[8], xp[8], o[8];
    unpack8(cur, x); unpack8(prv, xp);
#pragma unroll
    for (int e = 0; e < 8; ++e) {
      const int j = c8 + e;
      const float xs = x[e] + (xp[e] - x[e]) * mu[j];
      o[e] = j < 64 ? tanhf(xs) : (j < 128 ? xs : sigmoidf_(xs));
    }
    *(uint4*)(act + (size_t)t * 256 + c8) = pack8(o);
  }
}
template <class F>
DI void gemm_lora_phase(const Params& p, int aoff, int K, const bf16_t* wt, int bid, int nb, char* smem, F epi) {
  bf16_t* sA = (bf16_t*)smem; bf16_t* sB = sA + 128 * LDT;
  const bf16_t* A = (const bf16_t*)(p.ws + O_LACT) + aoff;
  for (int t = bid; t < 256 * 8; t += nb) {
    const int tm = t >> 3, tn = t & 7;
    f32x16 acc[2][2]; acc_zero<2>(acc);
    gemm_core<2>(A + (size_t)tm * 128 * 256, 256, wt + (size_t)tn * 128 * K, K, K, sA, sB, acc);
    const int row0 = tm * 128, col0 = tn * 128;
    ACC_FOREACH(2, acc, { epi(row0 + r, col0 + c, v); })
  }
}
DI void phase_lora_wa(const Params& p, int l, int bid, int nb, char* smem) {
  const float* w0 = p.in[I_W0] + l * 1024; const float* a0 = p.in[I_A0] + l * 1024;
  bf16_t* ew = slab(p, 1); bf16_t* av = slab(p, 2);
  gemm_lora_phase(p, 0, 64, (const bf16_t*)(p.ws + O_WW2), bid, nb, smem, [&](int r, int c, float v) {
    const float wpre = w0[c] + v;
    const float w = -softplusf_(-wpre) - 0.5f;
    ew[(size_t)r * 1024 + c] = f2bf(__expf(w));
  });
  gemm_lora_phase(p, 64, 64, (const bf16_t*)(p.ws + O_WA2), bid, nb, smem, [&](int r, int c, float v) {
    av[(size_t)r * 1024 + c] = f2bf(sigmoidf_(a0[c] + v));
  });
}
DI void phase_rwkv_scan(const Params& p, int l, int bid, int nb, char* smem) {
  float* sa = (float*)smem; float* sw = sa + 2048; float* sb = sw + 2048; float* sk = sb + 2048; float* sr = sk + 2048;
  float* sv = sr + 2048; float* sy = sv + 512;
  const int tid = tidx(), lane = tid & 63, wave = tid >> 6;
  const bf16_t* R = slab(p, 4); const bf16_t* Kx = slab(p, 5); const bf16_t* V = slab(p, 6);
  const bf16_t* EW = slab(p, 1); const bf16_t* AV = slab(p, 2);
  bf16_t* Y = slab(p, 3);
  float* rbout = (float*)(p.ws + O_RB);
  for (int task = bid; task < 128; task += nb) {
    const int qd = task & 3, head = (task >> 2) & 15, b = task >> 6;
    const int st = tid >> 3, c8 = tid & 7, ch0 = head * 64 + c8 * 8;
    float mur[8], muk[8], muv[8], ckk[8], cka[8], crk[8];
#pragma unroll
    for (int e = 0; e < 8; ++e) {
      mur[e] = p.in[I_MU][l * 3328 + ch0 + e]; muk[e] = p.in[I_MU][l * 3328 + 1024 + ch0 + e]; muv[e] = p.in[I_MU][l * 3328 + 2048 + ch0 + e];
      ckk[e] = p.in[I_KK][l * 1024 + ch0 + e]; cka[e] = p.in[I_KA][l * 1024 + ch0 + e]; crk[e] = p.in[I_RK][l * 1024 + ch0 + e];
    }
    uint4 gr, gk, gv, gw, ga, gpr, gpk, gpv;
    auto gload = [&](int c) {
      const int ts = c * 32 + st;
      const size_t o = ((size_t)b * S_ + ts) * 1024 + ch0;
      gr = *(const uint4*)(R + o); gk = *(const uint4*)(Kx + o); gv = *(const uint4*)(V + o);
      gw = *(const uint4*)(EW + o); ga = *(const uint4*)(AV + o);
      if (ts > 0) { gpr = *(const uint4*)(R + o - 1024); gpk = *(const uint4*)(Kx + o - 1024); gpv = *(const uint4*)(V + o - 1024); }
      else { gpr = make_uint4(0, 0, 0, 0); gpk = gpr; gpv = gpr; }
    };
    auto stage = [&](int c) {
      float r[8], k[8], v[8], w[8], a[8], pr[8], pk[8], pv[8];
      unpack8(gr, r); unpack8(gk, k); unpack8(gv, v); unpack8(gw, w); unpack8(ga, a); unpack8(gpr, pr); unpack8(gpk, pk); unpack8(gpv, pv);
      float kk[8], ss = 0.f, rbs = 0.f;
#pragma unroll
      for (int e = 0; e < 8; ++e) {
        r[e] = r[e] + (pr[e] - r[e]) * mur[e];
        k[e] = k[e] + (pk[e] - k[e]) * muk[e];
        v[e] = v[e] + (pv[e] - v[e]) * muv[e];
        kk[e] = k[e] * ckk[e]; ss += kk[e] * kk[e];
      }
      ss = red8(ss);
      const float inv = rsqrtf(fmaxf(ss, 1e-12f));
      float oa[8], ow[8], ob[8], ok[8];
#pragma unroll
      for (int e = 0; e < 8; ++e) {
        kk[e] *= inv;
        ok[e] = k[e] * (1.f + (a[e] - 1.f) * cka[e]);
        oa[e] = -kk[e]; ob[e] = kk[e] * a[e]; ow[e] = __expf(-w[e]);
        rbs += r[e] * ok[e] * crk[e];
      }
      rbs = red8(rbs);
      float* d;
      d = sa + st * 64 + c8 * 8; *(float4*)d = make_float4(oa[0], oa[1], oa[2], oa[3]); *(float4*)(d + 4) = make_float4(oa[4], oa[5], oa[6], oa[7]);
      d = sw + st * 64 + c8 * 8; *(float4*)d = make_float4(ow[0], ow[1], ow[2], ow[3]); *(float4*)(d + 4) = make_float4(ow[4], ow[5], ow[6], ow[7]);
      d = sb + st * 64 + c8 * 8; *(float4*)d = make_float4(ob[0], ob[1], ob[2], ob[3]); *(float4*)(d + 4) = make_float4(ob[4], ob[5], ob[6], ob[7]);
      d = sk + st * 64 + c8 * 8; *(float4*)d = make_float4(ok[0], ok[1], ok[2], ok[3]); *(float4*)(d + 4) = make_float4(ok[4], ok[5], ok[6], ok[7]);
      d = sr + st * 64 + c8 * 8; *(float4*)d = make_float4(r[0], r[1], r[2], r[3]); *(float4*)(d + 4) = make_float4(r[4], r[5], r[6], r[7]);
      if ((c8 >> 1) == qd) {
        d = sv + st * 16 + (c8 & 1) * 8; *(float4*)d = make_float4(v[0], v[1], v[2], v[3]); *(float4*)(d + 4) = make_float4(v[4], v[5], v[6], v[7]);
      }
      if (qd == 0 && c8 == 0) rbout[((size_t)b * S_ + c * 32 + st) * 16 + head] = rbs;
    };
    const int rowl = wave * 4 + (lane >> 4), pp = lane & 15;
    float s0 = 0.f, s1 = 0.f, s2 = 0.f, s3 = 0.f;
    gload(0);
    __syncthreads();
    stage(0);
    __syncthreads();
    for (int c = 0; c < 512; ++c) {
      if (c + 1 < 512) gload(c + 1);
#pragma unroll 4
      for (int s = 0; s < 32; ++s) {
        const float4 a4 = *(const float4*)(sa + s * 64 + 4 * pp);
        const float4 w4 = *(const float4*)(sw + s * 64 + 4 * pp);
        const float4 b4 = *(const float4*)(sb + s * 64 + 4 * pp);
        const float4 k4 = *(const float4*)(sk + s * 64 + 4 * pp);
        const float4 r4 = *(const float4*)(sr + s * 64 + 4 * pp);
        const float vv = sv[s * 16 + rowl];
        float d = s0 * a4.x + s1 * a4.y + s2 * a4.z + s3 * a4.w;
        d = red16(d);
        s0 = s0 * w4.x + d * b4.x + vv * k4.x;
        s1 = s1 * w4.y + d * b4.y + vv * k4.y;
        s2 = s2 * w4.z + d * b4.z + vv * k4.z;
        s3 = s3 * w4.w + d * b4.w + vv * k4.w;
        float y = s0 * r4.x + s1 * r4.y + s2 * r4.z + s3 * r4.w;
        y = red16(y);
        if (pp == 0) sy[s * 16 + rowl] = y;
      }
      __syncthreads();
      if (tid < 64) {
        const int s = tid >> 1, hf = tid & 1;
        float f[8];
#pragma unroll
        for (int e = 0; e < 8; ++e) f[e] = sy[s * 16 + hf * 8 + e];
        *(uint4*)(Y + ((size_t)b * S_ + c * 32 + s) * 1024 + head * 64 + qd * 16 + hf * 8) = pack8(f);
      }
      if (c + 1 < 512) stage(c + 1);
      __syncthreads();
    }
  }
}
DI void phase_rwkv_ln(const Params& p, int l, int bid, int nb) {
  bf16_t* Y = slab(p, 3); const bf16_t* V = slab(p, 6);
  const float* rb = (const float*)(p.ws + O_RB);
  const float* lng = p.in[I_LNG] + l * 1024; const float* lnb = p.in[I_LNB] + l * 1024; const float* muv = p.in[I_MU] + l * 3328 + 2048;
  for (int it = bid * 256 + tidx(); it < T_ * 128; it += nb * 256) {
    const int t = it >> 7, c8 = (it & 127) * 8, head = c8 >> 6;
    float y[8], v[8], pv[8], o[8];
    unpack8(*(const uint4*)(Y + (size_t)t * 1024 + c8), y);
    unpack8(*(const uint4*)(V + (size_t)t * 1024 + c8), v);
    uint4 pz = {0, 0, 0, 0};
    if (t & (S_ - 1)) pz = *(const uint4*)(V + (size_t)(t - 1) * 1024 + c8);
    unpack8(pz, pv);
    float s = 0.f;
#pragma unroll
    for (int e = 0; e < 8; ++e) s += y[e];
    s = red8(s);
    const float mean = s * (1.f / 64.f);
    float q = 0.f;
#pragma unroll
    for (int e = 0; e < 8; ++e) { const float d = y[e] - mean; q += d * d; }
    q = red8(q);
    const float rstd = rsqrtf(q * (1.f / 64.f) + 64e-5f);
    const float rbv = rb[(size_t)t * 16 + head];
#pragma unroll
    for (int e = 0; e < 8; ++e) {
      const float vs = v[e] + (pv[e] - v[e]) * muv[c8 + e];
      o[e] = (y[e] - mean) * rstd * lng[c8 + e] + lnb[c8 + e] + rbv * vs;
    }
    *(uint4*)(Y + (size_t)t * 1024 + c8) = pack8(o);
  }
}
DI void phase_rwkv_g(const Params& p, int l, int bid, int nb, char* smem) {
  bf16_t* Y = slab(p, 3);
  gemm_lora_phase(p, 128, 128, (const bf16_t*)(p.ws + O_WG2), bid, nb, smem, [&](int r, int c, float v) {
    const size_t o = (size_t)r * 1024 + c;
    Y[o] = f2bf(bf2f(Y[o]) * v);
  });
}

DI void phase_ssd_conv(const Params& p, int l, int bid, int nb) {
  const bf16_t* rx = slab(p, 2); const bf16_t* rbc = slab(p, 4);
  bf16_t* xs = slab(p, 5); bf16_t* bc = slab(p, 6);
  const float* cw = p.in[I_CONVW] + l * 4 * 2048; const float* cb = p.in[I_CONVB] + l * 2048;
  for (int it = bid * 256 + tidx(); it < T_ * 256; it += nb * 256) {
    const int t = it >> 8, c8 = (it & 255) * 8;
    const bf16_t* src = c8 < 1024 ? rx : rbc; bf16_t* dst = c8 < 1024 ? xs : bc;
    const int cc = c8 & 1023, ts = t & (S_ - 1);
    float acc[8];
#pragma unroll
    for (int e = 0; e < 8; ++e) acc[e] = cb[c8 + e];
#pragma unroll
    for (int k = 0; k < 4; ++k) {
      if (ts - 3 + k >= 0) {
        float x[8]; unpack8(*(const uint4*)(src + (size_t)(t - 3 + k) * 1024 + cc), x);
#pragma unroll
        for (int e = 0; e < 8; ++e) acc[e] += x[e] * cw[k * 2048 + c8 + e];
      }
    }
#pragma unroll
    for (int e = 0; e < 8; ++e) acc[e] = siluf_(acc[e]);
    *(uint4*)(dst + (size_t)t * 1024 + cc) = pack8(acc);
  }
}
DI float* scan128(float* a, float* b) {
  const int tid = tidx();
  float* src = a; float* dst = b;
  for (int off = 1; off < 128; off <<= 1) {
    if (tid < 128) dst[tid] = src[tid] + (tid >= off ? src[tid - off] : 0.f);
    __syncthreads();
    float* t = src; src = dst; dst = t;
  }
  return src;
}
DI void phase_ssd_states(const Params& p, int l, int bid, int nb, char* smem) {
  bf16_t* sXT = (bf16_t*)smem;
  bf16_t* sBT = sXT + 64 * 136;
  float* fa = (float*)(sBT + 128 * 136);
  float* fb = fa + 128; float* fdt = fb + 128;
  const int tid = tidx(), lane = tid & 63, wave = tid >> 6;
  const bf16_t* xs = slab(p, 5); const bf16_t* bc = slab(p, 6);
  const float* dt = (const float*)(p.ws + O_DT);
  float* cdec = (float*)(p.ws + O_CDEC);
  for (int task = bid; task < 4096; task += nb) {
    const int head = task & 15, c = (task >> 4) & 127, b = task >> 11, g = head >> 2;
    const size_t t0 = (size_t)b * S_ + c * 128;
    const float aneg = -__expf(p.in[I_ALOG][l * 16 + head]);
    __syncthreads();
    if (tid < 128) { const float d = dt[(t0 + tid) * 16 + head]; fdt[tid] = d; fa[tid] = d * aneg; }
    __syncthreads();
    float* acs = scan128(fa, fb);
    const float alast = acs[127];
    if (tid == 0) cdec[(b * 128 + c) * 16 + head] = __expf(alast);
#pragma unroll
    for (int j = 0; j < 4; ++j) {
      const int ci = tid + 256 * j, lr = ci >> 3, p8 = (ci & 7) * 8;
      float x[8]; unpack8(*(const uint4*)(xs + (t0 + lr) * 1024 + head * 64 + p8), x);
      const float sc = fdt[lr] * __expf(alast - acs[lr]);
#pragma unroll
      for (int e = 0; e < 8; ++e) sXT[(p8 + e) * 136 + lr] = f2bf(x[e] * sc);
    }
#pragma unroll
    for (int j = 0; j < 8; ++j) {
      const int ci = tid + 256 * j, lr = ci >> 4, n8 = (ci & 15) * 8;
      const uint4 u = *(const uint4*)(bc + (t0 + lr) * 1024 + g * 128 + n8);
#pragma unroll
      for (int e = 0; e < 8; ++e) sBT[(n8 + e) * 136 + lr] = get16(u, e);
    }
    __syncthreads();
    f32x16 acc[2];
#pragma unroll
    for (int mi = 0; mi < 2; ++mi)
#pragma unroll
      for (int i = 0; i < 16; ++i) acc[mi][i] = 0.f;
#pragma unroll
    for (int kk = 0; kk < 8; ++kk) {
      const bf16x8 bf = *(const bf16x8*)(sBT + (wave * 32 + (lane & 31)) * 136 + kk * 16 + (lane >> 5) * 8);
#pragma unroll
      for (int mi = 0; mi < 2; ++mi) {
        const bf16x8 af = *(const bf16x8*)(sXT + (mi * 32 + (lane & 31)) * 136 + kk * 16 + (lane >> 5) * 8);
        acc[mi] = MFMA32(af, bf, acc[mi]);
      }
    }
    float* st = (float*)slab(p, b == 0 ? 2 : 4) + ((size_t)(c * 16 + head) * 64) * 128;
#pragma unroll
    for (int mi = 0; mi < 2; ++mi)
#pragma unroll
      for (int i = 0; i < 16; ++i) st[(size_t)(mi * 32 + crow(i, lane >> 5)) * 128 + wave * 32 + (lane & 31)] = acc[mi][i];
  }
}
DI void phase_ssd_scan(const Params& p, int bid, int nb) {
  const float* cdec = (const float*)(p.ws + O_CDEC);
  for (int it = bid * 256 + tidx(); it < 2 * 16 * 8192; it += nb * 256) {
    const int b = it >> 17, rem = it & 131071, head = rem >> 13;
    float* st = (float*)slab(p, b == 0 ? 2 : 4) + rem;
    float h = 0.f;
#pragma unroll 8
    for (int c = 0; c < 128; ++c) {
      const float s = st[(size_t)c * 131072];
      st[(size_t)c * 131072] = h;
      h = h * cdec[(b * 128 + c) * 16 + head] + s;
    }
  }
}
DI void phase_ssd_out(const Params& p, int l, int bid, int nb, char* smem) {
  bf16_t* sM = (bf16_t*)smem;
  bf16_t* sXT = sM + 128 * 136;
  float* fa = (float*)(sXT + 64 * 136); float* fb = fa + 128; float* fdt = fb + 128; float* frs = fdt + 128;
  const int tid_ = tidx(), lane = tid_ & 63, wave_ = __builtin_amdgcn_readfirstlane(tid_ >> 6), hh_ = lane >> 5, l31_ = lane & 31;
  const bf16_t* xs = slab(p, 5); const bf16_t* bc = slab(p, 6);
  bf16_t* zy = slab(p, 1);
  const float* dt = (const float*)(p.ws + O_DT);
  const float* ng = p.in[I_SSDNG] + l * 1024;
  for (int task = bid; task < 1024; task += nb) {
    const int g = task & 3, c = (task >> 2) & 127, b = task >> 9;
    const size_t t0 = (size_t)b * S_ + c * 128;
    int tid = tid_; asm volatile("" : "+v"(tid));
    __syncthreads();
#pragma unroll
    for (int j = 0; j < 8; ++j) {
      const int ci = tid + 256 * j, lr = ci >> 4, n8 = (ci & 15) * 8;
      *(uint4*)(sM + lr * 136 + n8) = *(const uint4*)(bc + (t0 + lr) * 1024 + g * 128 + n8);
    }
    const int wave = wave_, hh = hh_, l31 = l31_;
    const bf16_t* cptr = bc + (t0 + wave * 32 + l31) * 1024 + 512 + g * 128 + hh * 8;
    __syncthreads();
    f32x16 cb[4];
#pragma unroll
    for (int ni = 0; ni < 4; ++ni)
#pragma unroll
      for (int i = 0; i < 16; ++i) cb[ni][i] = 0.f;
#pragma unroll
    for (int kk = 0; kk < 8; ++kk) {
      const bf16x8 cfk = *(const bf16x8*)(cptr + kk * 16);
#pragma unroll
      for (int ni = 0; ni < 4; ++ni) {
        const bf16x8 bf = *(const bf16x8*)(sM + (ni * 32 + l31) * 136 + kk * 16 + hh * 8);
        cb[ni] = MFMA32(cfk, bf, cb[ni]);
      }
    }
    float ssq[16];
#pragma unroll
    for (int i = 0; i < 16; ++i) ssq[i] = 0.f;
#pragma unroll 1
    for (int e = 0; e < 4; ++e) {
      int l31 = l31_, hh = hh_, wave = wave_;
      asm volatile("" : "+v"(l31), "+v"(hh));
      asm volatile("" : "+s"(wave));
      const int head = g * 4 + e;
      const float aneg = -__expf(p.in[I_ALOG][l * 16 + head]);
      const float dsk = p.in[I_DSKIP][l * 16 + head];
      __syncthreads();
      if (tid < 128) { const float d = dt[(t0 + tid) * 16 + head]; fdt[tid] = d; fa[tid] = d * aneg; }
      __syncthreads();
      float* acs = scan128(fa, fb);
#pragma unroll
      for (int j = 0; j < 4; ++j) {
        const int ci = tid + 256 * j, lr = ci >> 3, p8 = (ci & 7) * 8;
        const uint4 u = *(const uint4*)(xs + (t0 + lr) * 1024 + head * 64 + p8);
#pragma unroll
        for (int q = 0; q < 8; ++q) sXT[(p8 + q) * 136 + lr] = get16(u, q);
      }
#pragma unroll
      for (int ni = 0; ni < 4; ++ni)
#pragma unroll
        for (int i = 0; i < 16; ++i) {
          const int lr = wave * 32 + crow(i, hh), sc = ni * 32 + l31;
          const float m = sc <= lr ? cb[ni][i] * __expf(acs[lr] - acs[sc]) * fdt[sc] : 0.f;
          sM[lr * 136 + sc] = f2bf(m);
        }
      __syncthreads();
      const float* hin = (const float*)slab(p, b == 0 ? 2 : 4) + ((size_t)(c * 16 + head) * 64) * 128;
#pragma unroll 1
      for (int ni = 0; ni < 2; ++ni) {
        f32x16 yd;
#pragma unroll
        for (int i = 0; i < 16; ++i) yd[i] = 0.f;
#pragma unroll 2
        for (int kk = 0; kk < 8; ++kk) {
          const bf16x8 cfk = *(const bf16x8*)(cptr + kk * 16);
          const float* hp = hin + (size_t)(ni * 32 + l31) * 128 + kk * 16 + hh * 8;
          const float4 h0 = *(const float4*)hp, h1 = *(const float4*)(hp + 4);
          u32x4 u; u.x = pack2(h0.x, h0.y); u.y = pack2(h0.z, h0.w); u.z = pack2(h1.x, h1.y); u.w = pack2(h1.z, h1.w);
          yd = MFMA32(cfk, __builtin_bit_cast(bf16x8, u), yd);
        }
#pragma unroll
        for (int i = 0; i < 16; ++i) yd[i] *= (SSD_PROBE == 2 ? 0.f : __expf(acs[wave * 32 + crow(i, hh)]));
#pragma unroll
        for (int kk = 0; kk < 8; ++kk) {
          const bf16x8 af = *(const bf16x8*)(sM + (wave * 32 + l31) * 136 + kk * 16 + hh * 8);
          const bf16x8 bf = *(const bf16x8*)(sXT + (ni * 32 + l31) * 136 + kk * 16 + hh * 8);
          yd = MFMA32(af, bf, yd);
        }
#pragma unroll
        for (int i = 0; i < 16; ++i) {
          const int lr = wave * 32 + crow(i, hh), pc = ni * 32 + l31;
          const float xv = bf2f(sXT[pc * 136 + lr]);
          float y = (SSD_PROBE == 1 ? 0.f : yd[i]) + xv * dsk;
          const size_t o = (t0 + lr) * 1024 + head * 64 + pc;
          const float zv = bf2f(zy[o]);
          y *= siluf_(zv);
          ssq[i] += y * y;
          zy[o] = f2bf(y);
        }
      }
    }
#pragma unroll
    for (int i = 0; i < 16; ++i) {
      float s = ssq[i];
      for (int o = 16; o > 0; o >>= 1) s += __shfl_xor(s, o);
      if (l31 == 0) frs[wave * 32 + crow(i, hh)] = rsqrtf(s * (1.f / 256.f) + 1e-6f);
    }
    __syncthreads();
#pragma unroll 2
    for (int j = 0; j < (DBG == 2 ? 0 : 16); ++j) {
      const int ci = tid + 256 * j, lr = ci >> 5, c8 = (ci & 31) * 8;
      bf16_t* ptr = zy + (t0 + lr) * 1024 + g * 256 + c8;
      float f[8]; unpack8(*(const uint4*)ptr, f);
      const float rs = frs[lr];
#pragma unroll
      for (int q = 0; q < 8; ++q) f[q] *= rs * ng[g * 256 + c8 + q];
      *(uint4*)ptr = pack8(f);
    }
  }
}

DI void phase_moba_norm(const Params& p, int l, int bid, int nb, char* smem) {
  float* sK = (float*)smem;
  const int tid = tidx(), rg = tid >> 4, ln = tid & 15;
  bf16_t* Q = slab(p, 2); bf16_t* Kx = slab(p, 4);
  float* kmean = (float*)(p.ws + O_KMEAN);
  float qg[8], kg[8];
#pragma unroll
  for (int e = 0; e < 8; ++e) { qg[e] = p.in[I_QNG][l * 128 + ln * 8 + e]; kg[e] = p.in[I_KNG][l * 128 + ln * 8 + e]; }
  for (int task = bid; task < 1024; task += nb) {
    const int blk = task & 63, h = (task >> 6) & 7, b = task >> 9;
    const size_t t0 = (size_t)b * S_ + blk * 256;
    float ks[8];
#pragma unroll
    for (int e = 0; e < 8; ++e) ks[e] = 0.f;
    for (int j = 0; j < 16; ++j) {
      const size_t o = (t0 + rg + 16 * j) * 1024 + h * 128 + ln * 8;
      float f[8]; float ss = 0.f;
      unpack8(*(const uint4*)(Q + o), f);
#pragma unroll
      for (int e = 0; e < 8; ++e) ss += f[e] * f[e];
      ss = red16(ss);
      float r = rsqrtf(ss * (1.f / 128.f) + 1e-6f);
#pragma unroll
      for (int e = 0; e < 8; ++e) f[e] *= r * qg[e];
      *(uint4*)(Q + o) = pack8(f);
      unpack8(*(const uint4*)(Kx + o), f);
      ss = 0.f;
#pragma unroll
      for (int e = 0; e < 8; ++e) ss += f[e] * f[e];
      ss = red16(ss);
      r = rsqrtf(ss * (1.f / 128.f) + 1e-6f);
#pragma unroll
      for (int e = 0; e < 8; ++e) { f[e] *= r * kg[e]; ks[e] += f[e]; }
      *(uint4*)(Kx + o) = pack8(f);
    }
    __syncthreads();
#pragma unroll
    for (int e = 0; e < 8; ++e) sK[rg * 128 + ln * 8 + e] = ks[e];
    __syncthreads();
    if (tid < 128) {
      float s = 0.f;
#pragma unroll
      for (int j = 0; j < 16; ++j) s += sK[j * 128 + tid];
      kmean[((size_t)(b * 8 + h) * 64 + blk) * 128 + tid] = s * (1.f / 256.f);
    }
  }
}
DI void phase_moba_gate(const Params& p, int bid, int nb, char* smem) {
  float* sKm = (float*)smem;
  const int tid = tidx();
  const bf16_t* Q = slab(p, 2);
  const float* kmean = (const float*)(p.ws + O_KMEAN);
  int* sel = (int*)(p.ws + O_SEL); int* cnt = (int*)(p.ws + O_CNT);
  for (int task = bid; task < 1024; task += nb) {
    const int blk = task & 63, h = (task >> 6) & 7, b = task >> 9;
    __syncthreads();
    for (int i = tid; i < blk * 128; i += 256) sKm[i] = kmean[((size_t)(b * 8 + h) * 64) * 128 + i];
    __syncthreads();
    const size_t t = (size_t)b * S_ + blk * 256 + tid;
    float q[128];
#pragma unroll
    for (int j = 0; j < 16; ++j) unpack8(*(const uint4*)(Q + t * 1024 + h * 128 + j * 8), q + j * 8);
    float v0 = -3e38f, v1 = -3e38f, v2 = -3e38f; int i0 = -1, i1 = -1, i2 = -1;
    for (int j = 0; j < blk; ++j) {
      float d = 0.f;
#pragma unroll
      for (int e = 0; e < 128; ++e) d += q[e] * sKm[j * 128 + e];
      if (d > v0) { v2 = v1; i2 = i1; v1 = v0; i1 = i0; v0 = d; i0 = j; }
      else if (d > v1) { v2 = v1; i2 = i1; v1 = d; i1 = j; }
      else if (d > v2) { v2 = d; i2 = j; }
    }
    int* so = sel + (t * 8 + h) * 3;
    so[0] = i0; so[1] = i1; so[2] = i2;
    const int base = (b * 8 + h) * 64;
    if (i0 >= 0) atomicAdd(cnt + 0 * 1024 + base + i0, 1);
    if (i1 >= 0) atomicAdd(cnt + 1 * 1024 + base + i1, 1);
    if (i2 >= 0) atomicAdd(cnt + 2 * 1024 + base + i2, 1);
  }
}
DI void phase_moba_fill(const Params& p, int bid, int nb, char* smem) {
  int* sBase = (int*)smem;
  const int tid = tidx();
  const int* sel = (const int*)(p.ws + O_SEL); const int* cnt = (const int*)(p.ws + O_CNT);
  int* fill = (int*)(p.ws + O_FILL); int* lists = (int*)(p.ws + O_LISTS);
  for (int task = bid; task < 1024; task += nb) {
    const int blk = task & 63, h = (task >> 6) & 7, b = task >> 9;
    const int base = (b * 8 + h) * 64;
    __syncthreads();
    if (tid < 3) { int a = 0; for (int j = 0; j < 64; ++j) { sBase[tid * 64 + j] = a; a += cnt[tid * 1024 + base + j]; } }
    __syncthreads();
    const int ts = blk * 256 + tid;
    const size_t t = (size_t)b * S_ + ts;
    for (int s = 0; s < 3; ++s) {
      const int j = sel[(t * 8 + h) * 3 + s];
      if (j >= 0) {
        const int pos = sBase[s * 64 + j] + atomicAdd(fill + s * 1024 + base + j, 1);
        lists[(size_t)s * (T_ * 8) + (size_t)(b * 8 + h) * S_ + pos] = ts;
      }
    }
  }
}
DI int t5_bucket(int d) {
  if (d < 16) return d;
  const int large = 16 + (int)(__logf((float)d * (1.f / 16.f)) / 4.1588830833596715f * 16.f);
  return large < 31 ? large : 31;
}
struct MobaLds { bf16_t* sK; bf16_t* sVT; float* sBias; };
DI void moba_block(const Params& p, const MobaLds& L, int b, int h, int tsq  , int kb  ,
                   int ntiles, bool causal, bool init) {
  const int tid = tidx(), lane = tid & 63, hh = lane >> 5, l31 = lane & 31;
  const bf16_t* Q = slab(p, 2); const bf16_t* Kx = slab(p, 4); const bf16_t* V = slab(p, 5);
  bf16_t* ACC = slab(p, 6);
  float* MM = (float*)(p.ws + O_MM); float* ML = (float*)(p.ws + O_ML);
  const bool valid = tsq >= 0;
  const size_t tq = (size_t)b * S_ + (valid ? tsq : 0);
  bf16x8 qf[8];
#pragma unroll
  for (int kk = 0; kk < 8; ++kk) {
    uint4 u = {0, 0, 0, 0};
    if (valid) u = *(const uint4*)(Q + tq * 1024 + h * 128 + kk * 16 + hh * 8);
    qf[kk] = __builtin_bit_cast(bf16x8, u);
  }
  float m = -1e30f, lsum = 0.f;
  f32x16 o[4];
#pragma unroll
  for (int dt = 0; dt < 4; ++dt)
#pragma unroll
    for (int i = 0; i < 16; ++i) o[dt][i] = 0.f;
  if (!init && valid) {
    m = MM[tq * 8 + h]; lsum = ML[tq * 8 + h];
#pragma unroll
    for (int dt = 0; dt < 4; ++dt)
#pragma unroll
      for (int g4 = 0; g4 < 4; ++g4) {
        const uint2 u = *(const uint2*)(ACC + tq * 1024 + h * 128 + dt * 32 + g4 * 8 + hh * 4);
        o[dt][g4 * 4 + 0] = lo16(u.x) * lsum; o[dt][g4 * 4 + 1] = hi16(u.x) * lsum;
        o[dt][g4 * 4 + 2] = lo16(u.y) * lsum; o[dt][g4 * 4 + 3] = hi16(u.y) * lsum;
      }
  }
  int wmaxq = valid ? tsq : -1;
  for (int of = 32; of > 0; of >>= 1) wmaxq = max(wmaxq, __shfl_xor(wmaxq, of));
  const float bias31 = L.sBias[1023];
  const float scale = 0.08838834764831845f;
  const size_t k0 = (size_t)b * S_ + (size_t)kb * 256;
  for (int kt = 0; kt < ntiles; ++kt) {
    __syncthreads();
#pragma unroll
    for (int j = 0; j < 4; ++j) {
      const int ci = tid + 256 * j, kr = ci >> 4, d8 = (ci & 15) * 8;
      const size_t go = (k0 + kt * 64 + kr) * 1024 + h * 128 + d8;
      *(uint4*)(L.sK + kr * 136 + d8) = *(const uint4*)(Kx + go);
      const uint4 u = *(const uint4*)(V + go);
#pragma unroll
      for (int e = 0; e < 8; ++e) L.sVT[(d8 + e) * 72 + kr] = get16(u, e);
    }
    __syncthreads();
    const int kpos0 = kb * 256 + kt * 64;
    if (causal && kpos0 > wmaxq) continue;
    f32x16 st[2];
#pragma unroll
    for (int t2 = 0; t2 < 2; ++t2)
#pragma unroll
      for (int i = 0; i < 16; ++i) st[t2][i] = 0.f;
#pragma unroll
    for (int kk = 0; kk < 8; ++kk)
#pragma unroll
      for (int t2 = 0; t2 < 2; ++t2) {
        const bf16x8 af = *(const bf16x8*)(L.sK + (t2 * 32 + l31) * 136 + kk * 16 + hh * 8);
        st[t2] = MFMA32(af, qf[kk], st[t2]);
      }
    float mloc = -1e30f;
#pragma unroll
    for (int t2 = 0; t2 < 2; ++t2)
#pragma unroll
      for (int i = 0; i < 16; ++i) {
        const int kp = kpos0 + t2 * 32 + crow(i, hh);
        const int dist = tsq - kp;
        float s;
        if (causal && dist < 0) s = -1e30f;
        else {
          const int dd = dist < 0 ? 0 : dist;
          s = st[t2][i] * scale + (dd < 1024 ? L.sBias[dd] : bias31);
        }
        st[t2][i] = s;
        mloc = fmaxf(mloc, s);
      }
    mloc = fmaxf(mloc, __shfl_xor(mloc, 32));
    const float mnew = fmaxf(m, mloc);
    const float alpha = __expf(m - mnew);
    float ls = 0.f;
#pragma unroll
    for (int t2 = 0; t2 < 2; ++t2)
#pragma unroll
      for (int i = 0; i < 16; ++i) {
        const float pv = st[t2][i] <= -1e29f ? 0.f : __expf(st[t2][i] - mnew);
        st[t2][i] = pv; ls += pv;
      }
    ls += __shfl_xor(ls, 32);
    lsum = lsum * alpha + ls;
    m = mnew;
#pragma unroll
    for (int dt = 0; dt < 4; ++dt)
#pragma unroll
      for (int i = 0; i < 16; ++i) o[dt][i] *= alpha;
#pragma unroll
    for (int t2 = 0; t2 < 2; ++t2)
#pragma unroll
      for (int s2 = 0; s2 < 2; ++s2) {
        uint4 pu;
        pu.x = pack2(st[t2][8 * s2 + 0], st[t2][8 * s2 + 1]); pu.y = pack2(st[t2][8 * s2 + 2], st[t2][8 * s2 + 3]);
        pu.z = pack2(st[t2][8 * s2 + 4], st[t2][8 * s2 + 5]); pu.w = pack2(st[t2][8 * s2 + 6], st[t2][8 * s2 + 7]);
        const bf16x8 pf = __builtin_bit_cast(bf16x8, pu);
#pragma unroll
        for (int dt = 0; dt < 4; ++dt) {
          const bf16_t* vp = L.sVT + (dt * 32 + l31) * 72 + t2 * 32 + s2 * 16 + hh * 4;
          uint4 vu; const uint2 a0 = *(const uint2*)vp, a1 = *(const uint2*)(vp + 8);
          vu.x = a0.x; vu.y = a0.y; vu.z = a1.x; vu.w = a1.y;
          o[dt] = MFMA32(__builtin_bit_cast(bf16x8, vu), pf, o[dt]);
        }
      }
  }
  if (valid) {
    const float inv = 1.f / lsum;
    if (hh == 0) { MM[tq * 8 + h] = m; ML[tq * 8 + h] = lsum; }
#pragma unroll
    for (int dt = 0; dt < 4; ++dt)
#pragma unroll
      for (int g4 = 0; g4 < 4; ++g4) {
        uint2 u; u.x = pack2(o[dt][g4 * 4] * inv, o[dt][g4 * 4 + 1] * inv); u.y = pack2(o[dt][g4 * 4 + 2] * inv, o[dt][g4 * 4 + 3] * inv);
        *(uint2*)(ACC + tq * 1024 + h * 128 + dt * 32 + g4 * 8 + hh * 4) = u;
      }
  }
}
DI void moba_bias_table(const Params& p, float* sBias, int h) {
  for (int d = tidx(); d < 1024; d += 256) sBias[d] = p.in[I_RELB][t5_bucket(d) * 8 + h];
}
DI void phase_moba_own(const Params& p, int bid, int nb, char* smem) {
  MobaLds L; L.sK = (bf16_t*)smem; L.sVT = L.sK + 64 * 136; L.sBias = (float*)(L.sVT + 128 * 72);
  const int tid = tidx(), lane = tid & 63, wave = tid >> 6;
  for (int task = bid; task < 2048; task += nb) {
    const int qt = task & 1, blk = (task >> 1) & 63, h = (task >> 7) & 7, b = task >> 10;
    __syncthreads();
    moba_bias_table(p, L.sBias, h);
    __syncthreads();
    const int tsq = blk * 256 + qt * 128 + wave * 32 + (lane & 31);
    moba_block(p, L, b, h, tsq, blk, 2 * (qt + 1), true, true);
  }
}
DI void phase_moba_past(const Params& p, int s, int bid, int nb, char* smem) {
  MobaLds L; L.sK = (bf16_t*)smem; L.sVT = L.sK + 64 * 136; L.sBias = (float*)(L.sVT + 128 * 72);
  int* sTb = (int*)(L.sBias + 1024);
  const int tid = tidx(), lane = tid & 63, wave = tid >> 6;
  const int* cnt = (const int*)(p.ws + O_CNT) + s * 1024;
  const int* lists = (const int*)(p.ws + O_LISTS) + (size_t)s * (T_ * 8);
  __syncthreads();
  if (tid < 16) { int a = 0; for (int j = 0; j < 64; ++j) { sTb[tid * 64 + j] = a; a += (cnt[tid * 64 + j] + 127) >> 7; } sTb[1040 + tid] = a; }
  __syncthreads();
  if (tid == 0) { int a = 0; for (int i = 0; i < 16; ++i) { const int c = sTb[1040 + i]; sTb[1040 + i] = a; a += c; } sTb[1056] = a; }
  __syncthreads();
  const int total = sTb[1056];
  for (int task = bid; task < total; task += nb) {
    int gi = 0;
    for (int i = 1; i < 16; ++i) if (sTb[1040 + i] <= task) gi = i;
    const int loc = task - sTb[1040 + gi];
    int j = 0;
    for (int i = 1; i < 64; ++i) if (sTb[gi * 64 + i] <= loc) j = i;
    while (j > 0 && ((cnt[gi * 64 + j] + 127) >> 7) == 0) --j;
    const int tile = loc - sTb[gi * 64 + j];
    const int b = gi >> 3, h = gi & 7;
    __syncthreads();
    moba_bias_table(p, L.sBias, h);
    __syncthreads();
    int lbase = 0;
    for (int i = 0; i < j; ++i) lbase += cnt[gi * 64 + i];
    const int n = cnt[gi * 64 + j];
    const int qi = tile * 128 + wave * 32 + (lane & 31);
    const int tsq = qi < n ? lists[(size_t)gi * S_ + lbase + qi] : -1;
    moba_block(p, L, b, h, tsq, j, 4, false, false);
  }
}

DI void phase_merge(const Params& p, int l, int bid, int nb, char* smem) {
  bf16_t* sA = (bf16_t*)smem; bf16_t* sB = sA + 128 * LDT;
  bf16_t* stash = sB + 128 * LDT;
  const int tid = tidx();
  const bf16_t* h = slab(p, 0);
  const bf16_t* wg = (const bf16_t*)(p.ws + O_WGATE); const bf16_t* pt = (const bf16_t*)(p.ws + O_PT);
  const float* bg = p.in[I_BGATE] + l * 3072;
  bf16_t* mg = slab(p, 2);
  for (int t = bid; t < 512 * 8; t += nb) {
    const int tm = t >> 3, tn = t & 7;
    f32x16 accm[1][2]; acc_zero<1>(accm);
    for (int br = 0; br < 3; ++br) {
      if ((SKIP_BR >> br) & 1) continue;
      const bf16_t* yb = slab(p, br == 0 ? 1 : (br == 1 ? 6 : 3));
      f32x16 acc[1][2]; acc_zero<1>(acc);
      gemm_core<1>(h + (size_t)tm * 64 * 1024, 1024, wg + (size_t)(br * 1024 + tn * 128) * 1024, 1024, 1024, sA, sB, acc);
      {
        const float* bgp = bg + br * 1024 + tn * 128;
        ACC_FOREACH(1, acc, { stash[((mi * 2 + ni) * 16 + i) * 256 + tid] = f2bf(sigmoidf_(v + bgp[c])); })
      }
      acc_zero<1>(acc);
      gemm_core<1>(yb + (size_t)tm * 64 * 1024, 1024, pt + (size_t)(br * 1024 + tn * 128) * 1024, 1024, 1024, sA, sB, acc);
      ACC_FOREACH(1, acc, { accm[mi][ni][i] += bf2f(stash[((mi * 2 + ni) * 16 + i) * 256 + tid]) * v; })
    }
    bf16_t* d = mg + (size_t)tm * 64 * 1024 + tn * 128;
    ACC_FOREACH(1, accm, { d[(size_t)r * 1024 + c] = f2bf(v); })
  }
}
DI void phase_wout(const Params& p, int l, int bid, int nb, char* smem) {
  bf16_t* sA = (bf16_t*)smem; bf16_t* sB = sA + 128 * LDT;
  const bf16_t* mg = slab(p, 2); const bf16_t* wo = (const bf16_t*)(p.ws + O_WOUT);
  const float* xin = l == 0 ? p.in[I_X] : p.out;
  for (int t = bid; t < 256 * 8; t += nb) {
    const int tm = t >> 3, tn = t & 7;
    f32x16 acc[2][2]; acc_zero<2>(acc);
    gemm_core<2>(mg + (size_t)tm * 128 * 1024, 1024, wo + (size_t)tn * 128 * 1024, 1024, 1024, sA, sB, acc);
    const size_t o0 = (size_t)tm * 128 * 1024 + tn * 128;
    ACC_FOREACH(2, acc, { const size_t o = o0 + (size_t)r * 1024 + c; p.out[o] = xin[o] + v; })
  }
}

DI void phase_peer_prep(const Params& p, int l, int bid, int nb) {
  rmsnorm_phase(p.out, p.in[I_N2G] + l * 1024, slab(p, 0), bid, nb);
  conv_plain(p.in[I_U] + (size_t)l * 16777216, slab(p, 1), 16777216, bid, nb);
  conv_plain(p.in[I_V] + (size_t)l * 16777216, slab(p, 1) + 16777216, 16777216, bid, nb);
}
DI void phase_peer_q(const Params& p, int bid, int nb, char* smem) {
  bf16_t* sA = (bf16_t*)smem; bf16_t* sB = sA + 128 * LDT;
  const bf16_t* h2 = slab(p, 0); const bf16_t* wq = (const bf16_t*)(p.ws + O_WQ);
  bf16_t* q = slab(p, 2);
  for (int t = bid; t < 256 * 16; t += nb) {
    const int tm = t >> 4, tn = t & 15;
    f32x16 acc[2][2]; acc_zero<2>(acc);
    gemm_core<2>(h2 + (size_t)tm * 128 * 1024, 1024, wq + (size_t)tn * 128 * 1024, 1024, 1024, sA, sB, acc);
    bf16_t* d = q + (size_t)tm * 128 * 2048 + tn * 128;
    ACC_FOREACH(2, acc, { d[(size_t)r * 2048 + c] = f2bf(v); })
  }
}
DI unsigned fkey(float f) { unsigned u = __float_as_uint(f); return (u & 0x80000000u) ? ~u : (u | 0x80000000u); }
DI void phase_peer_topk(const Params& p, int bid, int nb, char* smem) {
  bf16_t* sQ = (bf16_t*)smem;
  float* sS = (float*)smem;
  float* wsc = (float*)(smem + 66560);
  const int tid = tidx(), lane = tid & 63, wave = tid >> 6, wm = wave >> 1, wn = wave & 1, hh = lane >> 5, l31 = lane & 31;
  const bf16_t* q = slab(p, 2);
  const bf16_t* kb = (const bf16_t*)(p.ws + (wn == 0 ? O_K1 : O_K2));
  int* idx_out = (int*)slab(p, 4); float* gate_out = (float*)slab(p, 5);
  float* tv = wsc + wave * 128; int* ti = (int*)(tv + 32); float* fv = tv + 64; int* fi = (int*)(tv + 80);
  const unsigned long long ltmask = (1ull << lane) - 1ull;
  for (int task = bid; task < 4096; task += nb) {
    const int hd = task & 7, tt = task >> 3;
    const size_t t0 = (size_t)tt * 64;
    __syncthreads();
#pragma unroll
    for (int j = 0; j < 8; ++j) {
      const int ci = tid + 256 * j, r = ci >> 5, c8 = (ci & 31) * 8;
      *(uint4*)(sQ + r * 264 + c8) = *(const uint4*)(q + (t0 + r) * 2048 + hd * 256 + c8);
    }
    __syncthreads();
    f32x16 acc[4];
#pragma unroll
    for (int ni = 0; ni < 4; ++ni)
#pragma unroll
      for (int i = 0; i < 16; ++i) acc[ni][i] = 0.f;
#pragma unroll
    for (int kk = 0; kk < 8; ++kk) {
      const bf16x8 af = *(const bf16x8*)(sQ + (wm * 32 + l31) * 264 + wn * 128 + kk * 16 + hh * 8);
#pragma unroll
      for (int ni = 0; ni < 4; ++ni) {
        const bf16x8 bf = *(const bf16x8*)(kb + (size_t)(ni * 32 + l31) * 128 + kk * 16 + hh * 8);
        acc[ni] = MFMA32(af, bf, acc[ni]);
      }
    }
    __syncthreads();
#pragma unroll
    for (int ni = 0; ni < 4; ++ni)
#pragma unroll
      for (int i = 0; i < 16; ++i) sS[(wm * 32 + crow(i, hh)) * 260 + wn * 128 + ni * 32 + l31] = acc[ni][i];
    __syncthreads();
    for (int tk = 0; tk < 16; ++tk) {
      const int r = wave * 16 + tk;
#pragma unroll
      for (int side = 0; side < 2; ++side) {
        const float a0 = sS[r * 260 + side * 128 + lane], a1 = sS[r * 260 + side * 128 + 64 + lane];
        const unsigned k0 = fkey(a0), k1 = fkey(a1);
        unsigned thr = 0;
        for (int bit = 31; bit >= 0; --bit) {
          const unsigned cand = thr | (1u << bit);
          const int c = __popcll(__ballot(k0 >= cand)) + __popcll(__ballot(k1 >= cand));
          if (c >= 16) thr = cand;
          if (c == 16) break;
        }
        const unsigned long long b0 = __ballot(k0 >= thr), b1 = __ballot(k1 >= thr);
        const int p0 = __popcll(b0 & ltmask), p1 = __popcll(b0) + __popcll(b1 & ltmask);
        if (k0 >= thr && p0 < 16) { tv[side * 16 + p0] = a0; ti[side * 16 + p0] = lane; }
        if (k1 >= thr && p1 < 16) { tv[side * 16 + p1] = a1; ti[side * 16 + p1] = lane + 64; }
      }
      __syncthreads();
      float cv[4]; unsigned ck[4];
#pragma unroll
      for (int q4 = 0; q4 < 4; ++q4) { const int c = lane + 64 * q4; cv[q4] = tv[c >> 4] + tv[16 + (c & 15)]; ck[q4] = fkey(cv[q4]); }
      unsigned thr = 0;
      for (int bit = 31; bit >= 0; --bit) {
        const unsigned cand = thr | (1u << bit);
        const int c = __popcll(__ballot(ck[0] >= cand)) + __popcll(__ballot(ck[1] >= cand)) + __popcll(__ballot(ck[2] >= cand)) + __popcll(__ballot(ck[3] >= cand));
        if (c >= 16) thr = cand;
        if (c == 16) break;
      }
      int basep = 0;
#pragma unroll
      for (int q4 = 0; q4 < 4; ++q4) {
        const unsigned long long bb = __ballot(ck[q4] >= thr);
        const int pos = basep + __popcll(bb & ltmask);
        if (ck[q4] >= thr && pos < 16) { const int c = lane + 64 * q4; fv[pos] = cv[q4]; fi[pos] = ti[c >> 4] * 128 + ti[16 + (c & 15)]; }
        basep += __popcll(bb);
      }
      __syncthreads();
      if (lane < 16) {
        float mx = -3e38f;
#pragma unroll
        for (int e = 0; e < 16; ++e) mx = fmaxf(mx, fv[e]);
        float sm = 0.f;
#pragma unroll
        for (int e = 0; e < 16; ++e) sm += __expf(fv[e] - mx);
        const size_t o = ((t0 + r) * 8 + hd) * 16 + lane;
        idx_out[o] = fi[lane];
        gate_out[o] = __expf(fv[lane] - mx) / sm;
      }
      __syncthreads();
    }
  }
}
DI void phase_peer_gather(const Params& p, int bid, int nb, char* smem) {
  const int tid = tidx(), lane = tid & 63, wave = tid >> 6;
  bf16_t* sH = (bf16_t*)(smem + wave * 3072);
  int* sIdx = (int*)(smem + wave * 3072 + 2048);
  float* sCoef = (float*)(smem + wave * 3072 + 2560);
  const bf16_t* h2 = slab(p, 0);
  const bf16_t* ub = slab(p, 1); const bf16_t* vb = slab(p, 1) + 16777216;
  const int* idx = (const int*)slab(p, 4); const float* gate = (const float*)slab(p, 5);
  for (int t = bid * 4 + wave; t < T_; t += nb * 4) {
    *(uint4*)(sH + lane * 8) = *(const uint4*)(h2 + (size_t)t * 1024 + lane * 8);
    *(uint4*)(sH + 512 + lane * 8) = *(const uint4*)(h2 + (size_t)t * 1024 + 512 + lane * 8);
    sIdx[lane] = idx[(size_t)t * 128 + lane]; sIdx[lane + 64] = idx[(size_t)t * 128 + 64 + lane];
    __builtin_amdgcn_fence(__ATOMIC_RELEASE, "wavefront"); __builtin_amdgcn_wave_barrier(); __builtin_amdgcn_fence(__ATOMIC_ACQUIRE, "wavefront");
    for (int g = 0; g < 8; ++g) {
      const int e = g * 16 + (lane & 15);
      const bf16_t* urow = ub + (size_t)sIdx[e] * 1024 + (lane >> 4) * 8;
      f32x4 acc = {0.f, 0.f, 0.f, 0.f};
#pragma unroll 8
      for (int kk = 0; kk < 32; ++kk) {
        const bf16x8 af = *(const bf16x8*)(urow + kk * 32);
        const bf16x8 bf = *(const bf16x8*)(sH + kk * 32 + (lane >> 4) * 8);
        acc = MFMA16(af, bf, acc);
      }
      if ((lane & 15) == 0) {
#pragma unroll
        for (int i = 0; i < 4; ++i) {
          const int ee = g * 16 + (lane >> 4) * 4 + i;
          const float a = acc[i];
          const float ge = 0.5f * a * (1.f + erff(a * 0.7071067811865476f));
          sCoef[ee] = gate[(size_t)t * 128 + ee] * ge;
        }
      }
    }
    __builtin_amdgcn_fence(__ATOMIC_RELEASE, "wavefront"); __builtin_amdgcn_wave_barrier(); __builtin_amdgcn_fence(__ATOMIC_ACQUIRE, "wavefront");
    float o[16];
#pragma unroll
    for (int i = 0; i < 16; ++i) o[i] = 0.f;
#pragma unroll 4
    for (int e = 0; e < 128; ++e) {
      const float c = sCoef[e];
      const bf16_t* vrow = vb + (size_t)sIdx[e] * 1024;
      float f[8];
      unpack8(*(const uint4*)(vrow + lane * 8), f);
#pragma unroll
      for (int i = 0; i < 8; ++i) o[i] += c * f[i];
      unpack8(*(const uint4*)(vrow + 512 + lane * 8), f);
#pragma unroll
      for (int i = 0; i < 8; ++i) o[8 + i] += c * f[i];
    }
    float4* xo = (float4*)(p.out + (size_t)t * 1024 + lane * 8);
    float4 a = xo[0], bq = xo[1];
    a.x += o[0]; a.y += o[1]; a.z += o[2]; a.w += o[3]; bq.x += o[4]; bq.y += o[5]; bq.z += o[6]; bq.w += o[7];
    xo[0] = a; xo[1] = bq;
    float4* xo2 = (float4*)(p.out + (size_t)t * 1024 + 512 + lane * 8);
    a = xo2[0]; bq = xo2[1];
    a.x += o[8]; a.y += o[9]; a.z += o[10]; a.w += o[11]; bq.x += o[12]; bq.y += o[13]; bq.z += o[14]; bq.w += o[15];
    xo2[0] = a; xo2[1] = bq;
    __builtin_amdgcn_fence(__ATOMIC_RELEASE, "wavefront"); __builtin_amdgcn_wave_barrier(); __builtin_amdgcn_fence(__ATOMIC_ACQUIRE, "wavefront");
  }
}

constexpr int NPH = 26;
DI void run_phase(const Params& p, int l, int ph, int bid, int nb, char* smem) {
#ifdef ONLY_PH
  ph = ONLY_PH;
#endif
  switch (ph) {
    case 0: phase_prep(p, l, bid, nb, smem); break;
    case 1: {
      Route rt; rt.seg0 = 6; rt.packed = 4 | (5 << 4) | (6 << 8);
      gemm_in_phase(p, l, rt, 26, 48, 26, 0, bid, nb, smem);
    } break;
    case 2: phase_lora_prep(p, l, bid, nb); break;
    case 3: phase_lora_wa(p, l, bid, nb, smem); break;
    case 4: phase_rwkv_scan(p, l, bid, nb, smem); break;
    case 5: phase_rwkv_ln(p, l, bid, nb); break;
    case 6: phase_rwkv_g(p, l, bid, nb, smem); break;
    case 7: {
      Route rt; rt.seg0 = 0; rt.packed = 1 | (2 << 4) | (4 << 8);
      gemm_in_phase(p, l, rt, 25, 0, 24, 74, bid, nb, smem);
    } break;
    case 8: phase_ssd_conv(p, l, bid, nb); break;
    case 9: phase_ssd_states(p, l, bid, nb, smem); break;
    case 10: phase_ssd_scan(p, bid, nb); break;
    case 11: phase_ssd_out(p, l, bid, nb, smem); break;
    case 12: {
      Route rt; rt.seg0 = 3; rt.packed = 2 | (4 << 4) | (5 << 8);
      gemm_in_phase(p, l, rt, 24, 24, 24, 0, bid, nb, smem);
    } break;
    case 13: phase_moba_norm(p, l, bid, nb, smem); break;
    case 14: phase_moba_gate(p, bid, nb, smem); break;
    case 15: phase_moba_fill(p, bid, nb, smem); break;
    case 16: phase_moba_own(p, bid, nb, smem); break;
    case 17: phase_moba_past(p, 0, bid, nb, smem); break;
    case 18: phase_moba_past(p, 1, bid, nb, smem); break;
    case 19: phase_moba_past(p, 2, bid, nb, smem); break;
    case 20: phase_merge(p, l, bid, nb, smem); break;
    case 21: phase_wout(p, l, bid, nb, smem); break;
    case 22: phase_peer_prep(p, l, bid, nb); break;
    case 23: phase_peer_q(p, bid, nb, smem); break;
    case 24: phase_peer_topk(p, bid, nb, smem); break;
    case 25: phase_peer_gather(p, bid, nb, smem); break;
  }
}

#if !MULTI
__global__ void __launch_bounds__(256, 2) mega(Params p) {
  __shared__ __attribute__((aligned(16))) char smem[LDS_BYTES];
  cg::grid_group grid = cg::this_grid();
  for (int it = 0; it < 2 * NPH; ++it) {
    int itv = it; asm volatile("" : "+v"(itv));
    const int its = __builtin_amdgcn_readfirstlane(itv);
    const int l = its / NPH, ph = its % NPH;
    int bv = blockIdx.x, nv = gridDim.x; asm volatile("" : "+v"(bv), "+v"(nv));
    run_phase(p, l, ph, __builtin_amdgcn_readfirstlane(bv), __builtin_amdgcn_readfirstlane(nv), smem);
    grid.sync();
  }
}
#else
__global__ void __launch_bounds__(256, 2) phase_kernel(Params p, int l, int ph) {
  __shared__ __attribute__((aligned(16))) char smem[LDS_BYTES];
  run_phase(p, l, ph, blockIdx.x, gridDim.x, smem);
}
#endif


#if DBG
DI int dbg_tok(int i) { return i == 0 ? 3 : (i == 1 ? 130 : (i == 2 ? 300 : 16384 + 511)); }
__global__ void __launch_bounds__(256) dbgA_kernel(Params p) {
  const int tid = tidx();
  for (size_t i = (size_t)blockIdx.x * 256 + tid; i < (size_t)T_ * 1024; i += (size_t)gridDim.x * 256) p.out[i] = p.in[I_X][i];
  if (blockIdx.x < 4) {
    const int t = dbg_tok(blockIdx.x);
    bf16_t* d = (bf16_t*)(p.ws + O_LISTS);
    for (int c = tid; c < 1024; c += 256) d[blockIdx.x * 1024 + c] = slab(p, 1)[(size_t)t * 1024 + c];
  }
}
__global__ void __launch_bounds__(256) dbgB_kernel(Params p, int l) {
  __shared__ float sred[256];
  const int tid = tidx();
  const int ti = blockIdx.x >> 2, g = blockIdx.x & 3;
  const int t = dbg_tok(ti), b = t >> 14, ts = t & (S_ - 1);
  const bf16_t* xs = slab(p, 5) + (size_t)b * S_ * 1024; const bf16_t* bc = slab(p, 6) + (size_t)b * S_ * 1024;
  const float* dt = (const float*)(p.ws + O_DT) + (size_t)b * S_ * 16;
  const bf16_t* zsave = (const bf16_t*)(p.ws + O_LISTS);
  const int ch = g * 256 + tid, head = ch >> 6;
  const float a = -__expf(p.in[I_ALOG][l * 16 + head]);
  float y = 0.f;
  for (int n = 0; n < (SSD_PROBE == 1 ? 0 : 128); ++n) {
    float h = 0.f;
    for (int s = 0; s <= ts; ++s) {
      const float d = dt[(size_t)s * 16 + head];
      h = h * __expf(d * a) + d * bf2f(bc[(size_t)s * 1024 + g * 128 + n]) * bf2f(xs[(size_t)s * 1024 + ch]);
    }
    y += bf2f(bc[(size_t)ts * 1024 + 512 + g * 128 + n]) * h;
  }
  y += p.in[I_DSKIP][l * 16 + head] * bf2f(xs[(size_t)ts * 1024 + ch]);
  y *= siluf_(bf2f(zsave[ti * 1024 + ch]));
  sred[tid] = y * y;
  __syncthreads();
  for (int o = 128; o > 0; o >>= 1) { if (tid < o) sred[tid] += sred[tid + o]; __syncthreads(); }
  const float rs = rsqrtf(sred[0] * (1.f / 256.f) + 1e-6f);
  __syncthreads();
  const float ref = DBG == 2 ? y : y * rs * p.in[I_SSDNG][l * 1024 + ch];
  const float mine = bf2f(slab(p, 1)[(size_t)t * 1024 + ch]);
  sred[tid] = fabsf(mine - ref);
  __syncthreads();
  for (int o = 128; o > 0; o >>= 1) { if (tid < o) sred[tid] = fmaxf(sred[tid], sred[tid + o]); __syncthreads(); }
  if (tid == 0) p.out[blockIdx.x] = 1000.f * sred[0] + 100.f;
}
#endif

#if DBG
__global__ void __launch_bounds__(256) dbgS_kernel(Params p, int l) {
  for (size_t i = (size_t)blockIdx.x * 256 + tidx(); i < (size_t)T_ * 1024; i += (size_t)gridDim.x * 256) {
    const int ch = (int)(i & 1023), head = ch >> 6;
    const float xv = bf2f(slab(p, 5)[i]);
    const float zv = bf2f(slab(p, 1)[i]);
    slab(p, 1)[i] = f2bf(xv * p.in[I_DSKIP][l * 16 + head] * siluf_(zv));
  }
}
#endif

extern "C" void kernel_launch(void* const* d_in, const int* in_sizes, int n_in, void* d_out, int out_size, void* d_ws, size_t ws_size,
                              hipStream_t stream) {
  Params p{};
  for (int i = 0; i < 35; ++i) p.in[i] = (const float*)d_in[i];
  p.out = (float*)d_out;
  p.ws = (char*)d_ws;
  if (ws_size < WS_END) { fprintf(stderr, "workspace too small\n"); return; }
#if MULTI
#if DBG
  for (int ph = 0; ph < 11; ++ph) hipLaunchKernelGGL(phase_kernel, dim3(512), dim3(256), 0, stream, p, 0, ph);
  hipLaunchKernelGGL(dbgA_kernel, dim3(512), dim3(256), 0, stream, p);
  hipLaunchKernelGGL(dbgS_kernel, dim3(512), dim3(256), 0, stream, p, 0);
  hipLaunchKernelGGL(dbgB_kernel, dim3(16), dim3(256), 0, stream, p, 0);
#else
  for (int l = 0; l < NLAYERS; ++l)
    for (int ph = 0; ph < (SKIP_PEER ? 22 : NPH); ++ph) hipLaunchKernelGGL(phase_kernel, dim3(512), dim3(256), 0, stream, p, l, ph);
#endif
#else
  static int grid_blocks = 0;
  if (!grid_blocks) {
    int dev = 0, cus = 0, per_cu = 0;
    (void)hipGetDevice(&dev);
    (void)hipDeviceGetAttribute(&cus, hipDeviceAttributeMultiprocessorCount, dev);
    (void)hipOccupancyMaxActiveBlocksPerMultiprocessor(&per_cu, mega, 256, 0);
    if (per_cu > 2) per_cu = 2;
    grid_blocks = cus * per_cu;
  }
  void* args[] = {&p};
  hipError_t e = hipLaunchCooperativeKernel((void*)mega, dim3(grid_blocks), dim3(256), args, 0, stream);
  if (e != hipSuccess) fprintf(stderr, "coop launch failed: %s (grid %d)\n", hipGetErrorString(e), grid_blocks);
#endif
}
```

```cpp
#include <hip/hip_runtime.h>
#include <hip/hip_cooperative_groups.h>
#include <cstdio>
#include <cstdint>
namespace cg = cooperative_groups;
#define DI __device__ __forceinline__
#ifndef MULTI
#define MULTI 0
#endif
#ifndef SKIP_BR
#define SKIP_BR 0
#endif
#ifndef SKIP_PEER
#define SKIP_PEER 0
#ifndef DBG
#define DBG 0
#endif
#ifndef SSD_PROBE
#define SSD_PROBE 0
#endif
#endif
#ifndef NLAYERS
#define NLAYERS 2
#endif

typedef unsigned short bf16_t;
typedef __attribute__((ext_vector_type(8))) short bf16x8;
typedef __attribute__((ext_vector_type(16))) float f32x16;
typedef __attribute__((ext_vector_type(4))) float f32x4;
typedef __attribute__((ext_vector_type(4))) unsigned u32x4;
#define MFMA32(a, b, c) __builtin_amdgcn_mfma_f32_32x32x16_bf16((a), (b), (c), 0, 0, 0)
#define MFMA16(a, b, c) __builtin_amdgcn_mfma_f32_16x16x32_bf16((a), (b), (c), 0, 0, 0)

constexpr int T_ = 32768, S_ = 16384;
constexpr size_t SLAB = 67108864;
constexpr int LDS_BYTES = 73728;

struct Params { const float* in[35]; float* out; char* ws; };

enum { I_X = 0, I_RELB, I_N1G, I_WIN, I_CONVW, I_CONVB, I_DTB, I_ALOG, I_DSKIP, I_SSDNG, I_QNG, I_KNG, I_MU, I_W0, I_WW2, I_A0,
       I_WA2, I_WG2, I_KK, I_KA, I_RK, I_LNG, I_LNB, I_PSSD, I_PMOBA, I_PRWKV, I_WGATE, I_BGATE, I_WOUT, I_N2G, I_WQ, I_K1, I_K2, I_U, I_V };

constexpr size_t OFF_W = 7 * SLAB;
constexpr size_t O_WIN = OFF_W;
constexpr size_t O_WGATE = O_WIN + 19660800;
constexpr size_t O_PT = O_WGATE + 6291456;
constexpr size_t O_WOUT = O_PT + 6291456;
constexpr size_t O_WQ = O_WOUT + 2097152;
constexpr size_t O_WW2 = O_WQ + 4194304;
constexpr size_t O_WA2 = O_WW2 + 131072;
constexpr size_t O_WG2 = O_WA2 + 131072;
constexpr size_t O_K1 = O_WG2 + 262144;
constexpr size_t O_K2 = O_K1 + 32768;
constexpr size_t OFF_X = O_K2 + 32768;
constexpr size_t O_DT = OFF_X;
constexpr size_t O_LACT = O_DT + 2097152;
constexpr size_t O_RB = O_LACT + 16777216;
constexpr size_t O_CDEC = O_RB + 2097152;
constexpr size_t O_KMEAN = O_CDEC + 16384;
constexpr size_t O_MM = O_KMEAN + 524288;
constexpr size_t O_ML = O_MM + 1048576;
constexpr size_t O_SEL = O_ML + 1048576;
constexpr size_t O_CNT = O_SEL + 3145728;
constexpr size_t O_FILL = O_CNT + 12288;
constexpr size_t O_LISTS = O_FILL + 12288;
constexpr size_t O_BAR = O_LISTS + 3145728;
constexpr size_t WS_END = O_BAR + 16384;

DI bf16_t* slab(const Params& p, int i) { return (bf16_t*)(p.ws + (size_t)i * SLAB); }

DI bf16_t f2bf(float x) { unsigned u = __float_as_uint(x); u += 0x7fffu + ((u >> 16) & 1u); return (bf16_t)(u >> 16); }
DI float bf2f(bf16_t b) { return __uint_as_float(((unsigned)b) << 16); }
DI unsigned pack2(float a, float b) { return (unsigned)f2bf(a) | ((unsigned)f2bf(b) << 16); }
DI float lo16(unsigned u) { return __uint_as_float(u << 16); }
DI float hi16(unsigned u) { return __uint_as_float(u & 0xffff0000u); }
DI bf16_t get16(const uint4& v, int e) { const unsigned w = (e >> 1) == 0 ? v.x : ((e >> 1) == 1 ? v.y : ((e >> 1) == 2 ? v.z : v.w)); return (bf16_t)((e & 1) ? (w >> 16) : (w & 0xffffu)); }
DI void unpack8(const uint4& v, float* f) {
  f[0] = lo16(v.x); f[1] = hi16(v.x); f[2] = lo16(v.y); f[3] = hi16(v.y);
  f[4] = lo16(v.z); f[5] = hi16(v.z); f[6] = lo16(v.w); f[7] = hi16(v.w);
}
DI uint4 pack8(const float* f) { uint4 v; v.x = pack2(f[0], f[1]); v.y = pack2(f[2], f[3]); v.z = pack2(f[4], f[5]); v.w = pack2(f[6], f[7]); return v; }
DI float sigmoidf_(float x) { return 1.f / (1.f + __expf(-x)); }
DI float softplusf_(float x) { return fmaxf(x, 0.f) + log1pf(__expf(-fabsf(x))); }
DI float siluf_(float x) { return x / (1.f + __expf(-x)); }
DI float wave_sum(float v) { for (int o = 32; o > 0; o >>= 1) v += __shfl_xor(v, o); return v; }
template <int CTRL> DI float dpp_add(float x) {
  int y = __builtin_amdgcn_update_dpp(0, __float_as_int(x), CTRL, 0xf, 0xf, true);
  return x + __int_as_float(y);
}
DI float red8(float x) { x = dpp_add<0xB1>(x); x = dpp_add<0x4E>(x); x = dpp_add<0x141>(x); return x; }
DI float red16(float x) { x = red8(x); x = dpp_add<0x140>(x); return x; }
DI int tidx() { int t = __builtin_amdgcn_workitem_id_x(); asm volatile("" : "+v"(t)); return t; }
DI int crow(int i, int h) { return (i & 3) + 8 * (i >> 2) + 4 * h; }

constexpr int LDT = 72;
template <int MI>
DI void gemm_core(const bf16_t* __restrict__ A, int lda, const bf16_t* __restrict__ Bt, int ldb, int K,
                  bf16_t* sA, bf16_t* sB, f32x16 (&acc)[MI][2]) {
  const int tid = tidx(), lane = tid & 63, wave = tid >> 6, wm = wave >> 1, wn = wave & 1;
  u32x4 ra[2 * MI], rb[4];
#pragma unroll
  for (int j = 0; j < 2 * MI; ++j) { const int c = tid + 256 * j; ra[j] = *(const u32x4*)(A + (size_t)(c >> 3) * lda + (c & 7) * 8); }
#pragma unroll
  for (int j = 0; j < 4; ++j) { const int c = tid + 256 * j; rb[j] = *(const u32x4*)(Bt + (size_t)(c >> 3) * ldb + (c & 7) * 8); }
  for (int k0 = 0; k0 < K; k0 += 64) {
#pragma unroll
    for (int j = 0; j < 2 * MI; ++j) { const int c = tid + 256 * j; *(u32x4*)(sA + (c >> 3) * LDT + (c & 7) * 8) = ra[j]; }
#pragma unroll
    for (int j = 0; j < 4; ++j) { const int c = tid + 256 * j; *(u32x4*)(sB + (c >> 3) * LDT + (c & 7) * 8) = rb[j]; }
    __syncthreads();
    const int kn = (k0 + 64 < K) ? k0 + 64 : k0;
#pragma unroll
    for (int j = 0; j < 2 * MI; ++j) { const int c = tid + 256 * j; ra[j] = *(const u32x4*)(A + (size_t)(c >> 3) * lda + kn + (c & 7) * 8); }
#pragma unroll
    for (int j = 0; j < 4; ++j) { const int c = tid + 256 * j; rb[j] = *(const u32x4*)(Bt + (size_t)(c >> 3) * ldb + kn + (c & 7) * 8); }
#pragma unroll
    for (int kk = 0; kk < 4; ++kk) {
      bf16x8 af[MI], bfr[2];
#pragma unroll
      for (int mi = 0; mi < MI; ++mi) af[mi] = *(const bf16x8*)(sA + (wm * 32 * MI + mi * 32 + (lane & 31)) * LDT + kk * 16 + (lane >> 5) * 8);
#pragma unroll
      for (int ni = 0; ni < 2; ++ni) bfr[ni] = *(const bf16x8*)(sB + (wn * 64 + ni * 32 + (lane & 31)) * LDT + kk * 16 + (lane >> 5) * 8);
#pragma unroll
      for (int mi = 0; mi < MI; ++mi)
#pragma unroll
        for (int ni = 0; ni < 2; ++ni) acc[mi][ni] = MFMA32(af[mi], bfr[ni], acc[mi][ni]);
    }
    __syncthreads();
  }
}
template <int MI> DI void acc_zero(f32x16 (&acc)[MI][2]) {
#pragma unroll
  for (int mi = 0; mi < MI; ++mi)
#pragma unroll
    for (int ni = 0; ni < 2; ++ni)
#pragma unroll
      for (int i = 0; i < 16; ++i) acc[mi][ni][i] = 0.f;
}
#define ACC_FOREACH(MI, acc, BODY)                                                        \
  {                                                                                       \
    int lane_ = tidx() & 63; asm volatile("" : "+v"(lane_));                        \
    const int wave_ = tidx() >> 6, wm_ = wave_ >> 1, wn_ = wave_ & 1;                \
    _Pragma("unroll") for (int mi = 0; mi < MI; ++mi)                                     \
    _Pragma("unroll") for (int ni = 0; ni < 2; ++ni)                                      \
    _Pragma("unroll") for (int i = 0; i < 16; ++i) {                                      \
      const int r = wm_ * 32 * MI + mi * 32 + crow(i, lane_ >> 5);                        \
      const int c = wn_ * 64 + ni * 32 + (lane_ & 31);                                    \
      const float v = acc[mi][ni][i];                                                       \
      BODY                                                                                \
    }                                                                                     \
  }

DI void tconv_job(const float* __restrict__ src, int ld, int K, int c0, int ncols, bf16_t* __restrict__ dst, int bid, int nb, float* sT) {
  const int ntn = (ncols + 63) >> 6, ntk = K >> 6, tid = tidx();
  for (int t = bid; t < ntn * ntk; t += nb) {
    const int tk = t % ntk, tn = t / ntk;
    const int kr = tid >> 4, nx = (tid & 15) * 4;
#pragma unroll
    for (int j = 0; j < 4; ++j) {
      const int k = kr + 16 * j;
      const float* s = src + (size_t)(tk * 64 + k) * ld + c0 + tn * 64 + nx;
      float4 v;
      if (tn * 64 + nx + 3 < ncols) v = *(const float4*)s;
      else { v.x = (tn * 64 + nx < ncols) ? s[0] : 0.f; v.y = (tn * 64 + nx + 1 < ncols) ? s[1] : 0.f; v.z = (tn * 64 + nx + 2 < ncols) ? s[2] : 0.f; v.w = 0.f; }
      sT[k * 65 + nx] = v.x; sT[k * 65 + nx + 1] = v.y; sT[k * 65 + nx + 2] = v.z; sT[k * 65 + nx + 3] = v.w;
    }
    __syncthreads();
    const int n = tid >> 2, kq = tid & 3;
    if (tn * 64 + n < ncols) {
      float f[16];
#pragma unroll
      for (int j = 0; j < 16; ++j) f[j] = sT[(kq * 16 + j) * 65 + n];
      uint4* d = (uint4*)(dst + (size_t)(tn * 64 + n) * K + tk * 64 + kq * 16);
      d[0] = pack8(f); d[1] = pack8(f + 8);
    }
    __syncthreads();
  }
}
DI void conv_plain(const float* __restrict__ src, bf16_t* __restrict__ dst, size_t n, int bid, int nb) {
  size_t i = ((size_t)bid * 256 + tidx()), st = (size_t)nb * 256;
  for (; i < n / 8; i += st) {
    float4 a = ((const float4*)src)[2 * i], b = ((const float4*)src)[2 * i + 1];
    uint4 o; o.x = pack2(a.x, a.y); o.y = pack2(a.z, a.w); o.z = pack2(b.x, b.y); o.w = pack2(b.z, b.w);
    ((uint4*)dst)[i] = o;
  }
}
DI void rmsnorm_phase(const float* __restrict__ x, const float* __restrict__ g, bf16_t* __restrict__ h, int bid, int nb) {
  const int wave = tidx() >> 6, lane = tidx() & 63;
  for (int row = bid * 4 + wave; row < T_; row += nb * 4) {
    const float4* xr = (const float4*)(x + (size_t)row * 1024);
    float4 v[4]; float ss = 0.f;
#pragma unroll
    for (int j = 0; j < 4; ++j) { v[j] = xr[lane + 64 * j]; ss += v[j].x * v[j].x + v[j].y * v[j].y + v[j].z * v[j].z + v[j].w * v[j].w; }
    ss = wave_sum(ss);
    const float r = rsqrtf(ss * (1.f / 1024.f) + 1e-6f);
#pragma unroll
    for (int j = 0; j < 4; ++j) {
      float4 g4 = ((const float4*)g)[lane + 64 * j];
      uint2 o; o.x = pack2(v[j].x * r * g4.x, v[j].y * r * g4.y); o.y = pack2(v[j].z * r * g4.z, v[j].w * r * g4.w);
      ((uint2*)(h + (size_t)row * 1024))[lane + 64 * j] = o;
    }
  }
}
DI void phase_prep(const Params& p, int l, int bid, int nb, char* smem) {
  float* sT = (float*)smem;
  char* ws = p.ws;
  const float* win = p.in[I_WIN] + (size_t)l * 1024 * 9488;
  bf16_t* wt_in = (bf16_t*)(ws + O_WIN);
  tconv_job(win, 9488, 1024, 0, 3072, wt_in, bid, nb, sT);
  tconv_job(win, 9488, 1024, 3088, 6400, wt_in + (size_t)3072 * 1024, bid, nb, sT);
  tconv_job(win, 9488, 1024, 3072, 16, wt_in + (size_t)9472 * 1024, bid, nb, sT);
  {
    uint4 z = {0, 0, 0, 0};
    uint4* d = (uint4*)(wt_in + (size_t)9488 * 1024);
    for (int i = bid * 256 + tidx(); i < 112 * 1024 / 8; i += nb * 256) d[i] = z;
  }
  tconv_job(p.in[I_WGATE] + (size_t)l * 1024 * 3072, 3072, 1024, 0, 3072, (bf16_t*)(ws + O_WGATE), bid, nb, sT);
  tconv_job(p.in[I_PSSD] + (size_t)l * 1048576, 1024, 1024, 0, 1024, (bf16_t*)(ws + O_PT), bid, nb, sT);
  tconv_job(p.in[I_PMOBA] + (size_t)l * 1048576, 1024, 1024, 0, 1024, (bf16_t*)(ws + O_PT) + 1048576, bid, nb, sT);
  tconv_job(p.in[I_PRWKV] + (size_t)l * 1048576, 1024, 1024, 0, 1024, (bf16_t*)(ws + O_PT) + 2 * 1048576, bid, nb, sT);
  tconv_job(p.in[I_WOUT] + (size_t)l * 1048576, 1024, 1024, 0, 1024, (bf16_t*)(ws + O_WOUT), bid, nb, sT);
  tconv_job(p.in[I_WQ] + (size_t)l * 1024 * 2048, 2048, 1024, 0, 2048, (bf16_t*)(ws + O_WQ), bid, nb, sT);
  tconv_job(p.in[I_WW2] + (size_t)l * 64 * 1024, 1024, 64, 0, 1024, (bf16_t*)(ws + O_WW2), bid, nb, sT);
  tconv_job(p.in[I_WA2] + (size_t)l * 64 * 1024, 1024, 64, 0, 1024, (bf16_t*)(ws + O_WA2), bid, nb, sT);
  tconv_job(p.in[I_WG2] + (size_t)l * 128 * 1024, 1024, 128, 0, 1024, (bf16_t*)(ws + O_WG2), bid, nb, sT);
  conv_plain(p.in[I_K1] + (size_t)l * 16384, (bf16_t*)(ws + O_K1), 16384, bid, nb);
  conv_plain(p.in[I_K2] + (size_t)l * 16384, (bf16_t*)(ws + O_K2), 16384, bid, nb);
  { int* cz = (int*)(ws + O_CNT); for (int i = bid * 256 + tidx(); i < 2 * 3072; i += nb * 256) cz[i] = 0; }
  const float* xin = l == 0 ? p.in[I_X] : p.out;
  rmsnorm_phase(xin, p.in[I_N1G] + l * 1024, slab(p, 0), bid, nb);
}

struct Route { int packed; int seg0; };
DI void gemm_in_phase(const Params& p, int l, const Route rt, int nt, int t0a, int t0b_from, int t0b, int bid, int nb, char* smem) {
  bf16_t* sA = (bf16_t*)smem; bf16_t* sB = sA + 128 * LDT;
  const bf16_t* h = slab(p, 0);
  const bf16_t* wt = (const bf16_t*)(p.ws + O_WIN);
  bf16_t* lora = slab(p, 3); float* dtp = (float*)(p.ws + O_DT); const float* dtb = p.in[I_DTB] + l * 16;
  for (int t = bid; t < 256 * nt; t += nb) {
    const int tm = t / nt, tl = t % nt;
    const int tn = tl < t0b_from ? t0a + tl : t0b + (tl - t0b_from);
    f32x16 acc[2][2]; acc_zero<2>(acc);
    gemm_core<2>(h + (size_t)tm * 128 * 1024, 1024, wt + (size_t)tn * 128 * 1024, 1024, 1024, sA, sB, acc);
    const int row0 = tm * 128, col0 = tn * 128, seg = col0 >> 10;
    if (seg < 9) {
      bf16_t* d = slab(p, (rt.packed >> (4 * (seg - rt.seg0))) & 15) + (size_t)row0 * 1024 + (col0 & 1023);
      ACC_FOREACH(2, acc, { d[(size_t)r * 1024 + c] = f2bf(v); })
    } else {
      const int cc0 = col0 - 9216;
      ACC_FOREACH(2, acc, {
        const int cc = cc0 + c;
        if (cc < 256) lora[(size_t)(row0 + r) * 256 + cc] = f2bf(v);
        else if (cc < 272) dtp[(size_t)(row0 + r) * 16 + (cc - 256)] = softplusf_(v + dtb[cc - 256]);
      })
    }
  }
}

DI void phase_lora_prep(const Params& p, int l, int bid, int nb) {
  const bf16_t* raw = slab(p, 3);
  bf16_t* act = (bf16_t*)(p.ws + O_LACT);
  const float* mu = p.in[I_MU] + l * 3328 + 3072;
  for (int it = bid * 256 + tidx(); it < T_ * 32; it += nb * 256) {
    const int t = it >> 5, c8 = (it & 31) * 8;
    uint4 cur = *(const uint4*)(raw + (size_t)t * 256 + c8);
    uint4 prv = {0, 0, 0, 0};
    if (t & (S_ - 1)) prv = *(const uint4*)(raw + (size_t)(t - 1) * 256 + c8);
    float x[8], xp[8], o[8];
    unpack8(cur, x); unpack8(prv, xp);
#pragma unroll
    for (int e = 0; e < 8; ++e) {
      const int j = c8 + e;
      const float xs = x[e] + (xp[e] - x[e]) * mu[j];
      o[e] = j < 64 ? tanhf(xs) : (j < 128 ? xs : sigmoidf_(xs));
    }
    *(uint4*)(act + (size_t)t * 256 + c8) = pack8(o);
  }
}
template <class F>
DI void gemm_lora_phase(const Params& p, int aoff, int K, const bf16_t* wt, int bid, int nb, char* smem, F epi) {
  bf16_t* sA = (bf16_t*)smem; bf16_t* sB = sA + 128 * LDT;
  const bf16_t* A = (const bf16_t*)(p.ws + O_LACT) + aoff;
  for (int t = bid; t < 256 * 8; t += nb) {
    const int tm = t >> 3, tn = t & 7;
    f32x16 acc[2][2]; acc_zero<2>(acc);
    gemm_core<2>(A + (size_t)tm * 128 * 256, 256, wt + (size_t)tn * 128 * K, K, K, sA, sB, acc);
    const int row0 = tm * 128, col0 = tn * 128;
    ACC_FOREACH(2, acc, { epi(row0 + r, col0 + c, v); })
  }
}
DI void phase_lora_wa(const Params& p, int l, int bid, int nb, char* smem) {
  const float* w0 = p.in[I_W0] + l * 1024; const float* a0 = p.in[I_A0] + l * 1024;
  bf16_t* ew = slab(p, 1); bf16_t* av = slab(p, 2);
  gemm_lora_phase(p, 0, 64, (const bf16_t*)(p.ws + O_WW2), bid, nb, smem, [&](int r, int c, float v) {
    const float wpre = w0[c] + v;
    const float w = -softplusf_(-wpre) - 0.5f;
    ew[(size_t)r * 1024 + c] = f2bf(__expf(w));
  });
  gemm_lora_phase(p, 64, 64, (const bf16_t*)(p.ws + O_WA2), bid, nb, smem, [&](int r, int c, float v) {
    av[(size_t)r * 1024 + c] = f2bf(sigmoidf_(a0[c] + v));
  });
}
DI void phase_rwkv_scan(const Params& p, int l, int bid, int nb, char* smem) {
  float* sa = (float*)smem; float* sw = sa + 2048; float* sb = sw + 2048; float* sk = sb + 2048; float* sr = sk + 2048;
  float* sv = sr + 2048; float* sy = sv + 512;
  const int tid = tidx(), lane = tid & 63, wave = tid >> 6;
  const bf16_t* R = slab(p, 4); const bf16_t* Kx = slab(p, 5); const bf16_t* V = slab(p, 6);
  const bf16_t* EW = slab(p, 1); const bf16_t* AV = slab(p, 2);
  bf16_t* Y = slab(p, 3);
  float* rbout = (float*)(p.ws + O_RB);
  for (int task = bid; task < 128; task += nb) {
    const int qd = task & 3, head = (task >> 2) & 15, b = task >> 6;
    const int st = tid >> 3, c8 = tid & 7, ch0 = head * 64 + c8 * 8;
    float mur[8], muk[8], muv[8], ckk[8], cka[8], crk[8];
#pragma unroll
    for (int e = 0; e < 8; ++e) {
      mur[e] = p.in[I_MU][l * 3328 + ch0 + e]; muk[e] = p.in[I_MU][l * 3328 + 1024 + ch0 + e]; muv[e] = p.in[I_MU][l * 3328 + 2048 + ch0 + e];
      ckk[e] = p.in[I_KK][l * 1024 + ch0 + e]; cka[e] = p.in[I_KA][l * 1024 + ch0 + e]; crk[e] = p.in[I_RK][l * 1024 + ch0 + e];
    }
    uint4 gr, gk, gv, gw, ga, gpr, gpk, gpv;
    auto gload = [&](int c) {
      const int ts = c * 32 + st;
      const size_t o = ((size_t)b * S_ + ts) * 1024 + ch0;
      gr = *(const uint4*)(R + o); gk = *(const uint4*)(Kx + o); gv = *(const uint4*)(V + o);
      gw = *(const uint4*)(EW + o); ga = *(const uint4*)(AV + o);
      if (ts > 0) { gpr = *(const uint4*)(R + o - 1024); gpk = *(const uint4*)(Kx + o - 1024); gpv = *(const uint4*)(V + o - 1024); }
      else { gpr = make_uint4(0, 0, 0, 0); gpk = gpr; gpv = gpr; }
    };
    auto stage = [&](int c) {
      float r[8], k[8], v[8], w[8], a[8], pr[8], pk[8], pv[8];
      unpack8(gr, r); unpack8(gk, k); unpack8(gv, v); unpack8(gw, w); unpack8(ga, a); unpack8(gpr, pr); unpack8(gpk, pk); unpack8(gpv, pv);
      float kk[8], ss = 0.f, rbs = 0.f;
#pragma unroll
      for (int e = 0; e < 8; ++e) {
        r[e] = r[e] + (pr[e] - r[e]) * mur[e];
        k[e] = k[e] + (pk[e] - k[e]) * muk[e];
        v[e] = v[e] + (pv[e] - v[e]) * muv[e];
        kk[e] = k[e] * ckk[e]; ss += kk[e] * kk[e];
      }
      ss = red8(ss);
      const float inv = rsqrtf(fmaxf(ss, 1e-12f));
      float oa[8], ow[8], ob[8], ok[8];
#pragma unroll
      for (int e = 0; e < 8; ++e) {
        kk[e] *= inv;
        ok[e] = k[e] * (1.f + (a[e] - 1.f) * cka[e]);
        oa[e] = -kk[e]; ob[e] = kk[e] * a[e]; ow[e] = __expf(-w[e]);
        rbs += r[e] * ok[e] * crk[e];
      }
      rbs = red8(rbs);
      float* d;
      d = sa + st * 64 + c8 * 8; *(float4*)d = make_float4(oa[0], oa[1], oa[2], oa[3]); *(float4*)(d + 4) = make_float4(oa[4], oa[5], oa[6], oa[7]);
      d = sw + st * 64 + c8 * 8; *(float4*)d = make_float4(ow[0], ow[1], ow[2], ow[3]); *(float4*)(d + 4) = make_float4(ow[4], ow[5], ow[6], ow[7]);
      d = sb + st * 64 + c8 * 8; *(float4*)d = make_float4(ob[0], ob[1], ob[2], ob[3]); *(float4*)(d + 4) = make_float4(ob[4], ob[5], ob[6], ob[7]);
      d = sk + st * 64 + c8 * 8; *(float4*)d = make_float4(ok[0], ok[1], ok[2], ok[3]); *(float4*)(d + 4) = make_float4(ok[4], ok[5], ok[6], ok[7]);
      d = sr + st * 64 + c8 * 8; *(float4*)d = make_float4(r[0], r[1], r[2], r[3]); *(float4*)(d + 4) = make_float4(r[4], r[5], r[6], r[7]);
      if ((c8 >> 1) == qd) {
        d = sv + st * 16 + (c8 & 1) * 8; *(float4*)d = make_float4(v[0], v[1], v[2], v[3]); *(float4*)(d + 4) = make_float4(v[4], v[5], v[6], v[7]);
      }
      if (qd == 0 && c8 == 0) rbout[((size_t)b * S_ + c * 32 + st) * 16 + head] = rbs;
    };
    const int rowl = wave * 4 + (lane >> 4), pp = lane & 15;
    float s0 = 0.f, s1 = 0.f, s2 = 0.f, s3 = 0.f;
    gload(0);
    __syncthreads();
    stage(0);
    __syncthreads();
    for (int c = 0; c < 512; ++c) {
      if (c + 1 < 512) gload(c + 1);
#pragma unroll 4
      for (int s = 0; s < 32; ++s) {
        const float4 a4 = *(const float4*)(sa + s * 64 + 4 * pp);
        const float4 w4 = *(const float4*)(sw + s * 64 + 4 * pp);
        const float4 b4 = *(const float4*)(sb + s * 64 + 4 * pp);
        const float4 k4 = *(const float4*)(sk + s * 64 + 4 * pp);
        const float4 r4 = *(const float4*)(sr + s * 64 + 4 * pp);
        const float vv = sv[s * 16 + rowl];
        float d = s0 * a4.x + s1 * a4.y + s2 * a4.z + s3 * a4.w;
        d = red16(d);
        s0 = s0 * w4.x + d * b4.x + vv * k4.x;
        s1 = s1 * w4.y + d * b4.y + vv * k4.y;
        s2 = s2 * w4.z + d * b4.z + vv * k4.z;
        s3 = s3 * w4.w + d * b4.w + vv * k4.w;
        float y = s0 * r4.x + s1 * r4.y + s2 * r4.z + s3 * r4.w;
        y = red16(y);
        if (pp == 0) sy[s * 16 + rowl] = y;
      }
      __syncthreads();
      if (tid < 64) {
        const int s = tid >> 1, hf = tid & 1;
        float f[8];
#pragma unroll
        for (int e = 0; e < 8; ++e) f[e] = sy[s * 16 + hf * 8 + e];
        *(uint4*)(Y + ((size_t)b * S_ + c * 32 + s) * 1024 + head * 64 + qd * 16 + hf * 8) = pack8(f);
      }
      if (c + 1 < 512) stage(c + 1);
      __syncthreads();
    }
  }
}
DI void phase_rwkv_ln(const Params& p, int l, int bid, int nb) {
  bf16_t* Y = slab(p, 3); const bf16_t* V = slab(p, 6);
  const float* rb = (const float*)(p.ws + O_RB);
  const float* lng = p.in[I_LNG] + l * 1024; const float* lnb = p.in[I_LNB] + l * 1024; const float* muv = p.in[I_MU] + l * 3328 + 2048;
  for (int it = bid * 256 + tidx(); it < T_ * 128; it += nb * 256) {
    const int t = it >> 7, c8 = (it & 127) * 8, head = c8 >> 6;
    float y[8], v[8], pv[8], o[8];
    unpack8(*(const uint4*)(Y + (size_t)t * 1024 + c8), y);
    unpack8(*(const uint4*)(V + (size_t)t * 1024 + c8), v);
    uint4 pz = {0, 0, 0, 0};
    if (t & (S_ - 1)) pz = *(const uint4*)(V + (size_t)(t - 1) * 1024 + c8);
    unpack8(pz, pv);
    float s = 0.f;
#pragma unroll
    for (int e = 0; e < 8; ++e) s += y[e];
    s = red8(s);
    const float mean = s * (1.f / 64.f);
    float q = 0.f;
#pragma unroll
    for (int e = 0; e < 8; ++e) { const float d = y[e] - mean; q += d * d; }
    q = red8(q);
    const float rstd = rsqrtf(q * (1.f / 64.f) + 64e-5f);
    const float rbv = rb[(size_t)t * 16 + head];
#pragma unroll
    for (int e = 0; e < 8; ++e) {
      const float vs = v[e] + (pv[e] - v[e]) * muv[c8 + e];
      o[e] = (y[e] - mean) * rstd * lng[c8 + e] + lnb[c8 + e] + rbv * vs;
    }
    *(uint4*)(Y + (size_t)t * 1024 + c8) = pack8(o);
  }
}
DI void phase_rwkv_g(const Params& p, int l, int bid, int nb, char* smem) {
  bf16_t* Y = slab(p, 3);
  gemm_lora_phase(p, 128, 128, (const bf16_t*)(p.ws + O_WG2), bid, nb, smem, [&](int r, int c, float v) {
    const size_t o = (size_t)r * 1024 + c;
    Y[o] = f2bf(bf2f(Y[o]) * v);
  });
}

DI void phase_ssd_conv(const Params& p, int l, int bid, int nb) {
  const bf16_t* rx = slab(p, 2); const bf16_t* rbc = slab(p, 4);
  bf16_t* xs = slab(p, 5); bf16_t* bc = slab(p, 6);
  const float* cw = p.in[I_CONVW] + l * 4 * 2048; const float* cb = p.in[I_CONVB] + l * 2048;
  for (int it = bid * 256 + tidx(); it < T_ * 256; it += nb * 256) {
    const int t = it >> 8, c8 = (it & 255) * 8;
    const bf16_t* src = c8 < 1024 ? rx : rbc; bf16_t* dst = c8 < 1024 ? xs : bc;
    const int cc = c8 & 1023, ts = t & (S_ - 1);
    float acc[8];
#pragma unroll
    for (int e = 0; e < 8; ++e) acc[e] = cb[c8 + e];
#pragma unroll
    for (int k = 0; k < 4; ++k) {
      if (ts - 3 + k >= 0) {
        float x[8]; unpack8(*(const uint4*)(src + (size_t)(t - 3 + k) * 1024 + cc), x);
#pragma unroll
        for (int e = 0; e < 8; ++e) acc[e] += x[e] * cw[k * 2048 + c8 + e];
      }
    }
#pragma unroll
    for (int e = 0; e < 8; ++e) acc[e] = siluf_(acc[e]);
    *(uint4*)(dst + (size_t)t * 1024 + cc) = pack8(acc);
  }
}
DI float* scan128(float* a, float* b) {
  const int tid = tidx();
  float* src = a; float* dst = b;
  for (int off = 1; off < 128; off <<= 1) {
    if (tid < 128) dst[tid] = src[tid] + (tid >= off ? src[tid - off] : 0.f);
    __syncthreads();
    float* t = src; src = dst; dst = t;
  }
  return src;
}
DI void phase_ssd_states(const Params& p, int l, int bid, int nb, char* smem) {
  bf16_t* sXT = (bf16_t*)smem;
  bf16_t* sBT = sXT + 64 * 136;
  float* fa = (float*)(sBT + 128 * 136);
  float* fb = fa + 128; float* fdt = fb + 128;
  const int tid = tidx(), lane = tid & 63, wave = tid >> 6;
  const bf16_t* xs = slab(p, 5); const bf16_t* bc = slab(p, 6);
  const float* dt = (const float*)(p.ws + O_DT);
  float* cdec = (float*)(p.ws + O_CDEC);
  for (int task = bid; task < 4096; task += nb) {
    const int head = task & 15, c = (task >> 4) & 127, b = task >> 11, g = head >> 2;
    const size_t t0 = (size_t)b * S_ + c * 128;
    const float aneg = -__expf(p.in[I_ALOG][l * 16 + head]);
    __syncthreads();
    if (tid < 128) { const float d = dt[(t0 + tid) * 16 + head]; fdt[tid] = d; fa[tid] = d * aneg; }
    __syncthreads();
    float* acs = scan128(fa, fb);
    const float alast = acs[127];
    if (tid == 0) cdec[(b * 128 + c) * 16 + head] = __expf(alast);
#pragma unroll
    for (int j = 0; j < 4; ++j) {
      const int ci = tid + 256 * j, lr = ci >> 3, p8 = (ci & 7) * 8;
      float x[8]; unpack8(*(const uint4*)(xs + (t0 + lr) * 1024 + head * 64 + p8), x);
      const float sc = fdt[lr] * __expf(alast - acs[lr]);
#pragma unroll
      for (int e = 0; e < 8; ++e) sXT[(p8 + e) * 136 + lr] = f2bf(x[e] * sc);
    }
#pragma unroll
    for (int j = 0; j < 8; ++j) {
      const int ci = tid + 256 * j, lr = ci >> 4, n8 = (ci & 15) * 8;
      const uint4 u = *(const uint4*)(bc + (t0 + lr) * 1024 + g * 128 + n8);
#pragma unroll
      for (int e = 0; e < 8; ++e) sBT[(n8 + e) * 136 + lr] = get16(u, e);
    }
    __syncthreads();
    f32x16 acc[2];
#pragma unroll
    for (int mi = 0; mi < 2; ++mi)
#pragma unroll
      for (int i = 0; i < 16; ++i) acc[mi][i] = 0.f;
#pragma unroll
    for (int kk = 0; kk < 8; ++kk) {
      const bf16x8 bf = *(const bf16x8*)(sBT + (wave * 32 + (lane & 31)) * 136 + kk * 16 + (lane >> 5) * 8);
#pragma unroll
      for (int mi = 0; mi < 2; ++mi) {
        const bf16x8 af = *(const bf16x8*)(sXT + (mi * 32 + (lane & 31)) * 136 + kk * 16 + (lane >> 5) * 8);
        acc[mi] = MFMA32(af, bf, acc[mi]);
      }
    }
    float* st = (float*)slab(p, b == 0 ? 2 : 4) + ((size_t)(c * 16 + head) * 64) * 128;
#pragma unroll
    for (int mi = 0; mi < 2; ++mi)
#pragma unroll
      for (int i = 0; i < 16; ++i) st[(size_t)(mi * 32 + crow(i, lane >> 5)) * 128 + wave * 32 + (lane & 31)] = acc[mi][i];
  }
}
DI void phase_ssd_scan(const Params& p, int bid, int nb) {
  const float* cdec = (const float*)(p.ws + O_CDEC);
  for (int it = bid * 256 + tidx(); it < 2 * 16 * 8192; it += nb * 256) {
    const int b = it >> 17, rem = it & 131071, head = rem >> 13;
    float* st = (float*)slab(p, b == 0 ? 2 : 4) + rem;
    float h = 0.f;
#pragma unroll 8
    for (int c = 0; c < 128; ++c) {
      const float s = st[(size_t)c * 131072];
      st[(size_t)c * 131072] = h;
      h = h * cdec[(b * 128 + c) * 16 + head] + s;
    }
  }
}
DI void phase_ssd_out(const Params& p, int l, int bid, int nb, char* smem) {
  bf16_t* sM = (bf16_t*)smem;
  bf16_t* sXT = sM + 128 * 136;
  float* fa = (float*)(sXT + 64 * 136); float* fb = fa + 128; float* fdt = fb + 128; float* frs = fdt + 128;
  const int tid_ = tidx(), lane = tid_ & 63, wave_ = __builtin_amdgcn_readfirstlane(tid_ >> 6), hh_ = lane >> 5, l31_ = lane & 31;
  const bf16_t* xs = slab(p, 5); const bf16_t* bc = slab(p, 6);
  bf16_t* zy = slab(p, 1);
  const float* dt = (const float*)(p.ws + O_DT);
  const float* ng = p.in[I_SSDNG] + l * 1024;
  for (int task = bid; task < 1024; task += nb) {
    const int g = task & 3, c = (task >> 2) & 127, b = task >> 9;
    const size_t t0 = (size_t)b * S_ + c * 128;
    int tid = tid_; asm volatile("" : "+v"(tid));
    __syncthreads();
#pragma unroll
    for (int j = 0; j < 8; ++j) {
      const int ci = tid + 256 * j, lr = ci >> 4, n8 = (ci & 15) * 8;
      *(uint4*)(sM + lr * 136 + n8) = *(const uint4*)(bc + (t0 + lr) * 1024 + g * 128 + n8);
    }
    const int wave = wave_, hh = hh_, l31 = l31_;
    const bf16_t* cptr = bc + (t0 + wave * 32 + l31) * 1024 + 512 + g * 128 + hh * 8;
    __syncthreads();
    f32x16 cb[4];
#pragma unroll
    for (int ni = 0; ni < 4; ++ni)
#pragma unroll
      for (int i = 0; i < 16; ++i) cb[ni][i] = 0.f;
#pragma unroll
    for (int kk = 0; kk < 8; ++kk) {
      const bf16x8 cfk = *(const bf16x8*)(cptr + kk * 16);
#pragma unroll
      for (int ni = 0; ni < 4; ++ni) {
        const bf16x8 bf = *(const bf16x8*)(sM + (ni * 32 + l31) * 136 + kk * 16 + hh * 8);
        cb[ni] = MFMA32(cfk, bf, cb[ni]);
      }
    }
    float ssq[16];
#pragma unroll
    for (int i = 0; i < 16; ++i) ssq[i] = 0.f;
#pragma unroll 1
    for (int e = 0; e < 4; ++e) {
      int l31 = l31_, hh = hh_, wave = wave_;
      asm volatile("" : "+v"(l31), "+v"(hh));
      asm volatile("" : "+s"(wave));
      const int head = g * 4 + e;
      const float aneg = -__expf(p.in[I_ALOG][l * 16 + head]);
      const float dsk = p.in[I_DSKIP][l * 16 + head];
      __syncthreads();
      if (tid < 128) { const float d = dt[(t0 + tid) * 16 + head]; fdt[tid] = d; fa[tid] = d * aneg; }
      __syncthreads();
      float* acs = scan128(fa, fb);
#pragma unroll
      for (int j = 0; j < 4; ++j) {
        const int ci = tid + 256 * j, lr = ci >> 3, p8 = (ci & 7) * 8;
        const uint4 u = *(const uint4*)(xs + (t0 + lr) * 1024 + head * 64 + p8);
#pragma unroll
        for (int q = 0; q < 8; ++q) sXT[(p8 + q) * 136 + lr] = get16(u, q);
      }
#pragma unroll
      for (int ni = 0; ni < 4; ++ni)
#pragma unroll
        for (int i = 0; i < 16; ++i) {
          const int lr = wave * 32 + crow(i, hh), sc = ni * 32 + l31;
          const float m = sc <= lr ? cb[ni][i] * __expf(acs[lr] - acs[sc]) * fdt[sc] : 0.f;
          sM[lr * 136 + sc] = f2bf(m);
        }
      __syncthreads();
      const float* hin = (const float*)slab(p, b == 0 ? 2 : 4) + ((size_t)(c * 16 + head) * 64) * 128;
#pragma unroll 1
      for (int ni = 0; ni < 2; ++ni) {
        f32x16 yd;
#pragma unroll
        for (int i = 0; i < 16; ++i) yd[i] = 0.f;
#pragma unroll 2
        for (int kk = 0; kk < 8; ++kk) {
          const bf16x8 cfk = *(const bf16x8*)(cptr + kk * 16);
          const float* hp = hin + (size_t)(ni * 32 + l31) * 128 + kk * 16 + hh * 8;
          const float4 h0 = *(const float4*)hp, h1 = *(const float4*)(hp + 4);
          u32x4 u; u.x = pack2(h0.x, h0.y); u.y = pack2(h0.z, h0.w); u.z = pack2(h1.x, h1.y); u.w = pack2(h1.z, h1.w);
          yd = MFMA32(cfk, __builtin_bit_cast(bf16x8, u), yd);
        }
#pragma unroll
        for (int i = 0; i < 16; ++i) yd[i] *= (SSD_PROBE == 2 ? 0.f : __expf(acs[wave * 32 + crow(i, hh)]));
#pragma unroll
        for (int kk = 0; kk < 8; ++kk) {
          const bf16x8 af = *(const bf16x8*)(sM + (wave * 32 + l31) * 136 + kk * 16 + hh * 8);
          const bf16x8 bf = *(const bf16x8*)(sXT + (ni * 32 + l31) * 136 + kk * 16 + hh * 8);
          yd = MFMA32(af, bf, yd);
        }
#pragma unroll
        for (int i = 0; i < 16; ++i) {
          const int lr = wave * 32 + crow(i, hh), pc = ni * 32 + l31;
          const float xv = bf2f(sXT[pc * 136 + lr]);
          float y = (SSD_PROBE == 1 ? 0.f : yd[i]) + xv * dsk;
          const size_t o = (t0 + lr) * 1024 + head * 64 + pc;
          const float zv = bf2f(zy[o]);
          y *= siluf_(zv);
          ssq[i] += y * y;
          zy[o] = f2bf(y);
        }
      }
    }
#pragma unroll
    for (int i = 0; i < 16; ++i) {
      float s = ssq[i];
      for (int o = 16; o > 0; o >>= 1) s += __shfl_xor(s, o);
      if (l31 == 0) frs[wave * 32 + crow(i, hh)] = rsqrtf(s * (1.f / 256.f) + 1e-6f);
    }
    __syncthreads();
#pragma unroll 2
    for (int j = 0; j < (DBG == 2 ? 0 : 16); ++j) {
      const int ci = tid + 256 * j, lr = ci >> 5, c8 = (ci & 31) * 8;
      bf16_t* ptr = zy + (t0 + lr) * 1024 + g * 256 + c8;
      float f[8]; unpack8(*(const uint4*)ptr, f);
      const float rs = frs[lr];
#pragma unroll
      for (int q = 0; q < 8; ++q) f[q] *= rs * ng[g * 256 + c8 + q];
      *(uint4*)ptr = pack8(f);
    }
  }
}

DI void phase_moba_norm(const Params& p, int l, int bid, int nb, char* smem) {
  float* sK = (float*)smem;
  const int tid = tidx(), rg = tid >> 4, ln = tid & 15;
  bf16_t* Q = slab(p, 2); bf16_t* Kx = slab(p, 4);
  float* kmean = (float*)(p.ws + O_KMEAN);
  float qg[8], kg[8];
#pragma unroll
  for (int e = 0; e < 8; ++e) { qg[e] = p.in[I_QNG][l * 128 + ln * 8 + e]; kg[e] = p.in[I_KNG][l * 128 + ln * 8 + e]; }
  for (int task = bid; task < 1024; task += nb) {
    const int blk = task & 63, h = (task >> 6) & 7, b = task >> 9;
    const size_t t0 = (size_t)b * S_ + blk * 256;
    float ks[8];
#pragma unroll
    for (int e = 0; e < 8; ++e) ks[e] = 0.f;
    for (int j = 0; j < 16; ++j) {
      const size_t o = (t0 + rg + 16 * j) * 1024 + h * 128 + ln * 8;
      float f[8]; float ss = 0.f;
      unpack8(*(const uint4*)(Q + o), f);
#pragma unroll
      for (int e = 0; e < 8; ++e) ss += f[e] * f[e];
      ss = red16(ss);
      float r = rsqrtf(ss * (1.f / 128.f) + 1e-6f);
#pragma unroll
      for (int e = 0; e < 8; ++e) f[e] *= r * qg[e];
      *(uint4*)(Q + o) = pack8(f);
      unpack8(*(const uint4*)(Kx + o), f);
      ss = 0.f;
#pragma unroll
      for (int e = 0; e < 8; ++e) ss += f[e] * f[e];
      ss = red16(ss);
      r = rsqrtf(ss * (1.f / 128.f) + 1e-6f);
#pragma unroll
      for (int e = 0; e < 8; ++e) { f[e] *= r * kg[e]; ks[e] += f[e]; }
      *(uint4*)(Kx + o) = pack8(f);
    }
    __syncthreads();
#pragma unroll
    for (int e = 0; e < 8; ++e) sK[rg * 128 + ln * 8 + e] = ks[e];
    __syncthreads();
    if (tid < 128) {
      float s = 0.f;
#pragma unroll
      for (int j = 0; j < 16; ++j) s += sK[j * 128 + tid];
      kmean[((size_t)(b * 8 + h) * 64 + blk) * 128 + tid] = s * (1.f / 256.f);
    }
  }
}
DI void phase_moba_gate(const Params& p, int bid, int nb, char* smem) {
  float* sKm = (float*)smem;
  const int tid = tidx();
  const bf16_t* Q = slab(p, 2);
  const float* kmean = (const float*)(p.ws + O_KMEAN);
  int* sel = (int*)(p.ws + O_SEL); int* cnt = (int*)(p.ws + O_CNT);
  for (int task = bid; task < 1024; task += nb) {
    const int blk = task & 63, h = (task >> 6) & 7, b = task >> 9;
    __syncthreads();
    for (int i = tid; i < blk * 128; i += 256) sKm[i] = kmean[((size_t)(b * 8 + h) * 64) * 128 + i];
    __syncthreads();
    const size_t t = (size_t)b * S_ + blk * 256 + tid;
    float q[128];
#pragma unroll
    for (int j = 0; j < 16; ++j) unpack8(*(const uint4*)(Q + t * 1024 + h * 128 + j * 8), q + j * 8);
    float v0 = -3e38f, v1 = -3e38f, v2 = -3e38f; int i0 = -1, i1 = -1, i2 = -1;
    for (int j = 0; j < blk; ++j) {
      float d = 0.f;
#pragma unroll
      for (int e = 0; e < 128; ++e) d += q[e] * sKm[j * 128 + e];
      if (d > v0) { v2 = v1; i2 = i1; v1 = v0; i1 = i0; v0 = d; i0 = j; }
      else if (d > v1) { v2 = v1; i2 = i1; v1 = d; i1 = j; }
      else if (d > v2) { v2 = d; i2 = j; }
    }
    int* so = sel + (t * 8 + h) * 3;
    so[0] = i0; so[1] = i1; so[2] = i2;
    const int base = (b * 8 + h) * 64;
    if (i0 >= 0) atomicAdd(cnt + 0 * 1024 + base + i0, 1);
    if (i1 >= 0) atomicAdd(cnt + 1 * 1024 + base + i1, 1);
    if (i2 >= 0) atomicAdd(cnt + 2 * 1024 + base + i2, 1);
  }
}
DI void phase_moba_fill(const Params& p, int bid, int nb, char* smem) {
  int* sBase = (int*)smem;
  const int tid = tidx();
  const int* sel = (const int*)(p.ws + O_SEL); const int* cnt = (const int*)(p.ws + O_CNT);
  int* fill = (int*)(p.ws + O_FILL); int* lists = (int*)(p.ws + O_LISTS);
  for (int task = bid; task < 1024; task += nb) {
    const int blk = task & 63, h = (task >> 6) & 7, b = task >> 9;
    const int base = (b * 8 + h) * 64;
    __syncthreads();
    if (tid < 3) { int a = 0; for (int j = 0; j < 64; ++j) { sBase[tid * 64 + j] = a; a += cnt[tid * 1024 + base + j]; } }
    __syncthreads();
    const int ts = blk * 256 + tid;
    const size_t t = (size_t)b * S_ + ts;
    for (int s = 0; s < 3; ++s) {
      const int j = sel[(t * 8 + h) * 3 + s];
      if (j >= 0) {
        const int pos = sBase[s * 64 + j] + atomicAdd(fill + s * 1024 + base + j, 1);
        lists[(size_t)s * (T_ * 8) + (size_t)(b * 8 + h) * S_ + pos] = ts;
      }
    }
  }
}
DI int t5_bucket(int d) {
  if (d < 16) return d;
  const int large = 16 + (int)(__logf((float)d * (1.f / 16.f)) / 4.1588830833596715f * 16.f);
  return large < 31 ? large : 31;
}
struct MobaLds { bf16_t* sK; bf16_t* sVT; float* sBias; };
DI void moba_block(const Params& p, const MobaLds& L, int b, int h, int tsq  , int kb  ,
                   int ntiles, bool causal, bool init) {
  const int tid = tidx(), lane = tid & 63, hh = lane >> 5, l31 = lane & 31;
  const bf16_t* Q = slab(p, 2); const bf16_t* Kx = slab(p, 4); const bf16_t* V = slab(p, 5);
  bf16_t* ACC = slab(p, 6);
  float* MM = (float*)(p.ws + O_MM); float* ML = (float*)(p.ws + O_ML);
  const bool valid = tsq >= 0;
  const size_t tq = (size_t)b * S_ + (valid ? tsq : 0);
  bf16x8 qf[8];
#pragma unroll
  for (int kk = 0; kk < 8; ++kk) {
    uint4 u = {0, 0, 0, 0};
    if (valid) u = *(const uint4*)(Q + tq * 1024 + h * 128 + kk * 16 + hh * 8);
    qf[kk] = __builtin_bit_cast(bf16x8, u);
  }
  float m = -1e30f, lsum = 0.f;
  f32x16 o[4];
#pragma unroll
  for (int dt = 0; dt < 4; ++dt)
#pragma unroll
    for (int i = 0; i < 16; ++i) o[dt][i] = 0.f;
  if (!init && valid) {
    m = MM[tq * 8 + h]; lsum = ML[tq * 8 + h];
#pragma unroll
    for (int dt = 0; dt < 4; ++dt)
#pragma unroll
      for (int g4 = 0; g4 < 4; ++g4) {
        const uint2 u = *(const uint2*)(ACC + tq * 1024 + h * 128 + dt * 32 + g4 * 8 + hh * 4);
        o[dt][g4 * 4 + 0] = lo16(u.x) * lsum; o[dt][g4 * 4 + 1] = hi16(u.x) * lsum;
        o[dt][g4 * 4 + 2] = lo16(u.y) * lsum; o[dt][g4 * 4 + 3] = hi16(u.y) * lsum;
      }
  }
  int wmaxq = valid ? tsq : -1;
  for (int of = 32; of > 0; of >>= 1) wmaxq = max(wmaxq, __shfl_xor(wmaxq, of));
  const float bias31 = L.sBias[1023];
  const float scale = 0.08838834764831845f;
  const size_t k0 = (size_t)b * S_ + (size_t)kb * 256;
  for (int kt = 0; kt < ntiles; ++kt) {
    __syncthreads();
#pragma unroll
    for (int j = 0; j < 4; ++j) {
      const int ci = tid + 256 * j, kr = ci >> 4, d8 = (ci & 15) * 8;
      const size_t go = (k0 + kt * 64 + kr) * 1024 + h * 128 + d8;
      *(uint4*)(L.sK + kr * 136 + d8) = *(const uint4*)(Kx + go);
      const uint4 u = *(const uint4*)(V + go);
#pragma unroll
      for (int e = 0; e < 8; ++e) L.sVT[(d8 + e) * 72 + kr] = get16(u, e);
    }
    __syncthreads();
    const int kpos0 = kb * 256 + kt * 64;
    if (causal && kpos0 > wmaxq) continue;
    f32x16 st[2];
#pragma unroll
    for (int t2 = 0; t2 < 2; ++t2)
#pragma unroll
      for (int i = 0; i < 16; ++i) st[t2][i] = 0.f;
#pragma unroll
    for (int kk = 0; kk < 8; ++kk)
#pragma unroll
      for (int t2 = 0; t2 < 2; ++t2) {
        const bf16x8 af = *(const bf16x8*)(L.sK + (t2 * 32 + l31) * 136 + kk * 16 + hh * 8);
        st[t2] = MFMA32(af, qf[kk], st[t2]);
      }
    float mloc = -1e30f;
#pragma unroll
    for (int t2 = 0; t2 < 2; ++t2)
#pragma unroll
      for (int i = 0; i < 16; ++i) {
        const int kp = kpos0 + t2 * 32 + crow(i, hh);
        const int dist = tsq - kp;
        float s;
        if (causal && dist < 0) s = -1e30f;
        else {
          const int dd = dist < 0 ? 0 : dist;
          s = st[t2][i] * scale + (dd < 1024 ? L.sBias[dd] : bias31);
        }
        st[t2][i] = s;
        mloc = fmaxf(mloc, s);
      }
    mloc = fmaxf(mloc, __shfl_xor(mloc, 32));
    const float mnew = fmaxf(m, mloc);
    const float alpha = __expf(m - mnew);
    float ls = 0.f;
#pragma unroll
    for (int t2 = 0; t2 < 2; ++t2)
#pragma unroll
      for (int i = 0; i < 16; ++i) {
        const float pv = st[t2][i] <= -1e29f ? 0.f : __expf(st[t2][i] - mnew);
        st[t2][i] = pv; ls += pv;
      }
    ls += __shfl_xor(ls, 32);
    lsum = lsum * alpha + ls;
    m = mnew;
#pragma unroll
    for (int dt = 0; dt < 4; ++dt)
#pragma unroll
      for (int i = 0; i < 16; ++i) o[dt][i] *= alpha;
#pragma unroll
    for (int t2 = 0; t2 < 2; ++t2)
#pragma unroll
      for (int s2 = 0; s2 < 2; ++s2) {
        uint4 pu;
        pu.x = pack2(st[t2][8 * s2 + 0], st[t2][8 * s2 + 1]); pu.y = pack2(st[t2][8 * s2 + 2], st[t2][8 * s2 + 3]);
        pu.z = pack2(st[t2][8 * s2 + 4], st[t2][8 * s2 + 5]); pu.w = pack2(st[t2][8 * s2 + 6], st[t2][8 * s2 + 7]);
        const bf16x8 pf = __builtin_bit_cast(bf16x8, pu);
#pragma unroll
        for (int dt = 0; dt < 4; ++dt) {
          const bf16_t* vp = L.sVT + (dt * 32 + l31) * 72 + t2 * 32 + s2 * 16 + hh * 4;
          uint4 vu; const uint2 a0 = *(const uint2*)vp, a1 = *(const uint2*)(vp + 8);
          vu.x = a0.x; vu.y = a0.y; vu.z = a1.x; vu.w = a1.y;
          o[dt] = MFMA32(__builtin_bit_cast(bf16x8, vu), pf, o[dt]);
        }
      }
  }
  if (valid) {
    const float inv = 1.f / lsum;
    if (hh == 0) { MM[tq * 8 + h] = m; ML[tq * 8 + h] = lsum; }
#pragma unroll
    for (int dt = 0; dt < 4; ++dt)
#pragma unroll
      for (int g4 = 0; g4 < 4; ++g4) {
        uint2 u; u.x = pack2(o[dt][g4 * 4] * inv, o[dt][g4 * 4 + 1] * inv); u.y = pack2(o[dt][g4 * 4 + 2] * inv, o[dt][g4 * 4 + 3] * inv);
        *(uint2*)(ACC + tq * 1024 + h * 128 + dt * 32 + g4 * 8 + hh * 4) = u;
      }
  }
}
DI void moba_bias_table(const Params& p, float* sBias, int h) {
  for (int d = tidx(); d < 1024; d += 256) sBias[d] = p.in[I_RELB][t5_bucket(d) * 8 + h];
}
DI void phase_moba_own(const Params& p, int bid, int nb, char* smem) {
  MobaLds L; L.sK = (bf16_t*)smem; L.sVT = L.sK + 64 * 136; L.sBias = (float*)(L.sVT + 128 * 72);
  const int tid = tidx(), lane = tid & 63, wave = tid >> 6;
  for (int task = bid; task < 2048; task += nb) {
    const int qt = task & 1, blk = (task >> 1) & 63, h = (task >> 7) & 7, b = task >> 10;
    __syncthreads();
    moba_bias_table(p, L.sBias, h);
    __syncthreads();
    const int tsq = blk * 256 + qt * 128 + wave * 32 + (lane & 31);
    moba_block(p, L, b, h, tsq, blk, 2 * (qt + 1), true, true);
  }
}
DI void phase_moba_past(const Params& p, int s, int bid, int nb, char* smem) {
  MobaLds L; L.sK = (bf16_t*)smem; L.sVT = L.sK + 64 * 136; L.sBias = (float*)(L.sVT + 128 * 72);
  int* sTb = (int*)(L.sBias + 1024);
  const int tid = tidx(), lane = tid & 63, wave = tid >> 6;
  const int* cnt = (const int*)(p.ws + O_CNT) + s * 1024;
  const int* lists = (const int*)(p.ws + O_LISTS) + (size_t)s * (T_ * 8);
  __syncthreads();
  if (tid < 16) { int a = 0; for (int j = 0; j < 64; ++j) { sTb[tid * 64 + j] = a; a += (cnt[tid * 64 + j] + 127) >> 7; } sTb[1040 + tid] = a; }
  __syncthreads();
  if (tid == 0) { int a = 0; for (int i = 0; i < 16; ++i) { const int c = sTb[1040 + i]; sTb[1040 + i] = a; a += c; } sTb[1056] = a; }
  __syncthreads();
  const int total = sTb[1056];
  for (int task = bid; task < total; task += nb) {
    int gi = 0;
    for (int i = 1; i < 16; ++i) if (sTb[1040 + i] <= task) gi = i;
    const int loc = task - sTb[1040 + gi];
    int j = 0;
    for (int i = 1; i < 64; ++i) if (sTb[gi * 64 + i] <= loc) j = i;
    while (j > 0 && ((cnt[gi * 64 + j] + 127) >> 7) == 0) --j;
    const int tile = loc - sTb[gi * 64 + j];
    const int b = gi >> 3, h = gi & 7;
    __syncthreads();
    moba_bias_table(p, L.sBias, h);
    __syncthreads();
    int lbase = 0;
    for (int i = 0; i < j; ++i) lbase += cnt[gi * 64 + i];
    const int n = cnt[gi * 64 + j];
    const int qi = tile * 128 + wave * 32 + (lane & 31);
    const int tsq = qi < n ? lists[(size_t)gi * S_ + lbase + qi] : -1;
    moba_block(p, L, b, h, tsq, j, 4, false, false);
  }
}

DI void phase_merge(const Params& p, int l, int bid, int nb, char* smem) {
  bf16_t* sA = (bf16_t*)smem; bf16_t* sB = sA + 128 * LDT;
  bf16_t* stash = sB + 128 * LDT;
  const int tid = tidx();
  const bf16_t* h = slab(p, 0);
  const bf16_t* wg = (const bf16_t*)(p.ws + O_WGATE); const bf16_t* pt = (const bf16_t*)(p.ws + O_PT);
  const float* bg = p.in[I_BGATE] + l * 3072;
  bf16_t* mg = slab(p, 2);
  for (int t = bid; t < 512 * 8; t += nb) {
    const int tm = t >> 3, tn = t & 7;
    f32x16 accm[1][2]; acc_zero<1>(accm);
    for (int br = 0; br < 3; ++br) {
      if ((SKIP_BR >> br) & 1) continue;
      const bf16_t* yb = slab(p, br == 0 ? 1 : (br == 1 ? 6 : 3));
      f32x16 acc[1][2]; acc_zero<1>(acc);
      gemm_core<1>(h + (size_t)tm * 64 * 1024, 1024, wg + (size_t)(br * 1024 + tn * 128) * 1024, 1024, 1024, sA, sB, acc);
      {
        const float* bgp = bg + br * 1024 + tn * 128;
        ACC_FOREACH(1, acc, { stash[((mi * 2 + ni) * 16 + i) * 256 + tid] = f2bf(sigmoidf_(v + bgp[c])); })
      }
      acc_zero<1>(acc);
      gemm_core<1>(yb + (size_t)tm * 64 * 1024, 1024, pt + (size_t)(br * 1024 + tn * 128) * 1024, 1024, 1024, sA, sB, acc);
      ACC_FOREACH(1, acc, { accm[mi][ni][i] += bf2f(stash[((mi * 2 + ni) * 16 + i) * 256 + tid]) * v; })
    }
    bf16_t* d = mg + (size_t)tm * 64 * 1024 + tn * 128;
    ACC_FOREACH(1, accm, { d[(size_t)r * 1024 + c] = f2bf(v); })
  }
}
DI void phase_wout(const Params& p, int l, int bid, int nb, char* smem) {
  bf16_t* sA = (bf16_t*)smem; bf16_t* sB = sA + 128 * LDT;
  const bf16_t* mg = slab(p, 2); const bf16_t* wo = (const bf16_t*)(p.ws + O_WOUT);
  const float* xin = l == 0 ? p.in[I_X] : p.out;
  for (int t = bid; t < 256 * 8; t += nb) {
    const int tm = t >> 3, tn = t & 7;
    f32x16 acc[2][2]; acc_zero<2>(acc);
    gemm_core<2>(mg + (size_t)tm * 128 * 1024, 1024, wo + (size_t)tn * 128 * 1024, 1024, 1024, sA, sB, acc);
    const size_t o0 = (size_t)tm * 128 * 1024 + tn * 128;
    ACC_FOREACH(2, acc, { const size_t o = o0 + (size_t)r * 1024 + c; p.out[o] = xin[o] + v; })
  }
}

DI void phase_peer_prep(const Params& p, int l, int bid, int nb) {
  rmsnorm_phase(p.out, p.in[I_N2G] + l * 1024, slab(p, 0), bid, nb);
  conv_plain(p.in[I_U] + (size_t)l * 16777216, slab(p, 1), 16777216, bid, nb);
  conv_plain(p.in[I_V] + (size_t)l * 16777216, slab(p, 1) + 16777216, 16777216, bid, nb);
}
DI void phase_peer_q(const Params& p, int bid, int nb, char* smem) {
  bf16_t* sA = (bf16_t*)smem; bf16_t* sB = sA + 128 * LDT;
  const bf16_t* h2 = slab(p, 0); const bf16_t* wq = (const bf16_t*)(p.ws + O_WQ);
  bf16_t* q = slab(p, 2);
  for (int t = bid; t < 256 * 16; t += nb) {
    const int tm = t >> 4, tn = t & 15;
    f32x16 acc[2][2]; acc_zero<2>(acc);
    gemm_core<2>(h2 + (size_t)tm * 128 * 1024, 1024, wq + (size_t)tn * 128 * 1024, 1024, 1024, sA, sB, acc);
    bf16_t* d = q + (size_t)tm * 128 * 2048 + tn * 128;
    ACC_FOREACH(2, acc, { d[(size_t)r * 2048 + c] = f2bf(v); })
  }
}
DI unsigned fkey(float f) { unsigned u = __float_as_uint(f); return (u & 0x80000000u) ? ~u : (u | 0x80000000u); }
DI void phase_peer_topk(const Params& p, int bid, int nb, char* smem) {
  bf16_t* sQ = (bf16_t*)smem;
  float* sS = (float*)smem;
  float* wsc = (float*)(smem + 66560);
  const int tid = tidx(), lane = tid & 63, wave = tid >> 6, wm = wave >> 1, wn = wave & 1, hh = lane >> 5, l31 = lane & 31;
  const bf16_t* q = slab(p, 2);
  const bf16_t* kb = (const bf16_t*)(p.ws + (wn == 0 ? O_K1 : O_K2));
  int* idx_out = (int*)slab(p, 4); float* gate_out = (float*)slab(p, 5);
  float* tv = wsc + wave * 128; int* ti = (int*)(tv + 32); float* fv = tv + 64; int* fi = (int*)(tv + 80);
  const unsigned long long ltmask = (1ull << lane) - 1ull;
  for (int task = bid; task < 4096; task += nb) {
    const int hd = task & 7, tt = task >> 3;
    const size_t t0 = (size_t)tt * 64;
    __syncthreads();
#pragma unroll
    for (int j = 0; j < 8; ++j) {
      const int ci = tid + 256 * j, r = ci >> 5, c8 = (ci & 31) * 8;
      *(uint4*)(sQ + r * 264 + c8) = *(const uint4*)(q + (t0 + r) * 2048 + hd * 256 + c8);
    }
    __syncthreads();
    f32x16 acc[4];
#pragma unroll
    for (int ni = 0; ni < 4; ++ni)
#pragma unroll
      for (int i = 0; i < 16; ++i) acc[ni][i] = 0.f;
#pragma unroll
    for (int kk = 0; kk < 8; ++kk) {
      const bf16x8 af = *(const bf16x8*)(sQ + (wm * 32 + l31) * 264 + wn * 128 + kk * 16 + hh * 8);
#pragma unroll
      for (int ni = 0; ni < 4; ++ni) {
        const bf16x8 bf = *(const bf16x8*)(kb + (size_t)(ni * 32 + l31) * 128 + kk * 16 + hh * 8);
        acc[ni] = MFMA32(af, bf, acc[ni]);
      }
    }
    __syncthreads();
#pragma unroll
    for (int ni = 0; ni < 4; ++ni)
#pragma unroll
      for (int i = 0; i < 16; ++i) sS[(wm * 32 + crow(i, hh)) * 260 + wn * 128 + ni * 32 + l31] = acc[ni][i];
    __syncthreads();
    for (int tk = 0; tk < 16; ++tk) {
      const int r = wave * 16 + tk;
#pragma unroll
      for (int side = 0; side < 2; ++side) {
        const float a0 = sS[r * 260 + side * 128 + lane], a1 = sS[r * 260 + side * 128 + 64 + lane];
        const unsigned k0 = fkey(a0), k1 = fkey(a1);
        unsigned thr = 0;
        for (int bit = 31; bit >= 0; --bit) {
          const unsigned cand = thr | (1u << bit);
          const int c = __popcll(__ballot(k0 >= cand)) + __popcll(__ballot(k1 >= cand));
          if (c >= 16) thr = cand;
          if (c == 16) break;
        }
        const unsigned long long b0 = __ballot(k0 >= thr), b1 = __ballot(k1 >= thr);
        const int p0 = __popcll(b0 & ltmask), p1 = __popcll(b0) + __popcll(b1 & ltmask);
        if (k0 >= thr && p0 < 16) { tv[side * 16 + p0] = a0; ti[side * 16 + p0] = lane; }
        if (k1 >= thr && p1 < 16) { tv[side * 16 + p1] = a1; ti[side * 16 + p1] = lane + 64; }
      }
      __syncthreads();
      float cv[4]; unsigned ck[4];
#pragma unroll
      for (int q4 = 0; q4 < 4; ++q4) { const int c = lane + 64 * q4; cv[q4] = tv[c >> 4] + tv[16 + (c & 15)]; ck[q4] = fkey(cv[q4]); }
      unsigned thr = 0;
      for (int bit = 31; bit >= 0; --bit) {
        const unsigned cand = thr | (1u << bit);
        const int c = __popcll(__ballot(ck[0] >= cand)) + __popcll(__ballot(ck[1] >= cand)) + __popcll(__ballot(ck[2] >= cand)) + __popcll(__ballot(ck[3] >= cand));
        if (c >= 16) thr = cand;
        if (c == 16) break;
      }
      int basep = 0;
#pragma unroll
      for (int q4 = 0; q4 < 4; ++q4) {
        const unsigned long long bb = __ballot(ck[q4] >= thr);
        const int pos = basep + __popcll(bb & ltmask);
        if (ck[q4] >= thr && pos < 16) { const int c = lane + 64 * q4; fv[pos] = cv[q4]; fi[pos] = ti[c >> 4] * 128 + ti[16 + (c & 15)]; }
        basep += __popcll(bb);
      }
      __syncthreads();
      if (lane < 16) {
        float mx = -3e38f;
#pragma unroll
        for (int e = 0; e < 16; ++e) mx = fmaxf(mx, fv[e]);
        float sm = 0.f;
#pragma unroll
        for (int e = 0; e < 16; ++e) sm += __expf(fv[e] - mx);
        const size_t o = ((t0 + r) * 8 + hd) * 16 + lane;
        idx_out[o] = fi[lane];
        gate_out[o] = __expf(fv[lane] - mx) / sm;
      }
      __syncthreads();
    }
  }
}
DI void phase_peer_gather(const Params& p, int bid, int nb, char* smem) {
  const int tid = tidx(), lane = tid & 63, wave = tid >> 6;
  bf16_t* sH = (bf16_t*)(smem + wave * 3072);
  int* sIdx = (int*)(smem + wave * 3072 + 2048);
  float* sCoef = (float*)(smem + wave * 3072 + 2560);
  const bf16_t* h2 = slab(p, 0);
  const bf16_t* ub = slab(p, 1); const bf16_t* vb = slab(p, 1) + 16777216;
  const int* idx = (const int*)slab(p, 4); const float* gate = (const float*)slab(p, 5);
  for (int t = bid * 4 + wave; t < T_; t += nb * 4) {
    *(uint4*)(sH + lane * 8) = *(const uint4*)(h2 + (size_t)t * 1024 + lane * 8);
    *(uint4*)(sH + 512 + lane * 8) = *(const uint4*)(h2 + (size_t)t * 1024 + 512 + lane * 8);
    sIdx[lane] = idx[(size_t)t * 128 + lane]; sIdx[lane + 64] = idx[(size_t)t * 128 + 64 + lane];
    __builtin_amdgcn_fence(__ATOMIC_RELEASE, "wavefront"); __builtin_amdgcn_wave_barrier(); __builtin_amdgcn_fence(__ATOMIC_ACQUIRE, "wavefront");
    for (int g = 0; g < 8; ++g) {
      const int e = g * 16 + (lane & 15);
      const bf16_t* urow = ub + (size_t)sIdx[e] * 1024 + (lane >> 4) * 8;
      f32x4 acc = {0.f, 0.f, 0.f, 0.f};
#pragma unroll 8
      for (int kk = 0; kk < 32; ++kk) {
        const bf16x8 af = *(const bf16x8*)(urow + kk * 32);
        const bf16x8 bf = *(const bf16x8*)(sH + kk * 32 + (lane >> 4) * 8);
        acc = MFMA16(af, bf, acc);
      }
      if ((lane & 15) == 0) {
#pragma unroll
        for (int i = 0; i < 4; ++i) {
          const int ee = g * 16 + (lane >> 4) * 4 + i;
          const float a = acc[i];
          const float ge = 0.5f * a * (1.f + erff(a * 0.7071067811865476f));
          sCoef[ee] = gate[(size_t)t * 128 + ee] * ge;
        }
      }
    }
    __builtin_amdgcn_fence(__ATOMIC_RELEASE, "wavefront"); __builtin_amdgcn_wave_barrier(); __builtin_amdgcn_fence(__ATOMIC_ACQUIRE, "wavefront");
    float o[16];
#pragma unroll
    for (int i = 0; i < 16; ++i) o[i] = 0.f;
#pragma unroll 4
    for (int e = 0; e < 128; ++e) {
      const float c = sCoef[e];
      const bf16_t* vrow = vb + (size_t)sIdx[e] * 1024;
      float f[8];
      unpack8(*(const uint4*)(vrow + lane * 8), f);
#pragma unroll
      for (int i = 0; i < 8; ++i) o[i] += c * f[i];
      unpack8(*(const uint4*)(vrow + 512 + lane * 8), f);
#pragma unroll
      for (int i = 0; i < 8; ++i) o[8 + i] += c * f[i];
    }
    float4* xo = (float4*)(p.out + (size_t)t * 1024 + lane * 8);
    float4 a = xo[0], bq = xo[1];
    a.x += o[0]; a.y += o[1]; a.z += o[2]; a.w += o[3]; bq.x += o[4]; bq.y += o[5]; bq.z += o[6]; bq.w += o[7];
    xo[0] = a; xo[1] = bq;
    float4* xo2 = (float4*)(p.out + (size_t)t * 1024 + 512 + lane * 8);
    a = xo2[0]; bq = xo2[1];
    a.x += o[8]; a.y += o[9]; a.z += o[10]; a.w += o[11]; bq.x += o[12]; bq.y += o[13]; bq.z += o[14]; bq.w += o[15];
    xo2[0] = a; xo2[1] = bq;
    __builtin_amdgcn_fence(__ATOMIC_RELEASE, "wavefront"); __builtin_amdgcn_wave_barrier(); __builtin_amdgcn_fence(__ATOMIC_ACQUIRE, "wavefront");
  }
}

constexpr int NPH = 26;
DI void run_phase(const Params& p, int l, int ph, int bid, int nb, char* smem) {
#ifdef ONLY_PH
  ph = ONLY_PH;
#endif
  switch (ph) {
    case 0: phase_prep(p, l, bid, nb, smem); break;
    case 1: {
      Route rt; rt.seg0 = 6; rt.packed = 4 | (5 << 4) | (6 << 8);
      gemm_in_phase(p, l, rt, 26, 48, 26, 0, bid, nb, smem);
    } break;
    case 2: phase_lora_prep(p, l, bid, nb); break;
    case 3: phase_lora_wa(p, l, bid, nb, smem); break;
    case 4: phase_rwkv_scan(p, l, bid, nb, smem); break;
    case 5: phase_rwkv_ln(p, l, bid, nb); break;
    case 6: phase_rwkv_g(p, l, bid, nb, smem); break;
    case 7: {
      Route rt; rt.seg0 = 0; rt.packed = 1 | (2 << 4) | (4 << 8);
      gemm_in_phase(p, l, rt, 25, 0, 24, 74, bid, nb, smem);
    } break;
    case 8: phase_ssd_conv(p, l, bid, nb); break;
    case 9: phase_ssd_states(p, l, bid, nb, smem); break;
    case 10: phase_ssd_scan(p, bid, nb); break;
    case 11: phase_ssd_out(p, l, bid, nb, smem); break;
    case 12: {
      Route rt; rt.seg0 = 3; rt.packed = 2 | (4 << 4) | (5 << 8);
      gemm_in_phase(p, l, rt, 24, 24, 24, 0, bid, nb, smem);
    } break;
    case 13: phase_moba_norm(p, l, bid, nb, smem); break;
    case 14: phase_moba_gate(p, bid, nb, smem); break;
    case 15: phase_moba_fill(p, bid, nb, smem); break;
    case 16: phase_moba_own(p, bid, nb, smem); break;
    case 17: phase_moba_past(p, 0, bid, nb, smem); break;
    case 18: phase_moba_past(p, 1, bid, nb, smem); break;
    case 19: phase_moba_past(p, 2, bid, nb, smem); break;
    case 20: phase_merge(p, l, bid, nb, smem); break;
    case 21: phase_wout(p, l, bid, nb, smem); break;
    case 22: phase_peer_prep(p, l, bid, nb); break;
    case 23: phase_peer_q(p, bid, nb, smem); break;
    case 24: phase_peer_topk(p, bid, nb, smem); break;
    case 25: phase_peer_gather(p, bid, nb, smem); break;
  }
}

#if !MULTI
#define XB_TMO      128
#define XB_XCNT(j)  (256  + 64 * (j))
#define XB_XSUB(j)  (1280 + 64 * (j))
#define XB_XGEN(j)  (2304 + 64 * (j))
#define XB_TOP      3328
#define XB_TOPGEN   3392
#define XCD_BAR_WORDS 3456
#define XB_SPIN_CAP (1u << 22)
#define LAS __attribute__((address_space(3)))
DI unsigned xb_ld(unsigned* p)              { return __hip_atomic_load(p, __ATOMIC_RELAXED, __HIP_MEMORY_SCOPE_AGENT); }
DI unsigned xb_add(unsigned* p, unsigned v) { return __hip_atomic_fetch_add(p, v, __ATOMIC_RELAXED, __HIP_MEMORY_SCOPE_AGENT); }
DI unsigned xb_xcc_id() { return (unsigned)__builtin_amdgcn_s_getreg((3 << 11) | 20) & 0xFu; }
#define XB_SPIN(cond, bar) do { unsigned _sp = 0; while (cond) { __builtin_amdgcn_s_sleep(1); \
    if ((++_sp & 255u) == 0u) { if (xb_ld(&(bar)[XB_TMO])) break; if (_sp > XB_SPIN_CAP) { atomicAdd(&(bar)[XB_TMO], 1u); break; } } } } while (0)
struct XcdBarrier { unsigned* bar; unsigned x; volatile LAS unsigned* st; };
DI XcdBarrier xcd_barrier_post(unsigned* bar, volatile LAS unsigned* st) {
  XcdBarrier b; b.bar = bar; b.x = xb_xcc_id(); b.st = st;
  if (__builtin_amdgcn_workitem_id_x() == 0) (void)xb_add(&bar[XB_XCNT(b.x)], 1u);
  return b;
}
DI void xcd_barrier_complete(unsigned* bar, unsigned x, unsigned& nloc, unsigned& nx) {
  const unsigned G = gridDim.x * gridDim.y * gridDim.z;
  unsigned sum, cnt, mine, sp = 0u;
  for (;;) {
    sum = 0u; cnt = 0u; mine = 0u;
#pragma unroll
    for (unsigned j = 0; j < 16; ++j) { const unsigned c = xb_ld(&bar[XB_XCNT(j)]); sum += c; cnt += (c > 0u) ? 1u : 0u; mine = (j == x) ? c : mine; }
    if (sum == G) break;
    __builtin_amdgcn_s_sleep(1);
    if ((++sp & 255u) == 0u) { if (xb_ld(&bar[XB_TMO])) break; if (sp > XB_SPIN_CAP) { atomicAdd(&bar[XB_TMO], 1u); break; } }
  }
  nloc = mine > 0u ? mine : 1u; nx = cnt > 0u ? cnt : 1u;
}
DI void xcd_barrier(const XcdBarrier& b) {
  asm volatile("s_waitcnt vmcnt(0)" ::: "memory");
  __syncthreads();
  if (__builtin_amdgcn_workitem_id_x() == 0) {
    unsigned* bar = b.bar;
    __builtin_amdgcn_s_waitcnt(0);
    unsigned nloc = b.st[0], nx = b.st[1];
    if (nloc == 0u) { xcd_barrier_complete(bar, b.x, nloc, nx); b.st[0] = nloc; b.st[1] = nx; }
    const unsigned old = xb_add(&bar[XB_XSUB(b.x)], 1u);
    const unsigned gen = old / nloc;
    if (old + 1u == (gen + 1u) * nloc) {
      __builtin_amdgcn_fence(__ATOMIC_RELEASE, "agent");
      asm volatile("s_waitcnt vmcnt(0)" ::: "memory");
      const unsigned og = xb_add(&bar[XB_TOP], 1u);
      const unsigned tg = og / nx;
      if (og + 1u == (tg + 1u) * nx) xb_add(&bar[XB_TOPGEN], 1u);
      else XB_SPIN(xb_ld(&bar[XB_TOPGEN]) == tg, bar);
      __builtin_amdgcn_fence(__ATOMIC_ACQUIRE, "agent");
      xb_add(&bar[XB_XGEN(b.x)], 1u);
      asm volatile("s_waitcnt vmcnt(0)" ::: "memory");
    } else {
      XB_SPIN(xb_ld(&bar[XB_XGEN(b.x)]) == gen, bar);
      __builtin_amdgcn_fence(__ATOMIC_ACQUIRE, "agent");
      asm volatile("s_waitcnt vmcnt(0)" ::: "memory");
    }
  }
  __syncthreads();
}
__global__ void __launch_bounds__(256, 2) mega(Params p) {
  __shared__ __attribute__((aligned(16))) char smem[LDS_BYTES];
  __shared__ uint4 xb_words;
  cg::grid_group grid = cg::this_grid();
  if (__builtin_amdgcn_workitem_id_x() == 0) xb_words = make_uint4(0u, 0u, 0u, 0u);
  __syncthreads();
  XcdBarrier xb = xcd_barrier_post((unsigned*)(p.ws + O_BAR), (volatile LAS unsigned*)&xb_words);
  for (int it = 0; it < 2 * NPH; ++it) {
    int itv = it; asm volatile("" : "+v"(itv));
    const int its = __builtin_amdgcn_readfirstlane(itv);
    const int l = its / NPH, ph = its % NPH;
    int bv = blockIdx.x, nv = gridDim.x; asm volatile("" : "+v"(bv), "+v"(nv));
    run_phase(p, l, ph, __builtin_amdgcn_readfirstlane(bv), __builtin_amdgcn_readfirstlane(nv), smem);
    if (it == 0) grid.sync();
    else xcd_barrier(xb);
  }
}
#else
__global__ void __launch_bounds__(256, 2) phase_kernel(Params p, int l, int ph) {
  __shared__ __attribute__((aligned(16))) char smem[LDS_BYTES];
  run_phase(p, l, ph, blockIdx.x, gridDim.x, smem);
}
#endif


#if DBG
DI int dbg_tok(int i) { return i == 0 ? 3 : (i == 1 ? 130 : (i == 2 ? 300 : 16384 + 511)); }
__global__ void __launch_bounds__(256) dbgA_kernel(Params p) {
  const int tid = tidx();
  for (size_t i = (size_t)blockIdx.x * 256 + tid; i < (size_t)T_ * 1024; i += (size_t)gridDim.x * 256) p.out[i] = p.in[I_X][i];
  if (blockIdx.x < 4) {
    const int t = dbg_tok(blockIdx.x);
    bf16_t* d = (bf16_t*)(p.ws + O_LISTS);
    for (int c = tid; c < 1024; c += 256) d[blockIdx.x * 1024 + c] = slab(p, 1)[(size_t)t * 1024 + c];
  }
}
__global__ void __launch_bounds__(256) dbgB_kernel(Params p, int l) {
  __shared__ float sred[256];
  const int tid = tidx();
  const int ti = blockIdx.x >> 2, g = blockIdx.x & 3;
  const int t = dbg_tok(ti), b = t >> 14, ts = t & (S_ - 1);
  const bf16_t* xs = slab(p, 5) + (size_t)b * S_ * 1024; const bf16_t* bc = slab(p, 6) + (size_t)b * S_ * 1024;
  const float* dt = (const float*)(p.ws + O_DT) + (size_t)b * S_ * 16;
  const bf16_t* zsave = (const bf16_t*)(p.ws + O_LISTS);
  const int ch = g * 256 + tid, head = ch >> 6;
  const float a = -__expf(p.in[I_ALOG][l * 16 + head]);
  float y = 0.f;
  for (int n = 0; n < (SSD_PROBE == 1 ? 0 : 128); ++n) {
    float h = 0.f;
    for (int s = 0; s <= ts; ++s) {
      const float d = dt[(size_t)s * 16 + head];
      h = h * __expf(d * a) + d * bf2f(bc[(size_t)s * 1024 + g * 128 + n]) * bf2f(xs[(size_t)s * 1024 + ch]);
    }
    y += bf2f(bc[(size_t)ts * 1024 + 512 + g * 128 + n]) * h;
  }
  y += p.in[I_DSKIP][l * 16 + head] * bf2f(xs[(size_t)ts * 1024 + ch]);
  y *= siluf_(bf2f(zsave[ti * 1024 + ch]));
  sred[tid] = y * y;
  __syncthreads();
  for (int o = 128; o > 0; o >>= 1) { if (tid < o) sred[tid] += sred[tid + o]; __syncthreads(); }
  const float rs = rsqrtf(sred[0] * (1.f / 256.f) + 1e-6f);
  __syncthreads();
  const float ref = DBG == 2 ? y : y * rs * p.in[I_SSDNG][l * 1024 + ch];
  const float mine = bf2f(slab(p, 1)[(size_t)t * 1024 + ch]);
  sred[tid] = fabsf(mine - ref);
  __syncthreads();
  for (int o = 128; o > 0; o >>= 1) { if (tid < o) sred[tid] = fmaxf(sred[tid], sred[tid + o]); __syncthreads(); }
  if (tid == 0) p.out[blockIdx.x] = 1000.f * sred[0] + 100.f;
}
#endif

#if DBG
__global__ void __launch_bounds__(256) dbgS_kernel(Params p, int l) {
  for (size_t i = (size_t)blockIdx.x * 256 + tidx(); i < (size_t)T_ * 1024; i += (size_t)gridDim.x * 256) {
    const int ch = (int)(i & 1023), head = ch >> 6;
    const float xv = bf2f(slab(p, 5)[i]);
    const float zv = bf2f(slab(p, 1)[i]);
    slab(p, 1)[i] = f2bf(xv * p.in[I_DSKIP][l * 16 + head] * siluf_(zv));
  }
}
#endif

extern "C" void kernel_launch(void* const* d_in, const int* in_sizes, int n_in, void* d_out, int out_size, void* d_ws, size_t ws_size,
                              hipStream_t stream) {
  Params p{};
  for (int i = 0; i < 35; ++i) p.in[i] = (const float*)d_in[i];
  p.out = (float*)d_out;
  p.ws = (char*)d_ws;
  if (ws_size < WS_END) { fprintf(stderr, "workspace too small\n"); return; }
#if MULTI
#if DBG
  for (int ph = 0; ph < 11; ++ph) hipLaunchKernelGGL(phase_kernel, dim3(512), dim3(256), 0, stream, p, 0, ph);
  hipLaunchKernelGGL(dbgA_kernel, dim3(512), dim3(256), 0, stream, p);
  hipLaunchKernelGGL(dbgS_kernel, dim3(512), dim3(256), 0, stream, p, 0);
  hipLaunchKernelGGL(dbgB_kernel, dim3(16), dim3(256), 0, stream, p, 0);
#else
  for (int l = 0; l < NLAYERS; ++l)
    for (int ph = 0; ph < (SKIP_PEER ? 22 : NPH); ++ph) hipLaunchKernelGGL(phase_kernel, dim3(512), dim3(256), 0, stream, p, l, ph);
#endif
#else
  static int grid_blocks = 0;
  if (!grid_blocks) {
    int dev = 0, cus = 0, per_cu = 0;
    (void)hipGetDevice(&dev);
    (void)hipDeviceGetAttribute(&cus, hipDeviceAttributeMultiprocessorCount, dev);
    (void)hipOccupancyMaxActiveBlocksPerMultiprocessor(&per_cu, mega, 256, 0);
    if (per_cu > 2) per_cu = 2;
    grid_blocks = cus * per_cu;
  }
  (void)hipMemsetAsync(p.ws + O_BAR, 0, 16384, stream);
  void* args[] = {&p};
  hipError_t e = hipLaunchCooperativeKernel((void*)mega, dim3(grid_blocks), dim3(256), args, 0, stream);
  if (e != hipSuccess) fprintf(stderr, "coop launch failed: %s (grid %d)\n", hipGetErrorString(e), grid_blocks);
#endif
}
```

```cpp
#include <hip/hip_runtime.h>
#include <hip/hip_cooperative_groups.h>
#include <cstdio>
#include <cstdint>
namespace cg = cooperative_groups;
#define DI __device__ __forceinline__
#ifndef MULTI
#define MULTI 0
#endif
#ifndef SKIP_BR
#define SKIP_BR 0
#endif
#ifndef SKIP_PEER
#define SKIP_PEER 0
#ifndef DBG
#define DBG 0
#endif
#ifndef SSD_PROBE
#define SSD_PROBE 0
#endif
#endif
#ifndef REPMASK
#define REPMASK 0
#endif
#ifndef NLAYERS
#define NLAYERS 2
#endif

typedef unsigned short bf16_t;
typedef __attribute__((ext_vector_type(8))) short bf16x8;
typedef __attribute__((ext_vector_type(16))) float f32x16;
typedef __attribute__((ext_vector_type(4))) float f32x4;
typedef __attribute__((ext_vector_type(4))) unsigned u32x4;
typedef __attribute__((ext_vector_type(2))) float f32x2;
#define MFMA32(a, b, c) __builtin_amdgcn_mfma_f32_32x32x16_bf16((a), (b), (c), 0, 0, 0)
#define MFMA16(a, b, c) __builtin_amdgcn_mfma_f32_16x16x32_bf16((a), (b), (c), 0, 0, 0)

constexpr int T_ = 32768, S_ = 16384;
constexpr size_t SLAB = 67108864;
constexpr int LDS_BYTES = 73728;

struct Params { const float* in[35]; float* out; char* ws; };

enum { I_X = 0, I_RELB, I_N1G, I_WIN, I_CONVW, I_CONVB, I_DTB, I_ALOG, I_DSKIP, I_SSDNG, I_QNG, I_KNG, I_MU, I_W0, I_WW2, I_A0,
       I_WA2, I_WG2, I_KK, I_KA, I_RK, I_LNG, I_LNB, I_PSSD, I_PMOBA, I_PRWKV, I_WGATE, I_BGATE, I_WOUT, I_N2G, I_WQ, I_K1, I_K2, I_U, I_V };

constexpr size_t OFF_W = 7 * SLAB;
constexpr size_t O_WIN = OFF_W;
constexpr size_t O_WGATE = O_WIN + 19660800;
constexpr size_t O_PT = O_WGATE + 6291456;
constexpr size_t O_WOUT = O_PT + 6291456;
constexpr size_t O_WQ = O_WOUT + 2097152;
constexpr size_t O_WW2 = O_WQ + 4194304;
constexpr size_t O_WA2 = O_WW2 + 131072;
constexpr size_t O_WG2 = O_WA2 + 131072;
constexpr size_t O_K1 = O_WG2 + 262144;
constexpr size_t O_K2 = O_K1 + 32768;
constexpr size_t OFF_X = O_K2 + 32768;
constexpr size_t O_DT = OFF_X;
constexpr size_t O_LACT = O_DT + 2097152;
constexpr size_t O_RB = O_LACT + 16777216;
constexpr size_t O_CDEC = O_RB + 2097152;
constexpr size_t O_KMEAN = O_CDEC + 16384;
constexpr size_t O_MM = O_KMEAN + 524288;
constexpr size_t O_ML = O_MM + 1048576;
constexpr size_t O_SEL = O_ML + 1048576;
constexpr size_t O_CNT = O_SEL + 3145728;
constexpr size_t O_FILL = O_CNT + 12288;
constexpr size_t O_LISTS = O_FILL + 12288;
constexpr size_t O_BAR = O_LISTS + 3145728;
constexpr size_t WS_END = O_BAR + 16384;

DI bf16_t* slab(const Params& p, int i) { return (bf16_t*)(p.ws + (size_t)i * SLAB); }

DI bf16_t f2bf(float x) { unsigned u = __float_as_uint(x); u += 0x7fffu + ((u >> 16) & 1u); return (bf16_t)(u >> 16); }
DI float bf2f(bf16_t b) { return __uint_as_float(((unsigned)b) << 16); }
DI unsigned pack2(float a, float b) { return (unsigned)f2bf(a) | ((unsigned)f2bf(b) << 16); }
DI float lo16(unsigned u) { return __uint_as_float(u << 16); }
DI float hi16(unsigned u) { return __uint_as_float(u & 0xffff0000u); }
DI bf16_t get16(const uint4& v, int e) { const unsigned w = (e >> 1) == 0 ? v.x : ((e >> 1) == 1 ? v.y : ((e >> 1) == 2 ? v.z : v.w)); return (bf16_t)((e & 1) ? (w >> 16) : (w & 0xffffu)); }
DI void unpack8(const uint4& v, float* f) {
  f[0] = lo16(v.x); f[1] = hi16(v.x); f[2] = lo16(v.y); f[3] = hi16(v.y);
  f[4] = lo16(v.z); f[5] = hi16(v.z); f[6] = lo16(v.w); f[7] = hi16(v.w);
}
DI uint4 pack8(const float* f) { uint4 v; v.x = pack2(f[0], f[1]); v.y = pack2(f[2], f[3]); v.z = pack2(f[4], f[5]); v.w = pack2(f[6], f[7]); return v; }
DI float sigmoidf_(float x) { return 1.f / (1.f + __expf(-x)); }
DI float softplusf_(float x) { return fmaxf(x, 0.f) + log1pf(__expf(-fabsf(x))); }
DI float siluf_(float x) { return x / (1.f + __expf(-x)); }
DI float wave_sum(float v) { for (int o = 32; o > 0; o >>= 1) v += __shfl_xor(v, o); return v; }
template <int CTRL> DI float dpp_add(float x) {
  int y = __builtin_amdgcn_update_dpp(0, __float_as_int(x), CTRL, 0xf, 0xf, true);
  return x + __int_as_float(y);
}
DI float red8(float x) { x = dpp_add<0xB1>(x); x = dpp_add<0x4E>(x); x = dpp_add<0x141>(x); return x; }
DI float red16(float x) { x = red8(x); x = dpp_add<0x140>(x); return x; }
DI int tidx() { int t = __builtin_amdgcn_workitem_id_x(); asm volatile("" : "+v"(t)); return t; }
DI int crow(int i, int h) { return (i & 3) + 8 * (i >> 2) + 4 * h; }

constexpr int LDT = 72;
template <int MI>
DI void gemm_core(const bf16_t* __restrict__ A, int lda, const bf16_t* __restrict__ Bt, int ldb, int K,
                  bf16_t* sA, bf16_t* sB, f32x16 (&acc)[MI][2]) {
  const int tid = tidx(), lane = tid & 63, wave = tid >> 6, wm = wave >> 1, wn = wave & 1;
  u32x4 ra[2 * MI], rb[4];
#pragma unroll
  for (int j = 0; j < 2 * MI; ++j) { const int c = tid + 256 * j; ra[j] = *(const u32x4*)(A + (size_t)(c >> 3) * lda + (c & 7) * 8); }
#pragma unroll
  for (int j = 0; j < 4; ++j) { const int c = tid + 256 * j; rb[j] = *(const u32x4*)(Bt + (size_t)(c >> 3) * ldb + (c & 7) * 8); }
  for (int k0 = 0; k0 < K; k0 += 64) {
#pragma unroll
    for (int j = 0; j < 2 * MI; ++j) { const int c = tid + 256 * j; *(u32x4*)(sA + (c >> 3) * LDT + (c & 7) * 8) = ra[j]; }
#pragma unroll
    for (int j = 0; j < 4; ++j) { const int c = tid + 256 * j; *(u32x4*)(sB + (c >> 3) * LDT + (c & 7) * 8) = rb[j]; }
    __syncthreads();
    const int kn = (k0 + 64 < K) ? k0 + 64 : k0;
#pragma unroll
    for (int j = 0; j < 2 * MI; ++j) { const int c = tid + 256 * j; ra[j] = *(const u32x4*)(A + (size_t)(c >> 3) * lda + kn + (c & 7) * 8); }
#pragma unroll
    for (int j = 0; j < 4; ++j) { const int c = tid + 256 * j; rb[j] = *(const u32x4*)(Bt + (size_t)(c >> 3) * ldb + kn + (c & 7) * 8); }
#pragma unroll
    for (int kk = 0; kk < 4; ++kk) {
      bf16x8 af[MI], bfr[2];
#pragma unroll
      for (int mi = 0; mi < MI; ++mi) af[mi] = *(const bf16x8*)(sA + (wm * 32 * MI + mi * 32 + (lane & 31)) * LDT + kk * 16 + (lane >> 5) * 8);
#pragma unroll
      for (int ni = 0; ni < 2; ++ni) bfr[ni] = *(const bf16x8*)(sB + (wn * 64 + ni * 32 + (lane & 31)) * LDT + kk * 16 + (lane >> 5) * 8);
#pragma unroll
      for (int mi = 0; mi < MI; ++mi)
#pragma unroll
        for (int ni = 0; ni < 2; ++ni) acc[mi][ni] = MFMA32(af[mi], bfr[ni], acc[mi][ni]);
    }
    __syncthreads();
  }
}
template <int MI> DI void acc_zero(f32x16 (&acc)[MI][2]) {
#pragma unroll
  for (int mi = 0; mi < MI; ++mi)
#pragma unroll
    for (int ni = 0; ni < 2; ++ni)
#pragma unroll
      for (int i = 0; i < 16; ++i) acc[mi][ni][i] = 0.f;
}
#define ACC_FOREACH(MI, acc, BODY)                                                        \
  {                                                                                       \
    int lane_ = tidx() & 63; asm volatile("" : "+v"(lane_));                        \
    const int wave_ = tidx() >> 6, wm_ = wave_ >> 1, wn_ = wave_ & 1;                \
    _Pragma("unroll") for (int mi = 0; mi < MI; ++mi)                                     \
    _Pragma("unroll") for (int ni = 0; ni < 2; ++ni)                                      \
    _Pragma("unroll") for (int i = 0; i < 16; ++i) {                                      \
      const int r = wm_ * 32 * MI + mi * 32 + crow(i, lane_ >> 5);                        \
      const int c = wn_ * 64 + ni * 32 + (lane_ & 31);                                    \
      const float v = acc[mi][ni][i];                                                       \
      BODY                                                                                \
    }                                                                                     \
  }

DI void tconv_job(const float* __restrict__ src, int ld, int K, int c0, int ncols, bf16_t* __restrict__ dst, int bid, int nb, float* sT) {
  const int ntn = (ncols + 63) >> 6, ntk = K >> 6, tid = tidx();
  for (int t = bid; t < ntn * ntk; t += nb) {
    const int tk = t % ntk, tn = t / ntk;
    const int kr = tid >> 4, nx = (tid & 15) * 4;
#pragma unroll
    for (int j = 0; j < 4; ++j) {
      const int k = kr + 16 * j;
      const float* s = src + (size_t)(tk * 64 + k) * ld + c0 + tn * 64 + nx;
      float4 v;
      if (tn * 64 + nx + 3 < ncols) v = *(const float4*)s;
      else { v.x = (tn * 64 + nx < ncols) ? s[0] : 0.f; v.y = (tn * 64 + nx + 1 < ncols) ? s[1] : 0.f; v.z = (tn * 64 + nx + 2 < ncols) ? s[2] : 0.f; v.w = 0.f; }
      sT[k * 65 + nx] = v.x; sT[k * 65 + nx + 1] = v.y; sT[k * 65 + nx + 2] = v.z; sT[k * 65 + nx + 3] = v.w;
    }
    __syncthreads();
    const int n = tid >> 2, kq = tid & 3;
    if (tn * 64 + n < ncols) {
      float f[16];
#pragma unroll
      for (int j = 0; j < 16; ++j) f[j] = sT[(kq * 16 + j) * 65 + n];
      uint4* d = (uint4*)(dst + (size_t)(tn * 64 + n) * K + tk * 64 + kq * 16);
      d[0] = pack8(f); d[1] = pack8(f + 8);
    }
    __syncthreads();
  }
}
DI void conv_plain(const float* __restrict__ src, bf16_t* __restrict__ dst, size_t n, int bid, int nb) {
  size_t i = ((size_t)bid * 256 + tidx()), st = (size_t)nb * 256;
  for (; i < n / 8; i += st) {
    float4 a = ((const float4*)src)[2 * i], b = ((const float4*)src)[2 * i + 1];
    uint4 o; o.x = pack2(a.x, a.y); o.y = pack2(a.z, a.w); o.z = pack2(b.x, b.y); o.w = pack2(b.z, b.w);
    ((uint4*)dst)[i] = o;
  }
}
DI void conv_fp8(const float* __restrict__ src, unsigned char* __restrict__ dst, size_t n, float scale, int bid, int nb) {
  size_t i = ((size_t)bid * 256 + tidx()), st = (size_t)nb * 256;
  for (; i < n / 16; i += st) {
    const float4* sp = (const float4*)src + 4 * i;
    u32x4 o;
#pragma unroll
    for (int j = 0; j < 4; ++j) {
      const float4 a = sp[j];
      int w = 0;
      w = __builtin_amdgcn_cvt_pk_fp8_f32(a.x * scale, a.y * scale, w, false);
      w = __builtin_amdgcn_cvt_pk_fp8_f32(a.z * scale, a.w * scale, w, true);
      o[j] = (unsigned)w;
    }
    ((u32x4*)dst)[i] = o;
  }
}
DI void rmsnorm_phase(const float* __restrict__ x, const float* __restrict__ g, bf16_t* __restrict__ h, int bid, int nb) {
  const int wave = tidx() >> 6, lane = tidx() & 63;
  for (int row = bid * 4 + wave; row < T_; row += nb * 4) {
    const float4* xr = (const float4*)(x + (size_t)row * 1024);
    float4 v[4]; float ss = 0.f;
#pragma unroll
    for (int j = 0; j < 4; ++j) { v[j] = xr[lane + 64 * j]; ss += v[j].x * v[j].x + v[j].y * v[j].y + v[j].z * v[j].z + v[j].w * v[j].w; }
    ss = wave_sum(ss);
    const float r = rsqrtf(ss * (1.f / 1024.f) + 1e-6f);
#pragma unroll
    for (int j = 0; j < 4; ++j) {
      float4 g4 = ((const float4*)g)[lane + 64 * j];
      uint2 o; o.x = pack2(v[j].x * r * g4.x, v[j].y * r * g4.y); o.y = pack2(v[j].z * r * g4.z, v[j].w * r * g4.w);
      ((uint2*)(h + (size_t)row * 1024))[lane + 64 * j] = o;
    }
  }
}
DI void phase_prep(const Params& p, int l, int bid, int nb, char* smem) {
  float* sT = (float*)smem;
  char* ws = p.ws;
  const float* win = p.in[I_WIN] + (size_t)l * 1024 * 9488;
  bf16_t* wt_in = (bf16_t*)(ws + O_WIN);
  tconv_job(win, 9488, 1024, 0, 3072, wt_in, bid, nb, sT);
  tconv_job(win, 9488, 1024, 3088, 6400, wt_in + (size_t)3072 * 1024, bid, nb, sT);
  tconv_job(win, 9488, 1024, 3072, 16, wt_in + (size_t)9472 * 1024, bid, nb, sT);
  {
    uint4 z = {0, 0, 0, 0};
    uint4* d = (uint4*)(wt_in + (size_t)9488 * 1024);
    for (int i = bid * 256 + tidx(); i < 112 * 1024 / 8; i += nb * 256) d[i] = z;
  }
  tconv_job(p.in[I_WGATE] + (size_t)l * 1024 * 3072, 3072, 1024, 0, 3072, (bf16_t*)(ws + O_WGATE), bid, nb, sT);
  tconv_job(p.in[I_PSSD] + (size_t)l * 1048576, 1024, 1024, 0, 1024, (bf16_t*)(ws + O_PT), bid, nb, sT);
  tconv_job(p.in[I_PMOBA] + (size_t)l * 1048576, 1024, 1024, 0, 1024, (bf16_t*)(ws + O_PT) + 1048576, bid, nb, sT);
  tconv_job(p.in[I_PRWKV] + (size_t)l * 1048576, 1024, 1024, 0, 1024, (bf16_t*)(ws + O_PT) + 2 * 1048576, bid, nb, sT);
  tconv_job(p.in[I_WOUT] + (size_t)l * 1048576, 1024, 1024, 0, 1024, (bf16_t*)(ws + O_WOUT), bid, nb, sT);
  tconv_job(p.in[I_WQ] + (size_t)l * 1024 * 2048, 2048, 1024, 0, 2048, (bf16_t*)(ws + O_WQ), bid, nb, sT);
  tconv_job(p.in[I_WW2] + (size_t)l * 64 * 1024, 1024, 64, 0, 1024, (bf16_t*)(ws + O_WW2), bid, nb, sT);
  tconv_job(p.in[I_WA2] + (size_t)l * 64 * 1024, 1024, 64, 0, 1024, (bf16_t*)(ws + O_WA2), bid, nb, sT);
  tconv_job(p.in[I_WG2] + (size_t)l * 128 * 1024, 1024, 128, 0, 1024, (bf16_t*)(ws + O_WG2), bid, nb, sT);
  conv_plain(p.in[I_K1] + (size_t)l * 16384, (bf16_t*)(ws + O_K1), 16384, bid, nb);
  conv_plain(p.in[I_K2] + (size_t)l * 16384, (bf16_t*)(ws + O_K2), 16384, bid, nb);
  { int* cz = (int*)(ws + O_CNT); for (int i = bid * 256 + tidx(); i < 2 * 3072; i += nb * 256) cz[i] = 0; }
  const float* xin = l == 0 ? p.in[I_X] : p.out;
  rmsnorm_phase(xin, p.in[I_N1G] + l * 1024, slab(p, 0), bid, nb);
}

struct Route { int packed; int seg0; };
DI void gemm_in_phase(const Params& p, int l, const Route rt, int nt, int t0a, int t0b_from, int t0b, int bid, int nb, char* smem) {
  bf16_t* sA = (bf16_t*)smem; bf16_t* sB = sA + 128 * LDT;
  const bf16_t* h = slab(p, 0);
  const bf16_t* wt = (const bf16_t*)(p.ws + O_WIN);
  bf16_t* lora = slab(p, 3); float* dtp = (float*)(p.ws + O_DT); const float* dtb = p.in[I_DTB] + l * 16;
  for (int t = bid; t < 256 * nt; t += nb) {
    const int tm = t / nt, tl = t % nt;
    const int tn = tl < t0b_from ? t0a + tl : t0b + (tl - t0b_from);
    f32x16 acc[2][2]; acc_zero<2>(acc);
    gemm_core<2>(h + (size_t)tm * 128 * 1024, 1024, wt + (size_t)tn * 128 * 1024, 1024, 1024, sA, sB, acc);
    const int row0 = tm * 128, col0 = tn * 128, seg = col0 >> 10;
    if (seg < 9) {
      bf16_t* d = slab(p, (rt.packed >> (4 * (seg - rt.seg0))) & 15) + (size_t)row0 * 1024 + (col0 & 1023);
      ACC_FOREACH(2, acc, { d[(size_t)r * 1024 + c] = f2bf(v); })
    } else {
      const int cc0 = col0 - 9216;
      ACC_FOREACH(2, acc, {
        const int cc = cc0 + c;
        if (cc < 256) lora[(size_t)(row0 + r) * 256 + cc] = f2bf(v);
        else if (cc < 272) dtp[(size_t)(row0 + r) * 16 + (cc - 256)] = softplusf_(v + dtb[cc - 256]);
      })
    }
  }
}

DI void phase_lora_prep(const Params& p, int l, int bid, int nb) {
  const bf16_t* raw = slab(p, 3);
  bf16_t* act = (bf16_t*)(p.ws + O_LACT);
  const float* mu = p.in[I_MU] + l * 3328 + 3072;
  for (int it = bid * 256 + tidx(); it < T_ * 32; it += nb * 256) {
    const int t = it >> 5, c8 = (it & 31) * 8;
    uint4 cur = *(const uint4*)(raw + (size_t)t * 256 + c8);
    uint4 prv = {0, 0, 0, 0};
    if (t & (S_ - 1)) prv = *(const uint4*)(raw + (size_t)(t - 1) * 256 + c8);
    float x[8], xp[8], o[8];
    unpack8(cur, x); unpack8(prv, xp);
#pragma unroll
    for (int e = 0; e < 8; ++e) {
      const int j = c8 + e;
      const float xs = x[e] + (xp[e] - x[e]) * mu[j];
      o[e] = j < 64 ? tanhf(xs) : (j < 128 ? xs : sigmoidf_(xs));
    }
    *(uint4*)(act + (size_t)t * 256 + c8) = pack8(o);
  }
}
template <class F>
DI void gemm_lora_phase(const Params& p, int aoff, int K, const bf16_t* wt, int bid, int nb, char* smem, F epi) {
  bf16_t* sA = (bf16_t*)smem; bf16_t* sB = sA + 128 * LDT;
  const bf16_t* A = (const bf16_t*)(p.ws + O_LACT) + aoff;
  for (int t = bid; t < 256 * 8; t += nb) {
    const int tm = t >> 3, tn = t & 7;
    f32x16 acc[2][2]; acc_zero<2>(acc);
    gemm_core<2>(A + (size_t)tm * 128 * 256, 256, wt + (size_t)tn * 128 * K, K, K, sA, sB, acc);
    const int row0 = tm * 128, col0 = tn * 128;
    ACC_FOREACH(2, acc, { epi(row0 + r, col0 + c, v); })
  }
}
DI void phase_lora_wa(const Params& p, int l, int bid, int nb, char* smem) {
  const float* w0 = p.in[I_W0] + l * 1024; const float* a0 = p.in[I_A0] + l * 1024;
  bf16_t* ew = slab(p, 1); bf16_t* av = slab(p, 2);
  gemm_lora_phase(p, 0, 64, (const bf16_t*)(p.ws + O_WW2), bid, nb, smem, [&](int r, int c, float v) {
    const float wpre = w0[c] + v;
    const float w = -softplusf_(-wpre) - 0.5f;
    ew[(size_t)r * 1024 + c] = f2bf(__expf(w));
  });
  gemm_lora_phase(p, 64, 64, (const bf16_t*)(p.ws + O_WA2), bid, nb, smem, [&](int r, int c, float v) {
    av[(size_t)r * 1024 + c] = f2bf(sigmoidf_(a0[c] + v));
  });
}
DI void phase_rwkv_scan(const Params& p, int l, int bid, int nb, char* smem) {
  float* sa = (float*)smem; float* sw = sa + 2048; float* sb = sw + 2048; float* sk = sb + 2048; float* sr = sk + 2048;
  float* sv = sr + 2048; float* sy = sv + 512;
  const int tid = tidx(), lane = tid & 63, wave = tid >> 6;
  const bf16_t* R = slab(p, 4); const bf16_t* Kx = slab(p, 5); const bf16_t* V = slab(p, 6);
  const bf16_t* EW = slab(p, 1); const bf16_t* AV = slab(p, 2);
  bf16_t* Y = slab(p, 3);
  float* rbout = (float*)(p.ws + O_RB);
  for (int task = bid; task < 256; task += nb) {
    const int qd = task & 7, head = (task >> 3) & 15, b = task >> 7;
    const int st = tid >> 3, c8 = tid & 7, ch0 = head * 64 + c8 * 8;
    float mur[8], muk[8], muv[8], ckk[8], cka[8], crk[8];
#pragma unroll
    for (int e = 0; e < 8; ++e) {
      mur[e] = p.in[I_MU][l * 3328 + ch0 + e]; muk[e] = p.in[I_MU][l * 3328 + 1024 + ch0 + e]; muv[e] = p.in[I_MU][l * 3328 + 2048 + ch0 + e];
      ckk[e] = p.in[I_KK][l * 1024 + ch0 + e]; cka[e] = p.in[I_KA][l * 1024 + ch0 + e]; crk[e] = p.in[I_RK][l * 1024 + ch0 + e];
    }
    uint4 gr, gk, gv, gw, ga, gpr, gpk, gpv;
    auto gload = [&](int c) {
      const int ts = c * 32 + st;
      const size_t o = ((size_t)b * S_ + ts) * 1024 + ch0;
      gr = *(const uint4*)(R + o); gk = *(const uint4*)(Kx + o); gv = *(const uint4*)(V + o);
      gw = *(const uint4*)(EW + o); ga = *(const uint4*)(AV + o);
      if (ts > 0) { gpr = *(const uint4*)(R + o - 1024); gpk = *(const uint4*)(Kx + o - 1024); gpv = *(const uint4*)(V + o - 1024); }
      else { gpr = make_uint4(0, 0, 0, 0); gpk = gpr; gpv = gpr; }
    };
    auto stage = [&](int c) {
      float r[8], k[8], v[8], w[8], a[8], pr[8], pk[8], pv[8];
      unpack8(gr, r); unpack8(gk, k); unpack8(gv, v); unpack8(gw, w); unpack8(ga, a); unpack8(gpr, pr); unpack8(gpk, pk); unpack8(gpv, pv);
      float kk[8], ss = 0.f, rbs = 0.f;
#pragma unroll
      for (int e = 0; e < 8; ++e) {
        r[e] = r[e] + (pr[e] - r[e]) * mur[e];
        k[e] = k[e] + (pk[e] - k[e]) * muk[e];
        v[e] = v[e] + (pv[e] - v[e]) * muv[e];
        kk[e] = k[e] * ckk[e]; ss += kk[e] * kk[e];
      }
      ss = red8(ss);
      const float inv = rsqrtf(fmaxf(ss, 1e-12f));
      float oa[8], ow[8], ob[8], ok[8];
#pragma unroll
      for (int e = 0; e < 8; ++e) {
        kk[e] *= inv;
        ok[e] = k[e] * (1.f + (a[e] - 1.f) * cka[e]);
        oa[e] = -kk[e]; ob[e] = kk[e] * a[e]; ow[e] = __expf(-w[e]);
        rbs += r[e] * ok[e] * crk[e];
      }
      rbs = red8(rbs);
      float* d;
      d = sa + st * 64 + c8 * 8; *(float4*)d = make_float4(oa[0], oa[1], oa[2], oa[3]); *(float4*)(d + 4) = make_float4(oa[4], oa[5], oa[6], oa[7]);
      d = sw + st * 64 + c8 * 8; *(float4*)d = make_float4(ow[0], ow[1], ow[2], ow[3]); *(float4*)(d + 4) = make_float4(ow[4], ow[5], ow[6], ow[7]);
      d = sb + st * 64 + c8 * 8; *(float4*)d = make_float4(ob[0], ob[1], ob[2], ob[3]); *(float4*)(d + 4) = make_float4(ob[4], ob[5], ob[6], ob[7]);
      d = sk + st * 64 + c8 * 8; *(float4*)d = make_float4(ok[0], ok[1], ok[2], ok[3]); *(float4*)(d + 4) = make_float4(ok[4], ok[5], ok[6], ok[7]);
      d = sr + st * 64 + c8 * 8; *(float4*)d = make_float4(r[0], r[1], r[2], r[3]); *(float4*)(d + 4) = make_float4(r[4], r[5], r[6], r[7]);
      if (c8 == qd) {
        d = sv + st * 8; *(float4*)d = make_float4(v[0], v[1], v[2], v[3]); *(float4*)(d + 4) = make_float4(v[4], v[5], v[6], v[7]);
      }
      if (qd == 0 && c8 == 0) rbout[((size_t)b * S_ + c * 32 + st) * 16 + head] = rbs;
    };
    const int rowl = (wave & 1) * 4 + (lane >> 4), pp = lane & 15;
    f32x2 st01 = {0.f, 0.f}, st23 = {0.f, 0.f};
    gload(0);
    __syncthreads();
    stage(0);
    __syncthreads();
    for (int c = 0; c < 512; ++c) {
      if (c + 1 < 512) gload(c + 1);
      float yk0 = 0.f, yk1 = 0.f;
      f32x4 a4 = *(const f32x4*)(sa + 4 * pp), w4 = *(const f32x4*)(sw + 4 * pp), b4 = *(const f32x4*)(sb + 4 * pp);
      f32x4 k4 = *(const f32x4*)(sk + 4 * pp), r4 = *(const f32x4*)(sr + 4 * pp);
      float vv = sv[rowl];
      if (wave < 2) {
#pragma unroll
      for (int s = 0; s < 32; ++s) {
        f32x4 a4n = a4, w4n = w4, b4n = b4, k4n = k4, r4n = r4; float vvn = vv;
        if (s + 1 < 32) {
          a4n = *(const f32x4*)(sa + (s + 1) * 64 + 4 * pp); w4n = *(const f32x4*)(sw + (s + 1) * 64 + 4 * pp);
          b4n = *(const f32x4*)(sb + (s + 1) * 64 + 4 * pp); k4n = *(const f32x4*)(sk + (s + 1) * 64 + 4 * pp);
          r4n = *(const f32x4*)(sr + (s + 1) * 64 + 4 * pp); vvn = sv[(s + 1) * 8 + rowl];
        }
        f32x2 t = st01 * a4.xy + st23 * a4.zw;
        float d = red16(t.x + t.y);
        st01 = st01 * w4.xy + b4.xy * d + k4.xy * vv;
        st23 = st23 * w4.zw + b4.zw * d + k4.zw * vv;
        f32x2 u = st01 * r4.xy + st23 * r4.zw;
        const float y = red16(u.x + u.y);
        if (s < 16) yk0 = (pp == s) ? y : yk0; else yk1 = (pp == s - 16) ? y : yk1;
        a4 = a4n; w4 = w4n; b4 = b4n; k4 = k4n; r4 = r4n; vv = vvn;
      }
      sy[pp * 8 + rowl] = yk0; sy[(pp + 16) * 8 + rowl] = yk1;
      }
      __syncthreads();
      if (tid < 32) {
        float f[8];
#pragma unroll
        for (int e = 0; e < 8; ++e) f[e] = sy[tid * 8 + e];
        *(uint4*)(Y + ((size_t)b * S_ + c * 32 + tid) * 1024 + head * 64 + qd * 8) = pack8(f);
      }
      if (c + 1 < 512) stage(c + 1);
      __syncthreads();
    }
  }
}
DI void phase_rwkv_ln(const Params& p, int l, int bid, int nb) {
  bf16_t* Y = slab(p, 3); const bf16_t* V = slab(p, 6);
  const float* rb = (const float*)(p.ws + O_RB);
  const float* lng = p.in[I_LNG] + l * 1024; const float* lnb = p.in[I_LNB] + l * 1024; const float* muv = p.in[I_MU] + l * 3328 + 2048;
  for (int it = bid * 256 + tidx(); it < T_ * 128; it += nb * 256) {
    const int t = it >> 7, c8 = (it & 127) * 8, head = c8 >> 6;
    float y[8], v[8], pv[8], o[8];
    unpack8(*(const uint4*)(Y + (size_t)t * 1024 + c8), y);
    unpack8(*(const uint4*)(V + (size_t)t * 1024 + c8), v);
    uint4 pz = {0, 0, 0, 0};
    if (t & (S_ - 1)) pz = *(const uint4*)(V + (size_t)(t - 1) * 1024 + c8);
    unpack8(pz, pv);
    float s = 0.f;
#pragma unroll
    for (int e = 0; e < 8; ++e) s += y[e];
    s = red8(s);
    const float mean = s * (1.f / 64.f);
    float q = 0.f;
#pragma unroll
    for (int e = 0; e < 8; ++e) { const float d = y[e] - mean; q += d * d; }
    q = red8(q);
    const float rstd = rsqrtf(q * (1.f / 64.f) + 64e-5f);
    const float rbv = rb[(size_t)t * 16 + head];
#pragma unroll
    for (int e = 0; e < 8; ++e) {
      const float vs = v[e] + (pv[e] - v[e]) * muv[c8 + e];
      o[e] = (y[e] - mean) * rstd * lng[c8 + e] + lnb[c8 + e] + rbv * vs;
    }
    *(uint4*)(Y + (size_t)t * 1024 + c8) = pack8(o);
  }
}
DI void phase_rwkv_g(const Params& p, int l, int bid, int nb, char* smem) {
  bf16_t* Y = slab(p, 3);
  gemm_lora_phase(p, 128, 128, (const bf16_t*)(p.ws + O_WG2), bid, nb, smem, [&](int r, int c, float v) {
    const size_t o = (size_t)r * 1024 + c;
    Y[o] = f2bf(bf2f(Y[o]) * v);
  });
}

DI void phase_ssd_conv(const Params& p, int l, int bid, int nb) {
  const bf16_t* rx = slab(p, 2); const bf16_t* rbc = slab(p, 4);
  bf16_t* xs = slab(p, 5); bf16_t* bc = slab(p, 6);
  const float* cw = p.in[I_CONVW] + l * 4 * 2048; const float* cb = p.in[I_CONVB] + l * 2048;
  for (int it = bid * 256 + tidx(); it < T_ * 256; it += nb * 256) {
    const int t = it >> 8, c8 = (it & 255) * 8;
    const bf16_t* src = c8 < 1024 ? rx : rbc; bf16_t* dst = c8 < 1024 ? xs : bc;
    const int cc = c8 & 1023, ts = t & (S_ - 1);
    float acc[8];
#pragma unroll
    for (int e = 0; e < 8; ++e) acc[e] = cb[c8 + e];
#pragma unroll
    for (int k = 0; k < 4; ++k) {
      if (ts - 3 + k >= 0) {
        float x[8]; unpack8(*(const uint4*)(src + (size_t)(t - 3 + k) * 1024 + cc), x);
#pragma unroll
        for (int e = 0; e < 8; ++e) acc[e] += x[e] * cw[k * 2048 + c8 + e];
      }
    }
#pragma unroll
    for (int e = 0; e < 8; ++e) acc[e] = siluf_(acc[e]);
    *(uint4*)(dst + (size_t)t * 1024 + cc) = pack8(acc);
  }
}
DI float* scan128(float* a, float* b) {
  const int tid = tidx();
  float* src = a; float* dst = b;
  for (int off = 1; off < 128; off <<= 1) {
    if (tid < 128) dst[tid] = src[tid] + (tid >= off ? src[tid - off] : 0.f);
    __syncthreads();
    float* t = src; src = dst; dst = t;
  }
  return src;
}
DI void phase_ssd_states(const Params& p, int l, int bid, int nb, char* smem) {
  bf16_t* sXT = (bf16_t*)smem;
  bf16_t* sBT = sXT + 64 * 136;
  float* fa = (float*)(sBT + 128 * 136);
  float* fb = fa + 128; float* fdt = fb + 128;
  const int tid = tidx(), lane = tid & 63, wave = tid >> 6;
  const bf16_t* xs = slab(p, 5); const bf16_t* bc = slab(p, 6);
  const float* dt = (const float*)(p.ws + O_DT);
  float* cdec = (float*)(p.ws + O_CDEC);
  for (int task = bid; task < 4096; task += nb) {
    const int head = task & 15, c = (task >> 4) & 127, b = task >> 11, g = head >> 2;
    const size_t t0 = (size_t)b * S_ + c * 128;
    const float aneg = -__expf(p.in[I_ALOG][l * 16 + head]);
    __syncthreads();
    if (tid < 128) { const float d = dt[(t0 + tid) * 16 + head]; fdt[tid] = d; fa[tid] = d * aneg; }
    __syncthreads();
    float* acs = scan128(fa, fb);
    const float alast = acs[127];
    if (tid == 0) cdec[(b * 128 + c) * 16 + head] = __expf(alast);
#pragma unroll
    for (int j = 0; j < 4; ++j) {
      const int ci = tid + 256 * j, lr = ci >> 3, p8 = (ci & 7) * 8;
      float x[8]; unpack8(*(const uint4*)(xs + (t0 + lr) * 1024 + head * 64 + p8), x);
      const float sc = fdt[lr] * __expf(alast - acs[lr]);
#pragma unroll
      for (int e = 0; e < 8; ++e) sXT[(p8 + e) * 136 + lr] = f2bf(x[e] * sc);
    }
#pragma unroll
    for (int j = 0; j < 8; ++j) {
      const int ci = tid + 256 * j, lr = ci >> 4, n8 = (ci & 15) * 8;
      const uint4 u = *(const uint4*)(bc + (t0 + lr) * 1024 + g * 128 + n8);
#pragma unroll
      for (int e = 0; e < 8; ++e) sBT[(n8 + e) * 136 + lr] = get16(u, e);
    }
    __syncthreads();
    f32x16 acc[2];
#pragma unroll
    for (int mi = 0; mi < 2; ++mi)
#pragma unroll
      for (int i = 0; i < 16; ++i) acc[mi][i] = 0.f;
#pragma unroll
    for (int kk = 0; kk < 8; ++kk) {
      const bf16x8 bf = *(const bf16x8*)(sBT + (wave * 32 + (lane & 31)) * 136 + kk * 16 + (lane >> 5) * 8);
#pragma unroll
      for (int mi = 0; mi < 2; ++mi) {
        const bf16x8 af = *(const bf16x8*)(sXT + (mi * 32 + (lane & 31)) * 136 + kk * 16 + (lane >> 5) * 8);
        acc[mi] = MFMA32(af, bf, acc[mi]);
      }
    }
    float* st = (float*)slab(p, b == 0 ? 2 : 4) + ((size_t)(c * 16 + head) * 64) * 128;
#pragma unroll
    for (int mi = 0; mi < 2; ++mi)
#pragma unroll
      for (int i = 0; i < 16; ++i) st[(size_t)(mi * 32 + crow(i, lane >> 5)) * 128 + wave * 32 + (lane & 31)] = acc[mi][i];
  }
}
DI void phase_ssd_scan(const Params& p, int bid, int nb) {
  const float* cdec = (const float*)(p.ws + O_CDEC);
  for (int it = bid * 256 + tidx(); it < 2 * 16 * 8192; it += nb * 256) {
    const int b = it >> 17, rem = it & 131071, head = rem >> 13;
    float* st = (float*)slab(p, b == 0 ? 2 : 4) + rem;
    float h = 0.f;
#pragma unroll 8
    for (int c = 0; c < 128; ++c) {
      const float s = st[(size_t)c * 131072];
      st[(size_t)c * 131072] = h;
      h = h * cdec[(b * 128 + c) * 16 + head] + s;
    }
  }
}
DI void phase_ssd_out(const Params& p, int l, int bid, int nb, char* smem) {
  bf16_t* sM = (bf16_t*)smem;
  bf16_t* sXT = sM + 128 * 136;
  float* fa = (float*)(sXT + 64 * 136); float* fb = fa + 128; float* fdt = fb + 128; float* frs = fdt + 128;
  const int tid_ = tidx(), lane = tid_ & 63, wave_ = __builtin_amdgcn_readfirstlane(tid_ >> 6), hh_ = lane >> 5, l31_ = lane & 31;
  const bf16_t* xs = slab(p, 5); const bf16_t* bc = slab(p, 6);
  bf16_t* zy = slab(p, 1);
  const float* dt = (const float*)(p.ws + O_DT);
  const float* ng = p.in[I_SSDNG] + l * 1024;
  for (int task = bid; task < 1024; task += nb) {
    const int g = task & 3, c = (task >> 2) & 127, b = task >> 9;
    const size_t t0 = (size_t)b * S_ + c * 128;
    int tid = tid_; asm volatile("" : "+v"(tid));
    __syncthreads();
#pragma unroll 2
    for (int j = 0; j < 8; ++j) {
      const int ci = tid + 256 * j, lr = ci >> 4, n8 = (ci & 15) * 8;
      *(uint4*)(sM + lr * 136 + n8) = *(const uint4*)(bc + (t0 + lr) * 1024 + g * 128 + n8);
    }
    const int wave = wave_, hh = hh_, l31 = l31_;
    const bf16_t* cptr = bc + (t0 + wave * 32 + l31) * 1024 + 512 + g * 128 + hh * 8;
    __syncthreads();
    f32x16 cb[4];
#pragma unroll
    for (int ni = 0; ni < 4; ++ni)
#pragma unroll
      for (int i = 0; i < 16; ++i) cb[ni][i] = 0.f;
#pragma unroll
    for (int kk = 0; kk < 8; ++kk) {
      const bf16x8 cfk = *(const bf16x8*)(cptr + kk * 16);
#pragma unroll
      for (int ni = 0; ni < 4; ++ni) {
        const bf16x8 bf = *(const bf16x8*)(sM + (ni * 32 + l31) * 136 + kk * 16 + hh * 8);
        cb[ni] = MFMA32(cfk, bf, cb[ni]);
      }
    }
    float ssq[16];
#pragma unroll
    for (int i = 0; i < 16; ++i) ssq[i] = 0.f;
#pragma unroll 1
    for (int e = 0; e < 4; ++e) {
      int l31 = l31_, hh = hh_, wave = wave_;
      asm volatile("" : "+v"(l31), "+v"(hh));
      asm volatile("" : "+s"(wave));
      const int head = g * 4 + e;
      const float aneg = -__expf(p.in[I_ALOG][l * 16 + head]);
      const float dsk = p.in[I_DSKIP][l * 16 + head];
      __syncthreads();
      if (tid < 128) { const float d = dt[(t0 + tid) * 16 + head]; fdt[tid] = d; fa[tid] = d * aneg; }
      __syncthreads();
      float* acs = scan128(fa, fb);
#pragma unroll 2
      for (int j = 0; j < 4; ++j) {
        const int ci = tid + 256 * j, lr = ci >> 3, p8 = (ci & 7) * 8;
        const uint4 u = *(const uint4*)(xs + (t0 + lr) * 1024 + head * 64 + p8);
#pragma unroll
        for (int q = 0; q < 8; ++q) sXT[(p8 + q) * 136 + lr] = get16(u, q);
      }
#pragma unroll
      for (int ni = 0; ni < 4; ++ni)
#pragma unroll
        for (int i = 0; i < 16; ++i) {
          const int lr = wave * 32 + crow(i, hh), sc = ni * 32 + l31;
          const float m = sc <= lr ? cb[ni][i] * __expf(acs[lr] - acs[sc]) * fdt[sc] : 0.f;
          sM[lr * 136 + sc] = f2bf(m);
        }
      __syncthreads();
      const float* hin = (const float*)slab(p, b == 0 ? 2 : 4) + ((size_t)(c * 16 + head) * 64) * 128;
#pragma unroll 1
      for (int ni = 0; ni < 2; ++ni) {
        f32x16 yd;
#pragma unroll
        for (int i = 0; i < 16; ++i) yd[i] = 0.f;
#pragma unroll 2
        for (int kk = 0; kk < 8; ++kk) {
          const bf16x8 cfk = *(const bf16x8*)(cptr + kk * 16);
          const float* hp = hin + (size_t)(ni * 32 + l31) * 128 + kk * 16 + hh * 8;
          const float4 h0 = *(const float4*)hp, h1 = *(const float4*)(hp + 4);
          u32x4 u; u.x = pack2(h0.x, h0.y); u.y = pack2(h0.z, h0.w); u.z = pack2(h1.x, h1.y); u.w = pack2(h1.z, h1.w);
          yd = MFMA32(cfk, __builtin_bit_cast(bf16x8, u), yd);
        }
#pragma unroll
        for (int i = 0; i < 16; ++i) yd[i] *= (SSD_PROBE == 2 ? 0.f : __expf(acs[wave * 32 + crow(i, hh)]));
#pragma unroll
        for (int kk = 0; kk < 8; ++kk) {
          const bf16x8 af = *(const bf16x8*)(sM + (wave * 32 + l31) * 136 + kk * 16 + hh * 8);
          const bf16x8 bf = *(const bf16x8*)(sXT + (ni * 32 + l31) * 136 + kk * 16 + hh * 8);
          yd = MFMA32(af, bf, yd);
        }
#pragma unroll
        for (int i = 0; i < 16; ++i) {
          const int lr = wave * 32 + crow(i, hh), pc = ni * 32 + l31;
          const float xv = bf2f(sXT[pc * 136 + lr]);
          float y = (SSD_PROBE == 1 ? 0.f : yd[i]) + xv * dsk;
          const size_t o = (t0 + lr) * 1024 + head * 64 + pc;
          const float zv = bf2f(zy[o]);
          y *= siluf_(zv);
          ssq[i] += y * y;
          zy[o] = f2bf(y);
        }
      }
    }
#pragma unroll
    for (int i = 0; i < 16; ++i) {
      float s = ssq[i];
      for (int o = 16; o > 0; o >>= 1) s += __shfl_xor(s, o);
      if (l31 == 0) frs[wave * 32 + crow(i, hh)] = rsqrtf(s * (1.f / 256.f) + 1e-6f);
    }
    __syncthreads();
#pragma unroll 1
    for (int j = 0; j < (DBG == 2 ? 0 : 16); ++j) {
      const int ci = tid + 256 * j, lr = ci >> 5, c8 = (ci & 31) * 8;
      bf16_t* ptr = zy + (t0 + lr) * 1024 + g * 256 + c8;
      float f[8]; unpack8(*(const uint4*)ptr, f);
      const float rs = frs[lr];
#pragma unroll
      for (int q = 0; q < 8; ++q) f[q] *= rs * ng[g * 256 + c8 + q];
      *(uint4*)ptr = pack8(f);
    }
  }
}

DI void phase_moba_norm(const Params& p, int l, int bid, int nb, char* smem) {
  float* sK = (float*)smem;
  const int tid = tidx(), rg = tid >> 4, ln = tid & 15;
  bf16_t* Q = slab(p, 2); bf16_t* Kx = slab(p, 4);
  float* kmean = (float*)(p.ws + O_KMEAN);
  float qg[8], kg[8];
#pragma unroll
  for (int e = 0; e < 8; ++e) { qg[e] = p.in[I_QNG][l * 128 + ln * 8 + e]; kg[e] = p.in[I_KNG][l * 128 + ln * 8 + e]; }
  for (int task = bid; task < 1024; task += nb) {
    const int blk = task & 63, h = (task >> 6) & 7, b = task >> 9;
    const size_t t0 = (size_t)b * S_ + blk * 256;
    float ks[8];
#pragma unroll
    for (int e = 0; e < 8; ++e) ks[e] = 0.f;
    for (int j = 0; j < 16; ++j) {
      const size_t o = (t0 + rg + 16 * j) * 1024 + h * 128 + ln * 8;
      float f[8]; float ss = 0.f;
      unpack8(*(const uint4*)(Q + o), f);
#pragma unroll
      for (int e = 0; e < 8; ++e) ss += f[e] * f[e];
      ss = red16(ss);
      float r = rsqrtf(ss * (1.f / 128.f) + 1e-6f);
#pragma unroll
      for (int e = 0; e < 8; ++e) f[e] *= r * qg[e];
      *(uint4*)(Q + o) = pack8(f);
      unpack8(*(const uint4*)(Kx + o), f);
      ss = 0.f;
#pragma unroll
      for (int e = 0; e < 8; ++e) ss += f[e] * f[e];
      ss = red16(ss);
      r = rsqrtf(ss * (1.f / 128.f) + 1e-6f);
#pragma unroll
      for (int e = 0; e < 8; ++e) { f[e] *= r * kg[e]; ks[e] += f[e]; }
      *(uint4*)(Kx + o) = pack8(f);
    }
    __syncthreads();
#pragma unroll
    for (int e = 0; e < 8; ++e) sK[rg * 128 + ln * 8 + e] = ks[e];
    __syncthreads();
    if (tid < 128) {
      float s = 0.f;
#pragma unroll
      for (int j = 0; j < 16; ++j) s += sK[j * 128 + tid];
      kmean[((size_t)(b * 8 + h) * 64 + blk) * 128 + tid] = s * (1.f / 256.f);
    }
  }
}
DI void phase_moba_gate(const Params& p, int bid, int nb, char* smem) {
  float* sKm = (float*)smem;
  const int tid = tidx();
  const bf16_t* Q = slab(p, 2);
  const float* kmean = (const float*)(p.ws + O_KMEAN);
  int* sel = (int*)(p.ws + O_SEL); int* cnt = (int*)(p.ws + O_CNT);
  for (int task = bid; task < 1024; task += nb) {
    const int blk = task & 63, h = (task >> 6) & 7, b = task >> 9;
    __syncthreads();
    for (int i = tid; i < blk * 128; i += 256) sKm[i] = kmean[((size_t)(b * 8 + h) * 64) * 128 + i];
    __syncthreads();
    const size_t t = (size_t)b * S_ + blk * 256 + tid;
    float q[128];
#pragma unroll
    for (int j = 0; j < 16; ++j) unpack8(*(const uint4*)(Q + t * 1024 + h * 128 + j * 8), q + j * 8);
    float v0 = -3e38f, v1 = -3e38f, v2 = -3e38f; int i0 = -1, i1 = -1, i2 = -1;
    for (int j = 0; j < blk; ++j) {
      float d = 0.f;
#pragma unroll
      for (int e = 0; e < 128; ++e) d += q[e] * sKm[j * 128 + e];
      if (d > v0) { v2 = v1; i2 = i1; v1 = v0; i1 = i0; v0 = d; i0 = j; }
      else if (d > v1) { v2 = v1; i2 = i1; v1 = d; i1 = j; }
      else if (d > v2) { v2 = d; i2 = j; }
    }
    int* so = sel + (t * 8 + h) * 3;
    so[0] = i0; so[1] = i1; so[2] = i2;
    const int base = (b * 8 + h) * 64;
    if (i0 >= 0) atomicAdd(cnt + 0 * 1024 + base + i0, 1);
    if (i1 >= 0) atomicAdd(cnt + 1 * 1024 + base + i1, 1);
    if (i2 >= 0) atomicAdd(cnt + 2 * 1024 + base + i2, 1);
  }
}
DI void phase_moba_fill(const Params& p, int bid, int nb, char* smem) {
  int* sBase = (int*)smem;
  const int tid = tidx();
  const int* sel = (const int*)(p.ws + O_SEL); const int* cnt = (const int*)(p.ws + O_CNT);
  int* fill = (int*)(p.ws + O_FILL); int* lists = (int*)(p.ws + O_LISTS);
  for (int task = bid; task < 1024; task += nb) {
    const int blk = task & 63, h = (task >> 6) & 7, b = task >> 9;
    const int base = (b * 8 + h) * 64;
    __syncthreads();
    if (tid < 3) { int a = 0; for (int j = 0; j < 64; ++j) { sBase[tid * 64 + j] = a; a += cnt[tid * 1024 + base + j]; } }
    __syncthreads();
    const int ts = blk * 256 + tid;
    const size_t t = (size_t)b * S_ + ts;
    for (int s = 0; s < 3; ++s) {
      const int j = sel[(t * 8 + h) * 3 + s];
      if (j >= 0) {
        const int pos = sBase[s * 64 + j] + atomicAdd(fill + s * 1024 + base + j, 1);
        lists[(size_t)s * (T_ * 8) + (size_t)(b * 8 + h) * S_ + pos] = ts;
      }
    }
  }
}
DI int t5_bucket(int d) {
  if (d < 16) return d;
  const int large = 16 + (int)(__logf((float)d * (1.f / 16.f)) / 4.1588830833596715f * 16.f);
  return large < 31 ? large : 31;
}
struct MobaLds { bf16_t* sK; bf16_t* sVT; float* sBias; };
DI void moba_block(const Params& p, const MobaLds& L, int b, int h, int tsq  , int kb  ,
                   int ntiles, bool causal, bool init) {
  const int tid = tidx(), lane = tid & 63, hh = lane >> 5, l31 = lane & 31;
  const bf16_t* Q = slab(p, 2); const bf16_t* Kx = slab(p, 4); const bf16_t* V = slab(p, 5);
  bf16_t* ACC = slab(p, 6);
  float* MM = (float*)(p.ws + O_MM); float* ML = (float*)(p.ws + O_ML);
  const bool valid = tsq >= 0;
  const size_t tq = (size_t)b * S_ + (valid ? tsq : 0);
  bf16x8 qf[8];
#pragma unroll
  for (int kk = 0; kk < 8; ++kk) {
    uint4 u = {0, 0, 0, 0};
    if (valid) u = *(const uint4*)(Q + tq * 1024 + h * 128 + kk * 16 + hh * 8);
    qf[kk] = __builtin_bit_cast(bf16x8, u);
  }
  float m = -1e30f, lsum = 0.f;
  f32x16 o[4];
#pragma unroll
  for (int dt = 0; dt < 4; ++dt)
#pragma unroll
    for (int i = 0; i < 16; ++i) o[dt][i] = 0.f;
  if (!init && valid) {
    m = MM[tq * 8 + h]; lsum = ML[tq * 8 + h];
#pragma unroll
    for (int dt = 0; dt < 4; ++dt)
#pragma unroll
      for (int g4 = 0; g4 < 4; ++g4) {
        const uint2 u = *(const uint2*)(ACC + tq * 1024 + h * 128 + dt * 32 + g4 * 8 + hh * 4);
        o[dt][g4 * 4 + 0] = lo16(u.x) * lsum; o[dt][g4 * 4 + 1] = hi16(u.x) * lsum;
        o[dt][g4 * 4 + 2] = lo16(u.y) * lsum; o[dt][g4 * 4 + 3] = hi16(u.y) * lsum;
      }
  }
  int wmaxq = valid ? tsq : -1;
  for (int of = 32; of > 0; of >>= 1) wmaxq = max(wmaxq, __shfl_xor(wmaxq, of));
  const float bias31 = L.sBias[1023];
  const float scale = 0.08838834764831845f;
  const size_t k0 = (size_t)b * S_ + (size_t)kb * 256;
  for (int kt = 0; kt < ntiles; ++kt) {
    __syncthreads();
#pragma unroll
    for (int j = 0; j < 4; ++j) {
      const int ci = tid + 256 * j, kr = ci >> 4, d8 = (ci & 15) * 8;
      const size_t go = (k0 + kt * 64 + kr) * 1024 + h * 128 + d8;
      *(uint4*)(L.sK + kr * 136 + d8) = *(const uint4*)(Kx + go);
      const uint4 u = *(const uint4*)(V + go);
#pragma unroll
      for (int e = 0; e < 8; ++e) L.sVT[(d8 + e) * 72 + kr] = get16(u, e);
    }
    __syncthreads();
    const int kpos0 = kb * 256 + kt * 64;
    if (causal && kpos0 > wmaxq) continue;
    f32x16 st[2];
#pragma unroll
    for (int t2 = 0; t2 < 2; ++t2)
#pragma unroll
      for (int i = 0; i < 16; ++i) st[t2][i] = 0.f;
#pragma unroll
    for (int kk = 0; kk < 8; ++kk)
#pragma unroll
      for (int t2 = 0; t2 < 2; ++t2) {
        const bf16x8 af = *(const bf16x8*)(L.sK + (t2 * 32 + l31) * 136 + kk * 16 + hh * 8);
        st[t2] = MFMA32(af, qf[kk], st[t2]);
      }
    float mloc = -1e30f;
#pragma unroll
    for (int t2 = 0; t2 < 2; ++t2)
#pragma unroll
      for (int i = 0; i < 16; ++i) {
        const int kp = kpos0 + t2 * 32 + crow(i, hh);
        const int dist = tsq - kp;
        float s;
        if (causal && dist < 0) s = -1e30f;
        else {
          const int dd = dist < 0 ? 0 : dist;
          s = st[t2][i] * scale + (dd < 1024 ? L.sBias[dd] : bias31);
        }
        st[t2][i] = s;
        mloc = fmaxf(mloc, s);
      }
    mloc = fmaxf(mloc, __shfl_xor(mloc, 32));
    const float mnew = fmaxf(m, mloc);
    const float alpha = __expf(m - mnew);
    float ls = 0.f;
#pragma unroll
    for (int t2 = 0; t2 < 2; ++t2)
#pragma unroll
      for (int i = 0; i < 16; ++i) {
        const float pv = st[t2][i] <= -1e29f ? 0.f : __expf(st[t2][i] - mnew);
        st[t2][i] = pv; ls += pv;
      }
    ls += __shfl_xor(ls, 32);
    lsum = lsum * alpha + ls;
    m = mnew;
#pragma unroll
    for (int dt = 0; dt < 4; ++dt)
#pragma unroll
      for (int i = 0; i < 16; ++i) o[dt][i] *= alpha;
#pragma unroll
    for (int t2 = 0; t2 < 2; ++t2)
#pragma unroll
      for (int s2 = 0; s2 < 2; ++s2) {
        uint4 pu;
        pu.x = pack2(st[t2][8 * s2 + 0], st[t2][8 * s2 + 1]); pu.y = pack2(st[t2][8 * s2 + 2], st[t2][8 * s2 + 3]);
        pu.z = pack2(st[t2][8 * s2 + 4], st[t2][8 * s2 + 5]); pu.w = pack2(st[t2][8 * s2 + 6], st[t2][8 * s2 + 7]);
        const bf16x8 pf = __builtin_bit_cast(bf16x8, pu);
#pragma unroll
        for (int dt = 0; dt < 4; ++dt) {
          const bf16_t* vp = L.sVT + (dt * 32 + l31) * 72 + t2 * 32 + s2 * 16 + hh * 4;
          uint4 vu; const uint2 a0 = *(const uint2*)vp, a1 = *(const uint2*)(vp + 8);
          vu.x = a0.x; vu.y = a0.y; vu.z = a1.x; vu.w = a1.y;
          o[dt] = MFMA32(__builtin_bit_cast(bf16x8, vu), pf, o[dt]);
        }
      }
  }
  if (valid) {
    const float inv = 1.f / lsum;
    if (hh == 0) { MM[tq * 8 + h] = m; ML[tq * 8 + h] = lsum; }
#pragma unroll
    for (int dt = 0; dt < 4; ++dt)
#pragma unroll
      for (int g4 = 0; g4 < 4; ++g4) {
        uint2 u; u.x = pack2(o[dt][g4 * 4] * inv, o[dt][g4 * 4 + 1] * inv); u.y = pack2(o[dt][g4 * 4 + 2] * inv, o[dt][g4 * 4 + 3] * inv);
        *(uint2*)(ACC + tq * 1024 + h * 128 + dt * 32 + g4 * 8 + hh * 4) = u;
      }
  }
}
DI void moba_bias_table(const Params& p, float* sBias, int h) {
  for (int d = tidx(); d < 1024; d += 256) sBias[d] = p.in[I_RELB][t5_bucket(d) * 8 + h];
}
DI void phase_moba_own(const Params& p, int bid, int nb, char* smem) {
  MobaLds L; L.sK = (bf16_t*)smem; L.sVT = L.sK + 64 * 136; L.sBias = (float*)(L.sVT + 128 * 72);
  const int tid = tidx(), lane = tid & 63, wave = tid >> 6;
  for (int task = bid; task < 2048; task += nb) {
    const int qt = task & 1, blk = (task >> 1) & 63, h = (task >> 7) & 7, b = task >> 10;
    __syncthreads();
    moba_bias_table(p, L.sBias, h);
    __syncthreads();
    const int tsq = blk * 256 + qt * 128 + wave * 32 + (lane & 31);
    moba_block(p, L, b, h, tsq, blk, 2 * (qt + 1), true, true);
  }
}
DI void phase_moba_past(const Params& p, int s, int bid, int nb, char* smem) {
  MobaLds L; L.sK = (bf16_t*)smem; L.sVT = L.sK + 64 * 136; L.sBias = (float*)(L.sVT + 128 * 72);
  int* sTb = (int*)(L.sBias + 1024);
  const int tid = tidx(), lane = tid & 63, wave = tid >> 6;
  const int* cnt = (const int*)(p.ws + O_CNT) + s * 1024;
  const int* lists = (const int*)(p.ws + O_LISTS) + (size_t)s * (T_ * 8);
  __syncthreads();
  if (tid < 16) { int a = 0; for (int j = 0; j < 64; ++j) { sTb[tid * 64 + j] = a; a += (cnt[tid * 64 + j] + 127) >> 7; } sTb[1040 + tid] = a; }
  __syncthreads();
  if (tid == 0) { int a = 0; for (int i = 0; i < 16; ++i) { const int c = sTb[1040 + i]; sTb[1040 + i] = a; a += c; } sTb[1056] = a; }
  __syncthreads();
  const int total = sTb[1056];
  for (int task = bid; task < total; task += nb) {
    int gi = 0;
    for (int i = 1; i < 16; ++i) if (sTb[1040 + i] <= task) gi = i;
    const int loc = task - sTb[1040 + gi];
    int j = 0;
    for (int i = 1; i < 64; ++i) if (sTb[gi * 64 + i] <= loc) j = i;
    while (j > 0 && ((cnt[gi * 64 + j] + 127) >> 7) == 0) --j;
    const int tile = loc - sTb[gi * 64 + j];
    const int b = gi >> 3, h = gi & 7;
    __syncthreads();
    moba_bias_table(p, L.sBias, h);
    __syncthreads();
    int lbase = 0;
    for (int i = 0; i < j; ++i) lbase += cnt[gi * 64 + i];
    const int n = cnt[gi * 64 + j];
    const int qi = tile * 128 + wave * 32 + (lane & 31);
    const int tsq = qi < n ? lists[(size_t)gi * S_ + lbase + qi] : -1;
    moba_block(p, L, b, h, tsq, j, 4, false, false);
  }
}

DI void phase_merge(const Params& p, int l, int bid, int nb, char* smem) {
  bf16_t* sA = (bf16_t*)smem; bf16_t* sB = sA + 128 * LDT;
  bf16_t* stash = sB + 128 * LDT;
  const int tid = tidx();
  const bf16_t* h = slab(p, 0);
  const bf16_t* wg = (const bf16_t*)(p.ws + O_WGATE); const bf16_t* pt = (const bf16_t*)(p.ws + O_PT);
  const float* bg = p.in[I_BGATE] + l * 3072;
  bf16_t* mg = slab(p, 2);
  for (int t = bid; t < 512 * 8; t += nb) {
    const int tm = t >> 3, tn = t & 7;
    f32x16 accm[1][2]; acc_zero<1>(accm);
    for (int br = 0; br < 3; ++br) {
      if ((SKIP_BR >> br) & 1) continue;
      const bf16_t* yb = slab(p, br == 0 ? 1 : (br == 1 ? 6 : 3));
      f32x16 acc[1][2]; acc_zero<1>(acc);
      gemm_core<1>(h + (size_t)tm * 64 * 1024, 1024, wg + (size_t)(br * 1024 + tn * 128) * 1024, 1024, 1024, sA, sB, acc);
      {
        const float* bgp = bg + br * 1024 + tn * 128;
        ACC_FOREACH(1, acc, { stash[((mi * 2 + ni) * 16 + i) * 256 + tid] = f2bf(sigmoidf_(v + bgp[c])); })
      }
      acc_zero<1>(acc);
      gemm_core<1>(yb + (size_t)tm * 64 * 1024, 1024, pt + (size_t)(br * 1024 + tn * 128) * 1024, 1024, 1024, sA, sB, acc);
      ACC_FOREACH(1, acc, { accm[mi][ni][i] += bf2f(stash[((mi * 2 + ni) * 16 + i) * 256 + tid]) * v; })
    }
    bf16_t* d = mg + (size_t)tm * 64 * 1024 + tn * 128;
    ACC_FOREACH(1, accm, { d[(size_t)r * 1024 + c] = f2bf(v); })
  }
}
DI void phase_wout(const Params& p, int l, int bid, int nb, char* smem) {
  bf16_t* sA = (bf16_t*)smem; bf16_t* sB = sA + 128 * LDT;
  const bf16_t* mg = slab(p, 2); const bf16_t* wo = (const bf16_t*)(p.ws + O_WOUT);
  const float* xin = l == 0 ? p.in[I_X] : p.out;
  for (int t = bid; t < 256 * 8; t += nb) {
    const int tm = t >> 3, tn = t & 7;
    f32x16 acc[2][2]; acc_zero<2>(acc);
    gemm_core<2>(mg + (size_t)tm * 128 * 1024, 1024, wo + (size_t)tn * 128 * 1024, 1024, 1024, sA, sB, acc);
    const size_t o0 = (size_t)tm * 128 * 1024 + tn * 128;
    ACC_FOREACH(2, acc, { const size_t o = o0 + (size_t)r * 1024 + c; p.out[o] = xin[o] + v; })
  }
}

DI void phase_peer_prep(const Params& p, int l, int bid, int nb) {
  rmsnorm_phase(p.out, p.in[I_N2G] + l * 1024, slab(p, 0), bid, nb);
  conv_fp8(p.in[I_U] + (size_t)l * 16777216, (unsigned char*)slab(p, 1), 16777216, 64.f, bid, nb);
  conv_fp8(p.in[I_V] + (size_t)l * 16777216, (unsigned char*)slab(p, 1) + 16777216, 16777216, 16.f, bid, nb);
}
DI void phase_peer_q(const Params& p, int bid, int nb, char* smem) {
  bf16_t* sA = (bf16_t*)smem; bf16_t* sB = sA + 128 * LDT;
  const bf16_t* h2 = slab(p, 0); const bf16_t* wq = (const bf16_t*)(p.ws + O_WQ);
  bf16_t* q = slab(p, 2);
  for (int t = bid; t < 256 * 16; t += nb) {
    const int tm = t >> 4, tn = t & 15;
    f32x16 acc[2][2]; acc_zero<2>(acc);
    gemm_core<2>(h2 + (size_t)tm * 128 * 1024, 1024, wq + (size_t)tn * 128 * 1024, 1024, 1024, sA, sB, acc);
    bf16_t* d = q + (size_t)tm * 128 * 2048 + tn * 128;
    ACC_FOREACH(2, acc, { d[(size_t)r * 2048 + c] = f2bf(v); })
  }
}
DI unsigned fkey(float f) { unsigned u = __float_as_uint(f); return (u & 0x80000000u) ? ~u : (u | 0x80000000u); }
DI void phase_peer_topk(const Params& p, int bid, int nb, char* smem) {
  bf16_t* sQ = (bf16_t*)smem;
  float* sS = (float*)smem;
  float* wsc = (float*)(smem + 66560);
  const int tid = tidx(), lane = tid & 63, wave = tid >> 6, wm = wave >> 1, wn = wave & 1, hh = lane >> 5, l31 = lane & 31;
  const bf16_t* q = slab(p, 2);
  const bf16_t* kb = (const bf16_t*)(p.ws + (wn == 0 ? O_K1 : O_K2));
  int* idx_out = (int*)slab(p, 4); float* gate_out = (float*)slab(p, 5);
  float* tv = wsc + wave * 128; int* ti = (int*)(tv + 32); float* fv = tv + 64; int* fi = (int*)(tv + 80);
  const unsigned long long ltmask = (1ull << lane) - 1ull;
  for (int task = bid; task < 4096; task += nb) {
    const int hd = task & 7, tt = task >> 3;
    const size_t t0 = (size_t)tt * 64;
    __syncthreads();
#pragma unroll
    for (int j = 0; j < 8; ++j) {
      const int ci = tid + 256 * j, r = ci >> 5, c8 = (ci & 31) * 8;
      *(uint4*)(sQ + r * 264 + c8) = *(const uint4*)(q + (t0 + r) * 2048 + hd * 256 + c8);
    }
    __syncthreads();
    f32x16 acc[4];
#pragma unroll
    for (int ni = 0; ni < 4; ++ni)
#pragma unroll
      for (int i = 0; i < 16; ++i) acc[ni][i] = 0.f;
#pragma unroll
    for (int kk = 0; kk < 8; ++kk) {
      const bf16x8 af = *(const bf16x8*)(sQ + (wm * 32 + l31) * 264 + wn * 128 + kk * 16 + hh * 8);
#pragma unroll
      for (int ni = 0; ni < 4; ++ni) {
        const bf16x8 bf = *(const bf16x8*)(kb + (size_t)(ni * 32 + l31) * 128 + kk * 16 + hh * 8);
        acc[ni] = MFMA32(af, bf, acc[ni]);
      }
    }
    __syncthreads();
#pragma unroll
    for (int ni = 0; ni < 4; ++ni)
#pragma unroll
      for (int i = 0; i < 16; ++i) sS[(wm * 32 + crow(i, hh)) * 260 + wn * 128 + ni * 32 + l31] = acc[ni][i];
    __syncthreads();
    for (int tk = 0; tk < 16; ++tk) {
      const int r = wave * 16 + tk;
#pragma unroll
      for (int side = 0; side < 2; ++side) {
        const float a0 = sS[r * 260 + side * 128 + lane], a1 = sS[r * 260 + side * 128 + 64 + lane];
        const unsigned k0 = fkey(a0), k1 = fkey(a1);
        unsigned thr = 0;
        for (int bit = 31; bit >= 0; --bit) {
          const unsigned cand = thr | (1u << bit);
          const int c = __popcll(__ballot(k0 >= cand)) + __popcll(__ballot(k1 >= cand));
          if (c >= 16) thr = cand;
          if (c == 16) break;
        }
        const unsigned long long b0 = __ballot(k0 >= thr), b1 = __ballot(k1 >= thr);
        const int p0 = __popcll(b0 & ltmask), p1 = __popcll(b0) + __popcll(b1 & ltmask);
        if (k0 >= thr && p0 < 16) { tv[side * 16 + p0] = a0; ti[side * 16 + p0] = lane; }
        if (k1 >= thr && p1 < 16) { tv[side * 16 + p1] = a1; ti[side * 16 + p1] = lane + 64; }
      }
      __syncthreads();
      float cv[4]; unsigned ck[4];
#pragma unroll
      for (int q4 = 0; q4 < 4; ++q4) { const int c = lane + 64 * q4; cv[q4] = tv[c >> 4] + tv[16 + (c & 15)]; ck[q4] = fkey(cv[q4]); }
      unsigned thr = 0;
      for (int bit = 31; bit >= 0; --bit) {
        const unsigned cand = thr | (1u << bit);
        const int c = __popcll(__ballot(ck[0] >= cand)) + __popcll(__ballot(ck[1] >= cand)) + __popcll(__ballot(ck[2] >= cand)) + __popcll(__ballot(ck[3] >= cand));
        if (c >= 16) thr = cand;
        if (c == 16) break;
      }
      int basep = 0;
#pragma unroll
      for (int q4 = 0; q4 < 4; ++q4) {
        const unsigned long long bb = __ballot(ck[q4] >= thr);
        const int pos = basep + __popcll(bb & ltmask);
        if (ck[q4] >= thr && pos < 16) { const int c = lane + 64 * q4; fv[pos] = cv[q4]; fi[pos] = ti[c >> 4] * 128 + ti[16 + (c & 15)]; }
        basep += __popcll(bb);
      }
      __syncthreads();
      if (lane < 16) {
        float mx = -3e38f;
#pragma unroll
        for (int e = 0; e < 16; ++e) mx = fmaxf(mx, fv[e]);
        float sm = 0.f;
#pragma unroll
        for (int e = 0; e < 16; ++e) sm += __expf(fv[e] - mx);
        const size_t o = ((t0 + r) * 8 + hd) * 16 + lane;
        idx_out[o] = fi[lane];
        gate_out[o] = __expf(fv[lane] - mx) / sm;
      }
      __syncthreads();
    }
  }
}
DI void fp8x16_to_f32(const u32x4& v, float* f) {
#pragma unroll
  for (int j = 0; j < 4; ++j) {
    const f32x2 lo = __builtin_amdgcn_cvt_pk_f32_fp8((int)v[j], false), hi = __builtin_amdgcn_cvt_pk_f32_fp8((int)v[j], true);
    f[4 * j] = lo.x; f[4 * j + 1] = lo.y; f[4 * j + 2] = hi.x; f[4 * j + 3] = hi.y;
  }
}
DI void phase_peer_gather(const Params& p, int bid, int nb, char* smem) {
  const int tid = tidx(), lane = tid & 63, wave = tid >> 6;
  const bf16_t* h2 = slab(p, 0);
  const unsigned char* ub = (const unsigned char*)slab(p, 1); const unsigned char* vb = ub + 16777216;
  const int* idx = (const int*)slab(p, 4); const float* gate = (const float*)slab(p, 5);
  for (int t = bid * 4 + wave; t < T_; t += nb * 4) {
    float h[16];
    unpack8(*(const uint4*)(h2 + (size_t)t * 1024 + lane * 16), h);
    unpack8(*(const uint4*)(h2 + (size_t)t * 1024 + lane * 16 + 8), h + 8);
    const int ia = idx[(size_t)t * 128 + lane], ib = idx[(size_t)t * 128 + 64 + lane];
    float c_lo = 0.f, c_hi = 0.f;
#pragma unroll 1
    for (int g = 0; g < 8; ++g) {
      float part[16];
#pragma unroll
      for (int hf = 0; hf < 2; ++hf) {
        u32x4 rows[8];
#pragma unroll
        for (int j = 0; j < 8; ++j) {
          const int e = g * 16 + hf * 8 + j;
          const int id = __builtin_amdgcn_readlane(g < 4 ? ia : ib, e & 63);
          rows[j] = *(const u32x4*)(ub + (size_t)id * 1024 + lane * 16);
        }
#pragma unroll
        for (int j = 0; j < 8; ++j) {
          float f[16]; fp8x16_to_f32(rows[j], f);
          float a = 0.f;
#pragma unroll
          for (int i = 0; i < 16; ++i) a += h[i] * f[i];
          part[hf * 8 + j] = a;
        }
      }
#pragma unroll
      for (int n = 8, m = 32; n >= 1; n >>= 1, m >>= 1) {
        const bool up = (lane & m) != 0;
#pragma unroll
        for (int i = 0; i < n; ++i) {
          const float keep = up ? part[i + n] : part[i];
          const float send = up ? part[i] : part[i + n];
          part[i] = keep + __shfl_xor(send, m);
        }
      }
      float a = part[0];
      a += __shfl_xor(a, 2);
      a += __shfl_xor(a, 1);
      a *= (1.f / 64.f);
      const float ge = 0.5f * a * (1.f + erff(a * 0.7071067811865476f));
      const float cj = __shfl(ge, 4 * (lane & 15));
      const float cv = cj * gate[(size_t)t * 128 + g * 16 + (lane & 15)];
      const bool mine = (lane >> 4) == (g & 3);
      if (g < 4) c_lo = mine ? cv : c_lo; else c_hi = mine ? cv : c_hi;
    }
    float o[16];
#pragma unroll
    for (int i = 0; i < 16; ++i) o[i] = 0.f;
#pragma unroll 1
    for (int g = 0; g < 16; ++g) {
      u32x4 rows[8];
#pragma unroll
      for (int j = 0; j < 8; ++j) {
        const int e = g * 8 + j;
        const int id = __builtin_amdgcn_readlane(g < 8 ? ia : ib, e & 63);
        rows[j] = *(const u32x4*)(vb + (size_t)id * 1024 + lane * 16);
      }
#pragma unroll
      for (int j = 0; j < 8; ++j) {
        const int e = g * 8 + j;
        const float c = __builtin_bit_cast(float, __builtin_amdgcn_readlane(__builtin_bit_cast(int, g < 8 ? c_lo : c_hi), e & 63));
        float f[16]; fp8x16_to_f32(rows[j], f);
#pragma unroll
        for (int i = 0; i < 16; ++i) o[i] += c * f[i];
      }
    }
    float4* xo = (float4*)(p.out + (size_t)t * 1024 + lane * 16);
#pragma unroll
    for (int q = 0; q < 4; ++q) {
      float4 a = xo[q];
      a.x += o[4 * q] * (1.f / 16.f); a.y += o[4 * q + 1] * (1.f / 16.f); a.z += o[4 * q + 2] * (1.f / 16.f); a.w += o[4 * q + 3] * (1.f / 16.f);
      xo[q] = a;
    }
  }
}

constexpr int NPH = 26;
DI void run_phase(const Params& p, int l, int ph, int bid, int nb, char* smem) {
#ifdef ONLY_PH
  ph = ONLY_PH;
#endif
  switch (ph) {
    case 0: phase_prep(p, l, bid, nb, smem); break;
    case 1: {
      Route rt; rt.seg0 = 6; rt.packed = 4 | (5 << 4) | (6 << 8);
      gemm_in_phase(p, l, rt, 26, 48, 26, 0, bid, nb, smem);
    } break;
    case 2: phase_lora_prep(p, l, bid, nb); break;
    case 3: phase_lora_wa(p, l, bid, nb, smem); break;
    case 4: phase_rwkv_scan(p, l, bid, nb, smem); break;
    case 5: phase_rwkv_ln(p, l, bid, nb); break;
    case 6: phase_rwkv_g(p, l, bid, nb, smem); break;
    case 7: {
      Route rt; rt.seg0 = 0; rt.packed = 1 | (2 << 4) | (4 << 8);
      gemm_in_phase(p, l, rt, 25, 0, 24, 74, bid, nb, smem);
    } break;
    case 8: phase_ssd_conv(p, l, bid, nb); break;
    case 9: phase_ssd_states(p, l, bid, nb, smem); break;
    case 10: phase_ssd_scan(p, bid, nb); break;
    case 11: phase_ssd_out(p, l, bid, nb, smem); break;
    case 12: {
      Route rt; rt.seg0 = 3; rt.packed = 2 | (4 << 4) | (5 << 8);
      gemm_in_phase(p, l, rt, 24, 24, 24, 0, bid, nb, smem);
    } break;
    case 13: phase_moba_norm(p, l, bid, nb, smem); break;
    case 14: phase_moba_gate(p, bid, nb, smem); break;
    case 15: phase_moba_fill(p, bid, nb, smem); break;
    case 16: phase_moba_own(p, bid, nb, smem); break;
    case 17: phase_moba_past(p, 0, bid, nb, smem); break;
    case 18: phase_moba_past(p, 1, bid, nb, smem); break;
    case 19: phase_moba_past(p, 2, bid, nb, smem); break;
    case 20: phase_merge(p, l, bid, nb, smem); break;
    case 21: phase_wout(p, l, bid, nb, smem); break;
    case 22: phase_peer_prep(p, l, bid, nb); break;
    case 23: phase_peer_q(p, bid, nb, smem); break;
    case 24: phase_peer_topk(p, bid, nb, smem); break;
    case 25: phase_peer_gather(p, bid, nb, smem); break;
  }
}

#if !MULTI
#define XB_TMO      128
#define XB_XCNT(j)  (256  + 64 * (j))
#define XB_XSUB(j)  (1280 + 64 * (j))
#define XB_XGEN(j)  (2304 + 64 * (j))
#define XB_TOP      3328
#define XB_TOPGEN   3392
#define XCD_BAR_WORDS 3456
#define XB_SPIN_CAP (1u << 22)
#define LAS __attribute__((address_space(3)))
DI unsigned xb_ld(unsigned* p)              { return __hip_atomic_load(p, __ATOMIC_RELAXED, __HIP_MEMORY_SCOPE_AGENT); }
DI unsigned xb_add(unsigned* p, unsigned v) { return __hip_atomic_fetch_add(p, v, __ATOMIC_RELAXED, __HIP_MEMORY_SCOPE_AGENT); }
DI unsigned xb_xcc_id() { return (unsigned)__builtin_amdgcn_s_getreg((3 << 11) | 20) & 0xFu; }
#define XB_SPIN(cond, bar) do { unsigned _sp = 0; while (cond) { __builtin_amdgcn_s_sleep(1); \
    if ((++_sp & 255u) == 0u) { if (xb_ld(&(bar)[XB_TMO])) break; if (_sp > XB_SPIN_CAP) { atomicAdd(&(bar)[XB_TMO], 1u); break; } } } } while (0)
struct XcdBarrier { unsigned* bar; unsigned x; volatile LAS unsigned* st; };
DI XcdBarrier xcd_barrier_post(unsigned* bar, volatile LAS unsigned* st) {
  XcdBarrier b; b.bar = bar; b.x = xb_xcc_id(); b.st = st;
  if (__builtin_amdgcn_workitem_id_x() == 0) (void)xb_add(&bar[XB_XCNT(b.x)], 1u);
  return b;
}
DI void xcd_barrier_complete(unsigned* bar, unsigned x, unsigned& nloc, unsigned& nx) {
  const unsigned G = gridDim.x * gridDim.y * gridDim.z;
  unsigned sum, cnt, mine, sp = 0u;
  for (;;) {
    sum = 0u; cnt = 0u; mine = 0u;
#pragma unroll
    for (unsigned j = 0; j < 16; ++j) { const unsigned c = xb_ld(&bar[XB_XCNT(j)]); sum += c; cnt += (c > 0u) ? 1u : 0u; mine = (j == x) ? c : mine; }
    if (sum == G) break;
    __builtin_amdgcn_s_sleep(1);
    if ((++sp & 255u) == 0u) { if (xb_ld(&bar[XB_TMO])) break; if (sp > XB_SPIN_CAP) { atomicAdd(&bar[XB_TMO], 1u); break; } }
  }
  nloc = mine > 0u ? mine : 1u; nx = cnt > 0u ? cnt : 1u;
}
DI void xcd_barrier(const XcdBarrier& b) {
  asm volatile("s_waitcnt vmcnt(0)" ::: "memory");
  __syncthreads();
  if (__builtin_amdgcn_workitem_id_x() == 0) {
    unsigned* bar = b.bar;
    __builtin_amdgcn_s_waitcnt(0);
    unsigned nloc = b.st[0], nx = b.st[1];
    if (nloc == 0u) { xcd_barrier_complete(bar, b.x, nloc, nx); b.st[0] = nloc; b.st[1] = nx; }
    const unsigned old = xb_add(&bar[XB_XSUB(b.x)], 1u);
    const unsigned gen = old / nloc;
    if (old + 1u == (gen + 1u) * nloc) {
      __builtin_amdgcn_fence(__ATOMIC_RELEASE, "agent");
      asm volatile("s_waitcnt vmcnt(0)" ::: "memory");
      const unsigned og = xb_add(&bar[XB_TOP], 1u);
      const unsigned tg = og / nx;
      if (og + 1u == (tg + 1u) * nx) xb_add(&bar[XB_TOPGEN], 1u);
      else XB_SPIN(xb_ld(&bar[XB_TOPGEN]) == tg, bar);
      __builtin_amdgcn_fence(__ATOMIC_ACQUIRE, "agent");
      xb_add(&bar[XB_XGEN(b.x)], 1u);
      asm volatile("s_waitcnt vmcnt(0)" ::: "memory");
    } else {
      XB_SPIN(xb_ld(&bar[XB_XGEN(b.x)]) == gen, bar);
      __builtin_amdgcn_fence(__ATOMIC_ACQUIRE, "agent");
      asm volatile("s_waitcnt vmcnt(0)" ::: "memory");
    }
  }
  __syncthreads();
}
__global__ void __launch_bounds__(256, 2) mega(Params p) {
  __shared__ __attribute__((aligned(16))) char smem[LDS_BYTES];
  __shared__ uint4 xb_words;
  cg::grid_group grid = cg::this_grid();
  if (__builtin_amdgcn_workitem_id_x() == 0) xb_words = make_uint4(0u, 0u, 0u, 0u);
  __syncthreads();
  XcdBarrier xb = xcd_barrier_post((unsigned*)(p.ws + O_BAR), (volatile LAS unsigned*)&xb_words);
  for (int it = 0; it < 2 * NPH; ++it) {
    int itv = it; asm volatile("" : "+v"(itv));
    const int its = __builtin_amdgcn_readfirstlane(itv);
    const int l = its / NPH, ph = its % NPH;
    int bv = blockIdx.x, nv = gridDim.x; asm volatile("" : "+v"(bv), "+v"(nv));
    const int nrep = ((REPMASK >> ph) & 1) ? 2 : 1;
    for (int r = 0; r < nrep; ++r) {
      run_phase(p, l, ph, __builtin_amdgcn_readfirstlane(bv), __builtin_amdgcn_readfirstlane(nv), smem);
      if (it == 0 && r == 0) grid.sync();
      else xcd_barrier(xb);
    }
  }
}
#else
__global__ void __launch_bounds__(256, 2) phase_kernel(Params p, int l, int ph) {
  __shared__ __attribute__((aligned(16))) char smem[LDS_BYTES];
  run_phase(p, l, ph, blockIdx.x, gridDim.x, smem);
}
#endif


#if DBG
DI int dbg_tok(int i) { return i == 0 ? 3 : (i == 1 ? 130 : (i == 2 ? 300 : 16384 + 511)); }
__global__ void __launch_bounds__(256) dbgA_kernel(Params p) {
  const int tid = tidx();
  for (size_t i = (size_t)blockIdx.x * 256 + tid; i < (size_t)T_ * 1024; i += (size_t)gridDim.x * 256) p.out[i] = p.in[I_X][i];
  if (blockIdx.x < 4) {
    const int t = dbg_tok(blockIdx.x);
    bf16_t* d = (bf16_t*)(p.ws + O_LISTS);
    for (int c = tid; c < 1024; c += 256) d[blockIdx.x * 1024 + c] = slab(p, 1)[(size_t)t * 1024 + c];
  }
}
__global__ void __launch_bounds__(256) dbgB_kernel(Params p, int l) {
  __shared__ float sred[256];
  const int tid = tidx();
  const int ti = blockIdx.x >> 2, g = blockIdx.x & 3;
  const int t = dbg_tok(ti), b = t >> 14, ts = t & (S_ - 1);
  const bf16_t* xs = slab(p, 5) + (size_t)b * S_ * 1024; const bf16_t* bc = slab(p, 6) + (size_t)b * S_ * 1024;
  const float* dt = (const float*)(p.ws + O_DT) + (size_t)b * S_ * 16;
  const bf16_t* zsave = (const bf16_t*)(p.ws + O_LISTS);
  const int ch = g * 256 + tid, head = ch >> 6;
  const float a = -__expf(p.in[I_ALOG][l * 16 + head]);
  float y = 0.f;
  for (int n = 0; n < (SSD_PROBE == 1 ? 0 : 128); ++n) {
    float h = 0.f;
    for (int s = 0; s <= ts; ++s) {
      const float d = dt[(size_t)s * 16 + head];
      h = h * __expf(d * a) + d * bf2f(bc[(size_t)s * 1024 + g * 128 + n]) * bf2f(xs[(size_t)s * 1024 + ch]);
    }
    y += bf2f(bc[(size_t)ts * 1024 + 512 + g * 128 + n]) * h;
  }
  y += p.in[I_DSKIP][l * 16 + head] * bf2f(xs[(size_t)ts * 1024 + ch]);
  y *= siluf_(bf2f(zsave[ti * 1024 + ch]));
  sred[tid] = y * y;
  __syncthreads();
  for (int o = 128; o > 0; o >>= 1) { if (tid < o) sred[tid] += sred[tid + o]; __syncthreads(); }
  const float rs = rsqrtf(sred[0] * (1.f / 256.f) + 1e-6f);
  __syncthreads();
  const float ref = DBG == 2 ? y : y * rs * p.in[I_SSDNG][l * 1024 + ch];
  const float mine = bf2f(slab(p, 1)[(size_t)t * 1024 + ch]);
  sred[tid] = fabsf(mine - ref);
  __syncthreads();
  for (int o = 128; o > 0; o >>= 1) { if (tid < o) sred[tid] = fmaxf(sred[tid], sred[tid + o]); __syncthreads(); }
  if (tid == 0) p.out[blockIdx.x] = 1000.f * sred[0] + 100.f;
}
#endif

#if DBG
__global__ void __launch_bounds__(256) dbgS_kernel(Params p, int l) {
  for (size_t i = (size_t)blockIdx.x * 256 + tidx(); i < (size_t)T_ * 1024; i += (size_t)gridDim.x * 256) {
    const int ch = (int)(i & 1023), head = ch >> 6;
    const float xv = bf2f(slab(p, 5)[i]);
    const float zv = bf2f(slab(p, 1)[i]);
    slab(p, 1)[i] = f2bf(xv * p.in[I_DSKIP][l * 16 + head] * siluf_(zv));
  }
}
#endif

extern "C" void kernel_launch(void* const* d_in, const int* in_sizes, int n_in, void* d_out, int out_size, void* d_ws, size_t ws_size,
                              hipStream_t stream) {
  Params p{};
  for (int i = 0; i < 35; ++i) p.in[i] = (const float*)d_in[i];
  p.out = (float*)d_out;
  p.ws = (char*)d_ws;
  if (ws_size < WS_END) { fprintf(stderr, "workspace too small\n"); return; }
#if MULTI
#if DBG
  for (int ph = 0; ph < 11; ++ph) hipLaunchKernelGGL(phase_kernel, dim3(512), dim3(256), 0, stream, p, 0, ph);
  hipLaunchKernelGGL(dbgA_kernel, dim3(512), dim3(256), 0, stream, p);
  hipLaunchKernelGGL(dbgS_kernel, dim3(512), dim3(256), 0, stream, p, 0);
  hipLaunchKernelGGL(dbgB_kernel, dim3(16), dim3(256), 0, stream, p, 0);
#else
  for (int l = 0; l < NLAYERS; ++l)
    for (int ph = 0; ph < (SKIP_PEER ? 22 : NPH); ++ph) hipLaunchKernelGGL(phase_kernel, dim3(512), dim3(256), 0, stream, p, l, ph);
#endif
#else
  static int grid_blocks = 0;
  if (!grid_blocks) {
    int dev = 0, cus = 0, per_cu = 0;
    (void)hipGetDevice(&dev);
    (void)hipDeviceGetAttribute(&cus, hipDeviceAttributeMultiprocessorCount, dev);
    (void)hipOccupancyMaxActiveBlocksPerMultiprocessor(&per_cu, mega, 256, 0);
    if (per_cu > 2) per_cu = 2;
    grid_blocks = cus * per_cu;
  }
  (void)hipMemsetAsync(p.ws + O_BAR, 0, 16384, stream);
  void* args[] = {&p};
  hipError_t e = hipLaunchCooperativeKernel((void*)mega, dim3(grid_blocks), dim3(256), args, 0, stream);
  if (e != hipSuccess) fprintf(stderr, "coop launch failed: %s (grid %d)\n", hipGetErrorString(e), grid_blocks);
#endif
}
```

```cpp
#include <hip/hip_runtime.h>
#include <hip/hip_cooperative_groups.h>
#include <cstdio>
#include <cstdint>
namespace cg = cooperative_groups;
#define DI __device__ __forceinline__
#ifndef MULTI
#define MULTI 0
#endif
#ifndef SKIP_BR
#define SKIP_BR 0
#endif
#ifndef SKIP_PEER
#define SKIP_PEER 0
#ifndef DBG
#define DBG 0
#endif
#ifndef SSD_PROBE
#define SSD_PROBE 0
#endif
#endif
#ifndef REPMASK
#define REPMASK 0
#endif
#ifndef NLAYERS
#define NLAYERS 2
#endif

typedef unsigned short bf16_t;
typedef __attribute__((ext_vector_type(8))) short bf16x8;
typedef __attribute__((ext_vector_type(16))) float f32x16;
typedef __attribute__((ext_vector_type(4))) float f32x4;
typedef __attribute__((ext_vector_type(4))) unsigned u32x4;
typedef __attribute__((ext_vector_type(2))) float f32x2;
#define MFMA32(a, b, c) __builtin_amdgcn_mfma_f32_32x32x16_bf16((a), (b), (c), 0, 0, 0)
#define MFMA16(a, b, c) __builtin_amdgcn_mfma_f32_16x16x32_bf16((a), (b), (c), 0, 0, 0)

constexpr int T_ = 32768, S_ = 16384;
constexpr size_t SLAB = 67108864;
constexpr int LDS_BYTES = 73728;

struct Params { const float* in[35]; float* out; char* ws; };

enum { I_X = 0, I_RELB, I_N1G, I_WIN, I_CONVW, I_CONVB, I_DTB, I_ALOG, I_DSKIP, I_SSDNG, I_QNG, I_KNG, I_MU, I_W0, I_WW2, I_A0,
       I_WA2, I_WG2, I_KK, I_KA, I_RK, I_LNG, I_LNB, I_PSSD, I_PMOBA, I_PRWKV, I_WGATE, I_BGATE, I_WOUT, I_N2G, I_WQ, I_K1, I_K2, I_U, I_V };

constexpr size_t OFF_W = 7 * SLAB;
constexpr size_t O_WIN = OFF_W;
constexpr size_t O_WGATE = O_WIN + 19660800;
constexpr size_t O_PT = O_WGATE + 6291456;
constexpr size_t O_WOUT = O_PT + 6291456;
constexpr size_t O_WQ = O_WOUT + 2097152;
constexpr size_t O_WW2 = O_WQ + 4194304;
constexpr size_t O_WA2 = O_WW2 + 131072;
constexpr size_t O_WG2 = O_WA2 + 131072;
constexpr size_t O_K1 = O_WG2 + 262144;
constexpr size_t O_K2 = O_K1 + 32768;
constexpr size_t OFF_X = O_K2 + 32768;
constexpr size_t O_DT = OFF_X;
constexpr size_t O_LACT = O_DT + 2097152;
constexpr size_t O_RB = O_LACT + 16777216;
constexpr size_t O_CDEC = O_RB + 2097152;
constexpr size_t O_KMEAN = O_CDEC + 16384;
constexpr size_t O_MM = O_KMEAN + 524288;
constexpr size_t O_ML = O_MM + 1048576;
constexpr size_t O_SEL = O_ML + 1048576;
constexpr size_t O_CNT = O_SEL + 3145728;
constexpr size_t O_FILL = O_CNT + 12288;
constexpr size_t O_LISTS = O_FILL + 12288;
constexpr size_t O_BAR = O_LISTS + 3145728;
constexpr size_t WS_END = O_BAR + 16384;

DI bf16_t* slab(const Params& p, int i) { return (bf16_t*)(p.ws + (size_t)i * SLAB); }

DI bf16_t f2bf(float x) { unsigned u = __float_as_uint(x); u += 0x7fffu + ((u >> 16) & 1u); return (bf16_t)(u >> 16); }
DI float bf2f(bf16_t b) { return __uint_as_float(((unsigned)b) << 16); }
DI unsigned pack2(float a, float b) { return (unsigned)f2bf(a) | ((unsigned)f2bf(b) << 16); }
DI float lo16(unsigned u) { return __uint_as_float(u << 16); }
DI float hi16(unsigned u) { return __uint_as_float(u & 0xffff0000u); }
DI bf16_t get16(const uint4& v, int e) { const unsigned w = (e >> 1) == 0 ? v.x : ((e >> 1) == 1 ? v.y : ((e >> 1) == 2 ? v.z : v.w)); return (bf16_t)((e & 1) ? (w >> 16) : (w & 0xffffu)); }
DI void unpack8(const uint4& v, float* f) {
  f[0] = lo16(v.x); f[1] = hi16(v.x); f[2] = lo16(v.y); f[3] = hi16(v.y);
  f[4] = lo16(v.z); f[5] = hi16(v.z); f[6] = lo16(v.w); f[7] = hi16(v.w);
}
DI uint4 pack8(const float* f) { uint4 v; v.x = pack2(f[0], f[1]); v.y = pack2(f[2], f[3]); v.z = pack2(f[4], f[5]); v.w = pack2(f[6], f[7]); return v; }
DI float sigmoidf_(float x) { return 1.f / (1.f + __expf(-x)); }
DI float softplusf_(float x) { return fmaxf(x, 0.f) + log1pf(__expf(-fabsf(x))); }
DI float siluf_(float x) { return x / (1.f + __expf(-x)); }
DI float wave_sum(float v) { for (int o = 32; o > 0; o >>= 1) v += __shfl_xor(v, o); return v; }
template <int CTRL> DI float dpp_add(float x) {
  int y = __builtin_amdgcn_update_dpp(0, __float_as_int(x), CTRL, 0xf, 0xf, true);
  return x + __int_as_float(y);
}
DI float red8(float x) { x = dpp_add<0xB1>(x); x = dpp_add<0x4E>(x); x = dpp_add<0x141>(x); return x; }
DI float red16(float x) { x = red8(x); x = dpp_add<0x140>(x); return x; }
DI int tidx() { int t = __builtin_amdgcn_workitem_id_x(); asm volatile("" : "+v"(t)); return t; }
DI int crow(int i, int h) { return (i & 3) + 8 * (i >> 2) + 4 * h; }

constexpr int LDT = 72;
template <int MI>
DI void gemm_core(const bf16_t* __restrict__ A, int lda, const bf16_t* __restrict__ Bt, int ldb, int K,
                  bf16_t* sA, bf16_t* sB, f32x16 (&acc)[MI][2]) {
  const int tid = tidx(), lane = tid & 63, wave = tid >> 6, wm = wave >> 1, wn = wave & 1;
  u32x4 ra[2 * MI], rb[4];
#pragma unroll
  for (int j = 0; j < 2 * MI; ++j) { const int c = tid + 256 * j; ra[j] = *(const u32x4*)(A + (size_t)(c >> 3) * lda + (c & 7) * 8); }
#pragma unroll
  for (int j = 0; j < 4; ++j) { const int c = tid + 256 * j; rb[j] = *(const u32x4*)(Bt + (size_t)(c >> 3) * ldb + (c & 7) * 8); }
  for (int k0 = 0; k0 < K; k0 += 64) {
#pragma unroll
    for (int j = 0; j < 2 * MI; ++j) { const int c = tid + 256 * j; *(u32x4*)(sA + (c >> 3) * LDT + (c & 7) * 8) = ra[j]; }
#pragma unroll
    for (int j = 0; j < 4; ++j) { const int c = tid + 256 * j; *(u32x4*)(sB + (c >> 3) * LDT + (c & 7) * 8) = rb[j]; }
    __syncthreads();
    const int kn = (k0 + 64 < K) ? k0 + 64 : k0;
#pragma unroll
    for (int j = 0; j < 2 * MI; ++j) { const int c = tid + 256 * j; ra[j] = *(const u32x4*)(A + (size_t)(c >> 3) * lda + kn + (c & 7) * 8); }
#pragma unroll
    for (int j = 0; j < 4; ++j) { const int c = tid + 256 * j; rb[j] = *(const u32x4*)(Bt + (size_t)(c >> 3) * ldb + kn + (c & 7) * 8); }
#pragma unroll
    for (int kk = 0; kk < 4; ++kk) {
      bf16x8 af[MI], bfr[2];
#pragma unroll
      for (int mi = 0; mi < MI; ++mi) af[mi] = *(const bf16x8*)(sA + (wm * 32 * MI + mi * 32 + (lane & 31)) * LDT + kk * 16 + (lane >> 5) * 8);
#pragma unroll
      for (int ni = 0; ni < 2; ++ni) bfr[ni] = *(const bf16x8*)(sB + (wn * 64 + ni * 32 + (lane & 31)) * LDT + kk * 16 + (lane >> 5) * 8);
#pragma unroll
      for (int mi = 0; mi < MI; ++mi)
#pragma unroll
        for (int ni = 0; ni < 2; ++ni) acc[mi][ni] = MFMA32(af[mi], bfr[ni], acc[mi][ni]);
    }
    __syncthreads();
  }
}
template <int MI> DI void acc_zero(f32x16 (&acc)[MI][2]) {
#pragma unroll
  for (int mi = 0; mi < MI; ++mi)
#pragma unroll
    for (int ni = 0; ni < 2; ++ni)
#pragma unroll
      for (int i = 0; i < 16; ++i) acc[mi][ni][i] = 0.f;
}
#define ACC_FOREACH(MI, acc, BODY)                                                        \
  {                                                                                       \
    int lane_ = tidx() & 63; asm volatile("" : "+v"(lane_));                        \
    const int wave_ = tidx() >> 6, wm_ = wave_ >> 1, wn_ = wave_ & 1;                \
    _Pragma("unroll") for (int mi = 0; mi < MI; ++mi)                                     \
    _Pragma("unroll") for (int ni = 0; ni < 2; ++ni)                                      \
    _Pragma("unroll") for (int i = 0; i < 16; ++i) {                                      \
      const int r = wm_ * 32 * MI + mi * 32 + crow(i, lane_ >> 5);                        \
      const int c = wn_ * 64 + ni * 32 + (lane_ & 31);                                    \
      const float v = acc[mi][ni][i];                                                       \
      BODY                                                                                \
    }                                                                                     \
  }

DI void tconv_job(const float* __restrict__ src, int ld, int K, int c0, int ncols, bf16_t* __restrict__ dst, int bid, int nb, float* sT) {
  const int ntn = (ncols + 63) >> 6, ntk = K >> 6, tid = tidx();
  for (int t = bid; t < ntn * ntk; t += nb) {
    const int tk = t % ntk, tn = t / ntk;
    const int kr = tid >> 4, nx = (tid & 15) * 4;
#pragma unroll
    for (int j = 0; j < 4; ++j) {
      const int k = kr + 16 * j;
      const float* s = src + (size_t)(tk * 64 + k) * ld + c0 + tn * 64 + nx;
      float4 v;
      if (tn * 64 + nx + 3 < ncols) v = *(const float4*)s;
      else { v.x = (tn * 64 + nx < ncols) ? s[0] : 0.f; v.y = (tn * 64 + nx + 1 < ncols) ? s[1] : 0.f; v.z = (tn * 64 + nx + 2 < ncols) ? s[2] : 0.f; v.w = 0.f; }
      sT[k * 65 + nx] = v.x; sT[k * 65 + nx + 1] = v.y; sT[k * 65 + nx + 2] = v.z; sT[k * 65 + nx + 3] = v.w;
    }
    __syncthreads();
    const int n = tid >> 2, kq = tid & 3;
    if (tn * 64 + n < ncols) {
      float f[16];
#pragma unroll
      for (int j = 0; j < 16; ++j) f[j] = sT[(kq * 16 + j) * 65 + n];
      uint4* d = (uint4*)(dst + (size_t)(tn * 64 + n) * K + tk * 64 + kq * 16);
      d[0] = pack8(f); d[1] = pack8(f + 8);
    }
    __syncthreads();
  }
}
DI void conv_plain(const float* __restrict__ src, bf16_t* __restrict__ dst, size_t n, int bid, int nb) {
  size_t i = ((size_t)bid * 256 + tidx()), st = (size_t)nb * 256;
  for (; i < n / 8; i += st) {
    float4 a = ((const float4*)src)[2 * i], b = ((const float4*)src)[2 * i + 1];
    uint4 o; o.x = pack2(a.x, a.y); o.y = pack2(a.z, a.w); o.z = pack2(b.x, b.y); o.w = pack2(b.z, b.w);
    ((uint4*)dst)[i] = o;
  }
}
DI void conv_fp8(const float* __restrict__ src, unsigned char* __restrict__ dst, size_t n, float scale, int bid, int nb) {
  size_t i = ((size_t)bid * 256 + tidx()), st = (size_t)nb * 256;
  for (; i < n / 16; i += st) {
    const float4* sp = (const float4*)src + 4 * i;
    u32x4 o;
#pragma unroll
    for (int j = 0; j < 4; ++j) {
      const float4 a = sp[j];
      int w = 0;
      w = __builtin_amdgcn_cvt_pk_fp8_f32(a.x * scale, a.y * scale, w, false);
      w = __builtin_amdgcn_cvt_pk_fp8_f32(a.z * scale, a.w * scale, w, true);
      o[j] = (unsigned)w;
    }
    ((u32x4*)dst)[i] = o;
  }
}
DI void rmsnorm_phase(const float* __restrict__ x, const float* __restrict__ g, bf16_t* __restrict__ h, int bid, int nb) {
  const int wave = tidx() >> 6, lane = tidx() & 63;
  for (int row = bid * 4 + wave; row < T_; row += nb * 4) {
    const float4* xr = (const float4*)(x + (size_t)row * 1024);
    float4 v[4]; float ss = 0.f;
#pragma unroll
    for (int j = 0; j < 4; ++j) { v[j] = xr[lane + 64 * j]; ss += v[j].x * v[j].x + v[j].y * v[j].y + v[j].z * v[j].z + v[j].w * v[j].w; }
    ss = wave_sum(ss);
    const float r = rsqrtf(ss * (1.f / 1024.f) + 1e-6f);
#pragma unroll
    for (int j = 0; j < 4; ++j) {
      float4 g4 = ((const float4*)g)[lane + 64 * j];
      uint2 o; o.x = pack2(v[j].x * r * g4.x, v[j].y * r * g4.y); o.y = pack2(v[j].z * r * g4.z, v[j].w * r * g4.w);
      ((uint2*)(h + (size_t)row * 1024))[lane + 64 * j] = o;
    }
  }
}
DI void phase_prep(const Params& p, int l, int bid, int nb, char* smem) {
  float* sT = (float*)smem;
  char* ws = p.ws;
  const float* win = p.in[I_WIN] + (size_t)l * 1024 * 9488;
  bf16_t* wt_in = (bf16_t*)(ws + O_WIN);
  tconv_job(win, 9488, 1024, 0, 3072, wt_in, bid, nb, sT);
  tconv_job(win, 9488, 1024, 3088, 6400, wt_in + (size_t)3072 * 1024, bid, nb, sT);
  tconv_job(win, 9488, 1024, 3072, 16, wt_in + (size_t)9472 * 1024, bid, nb, sT);
  {
    uint4 z = {0, 0, 0, 0};
    uint4* d = (uint4*)(wt_in + (size_t)9488 * 1024);
    for (int i = bid * 256 + tidx(); i < 112 * 1024 / 8; i += nb * 256) d[i] = z;
  }
  tconv_job(p.in[I_WGATE] + (size_t)l * 1024 * 3072, 3072, 1024, 0, 3072, (bf16_t*)(ws + O_WGATE), bid, nb, sT);
  tconv_job(p.in[I_PSSD] + (size_t)l * 1048576, 1024, 1024, 0, 1024, (bf16_t*)(ws + O_PT), bid, nb, sT);
  tconv_job(p.in[I_PMOBA] + (size_t)l * 1048576, 1024, 1024, 0, 1024, (bf16_t*)(ws + O_PT) + 1048576, bid, nb, sT);
  tconv_job(p.in[I_PRWKV] + (size_t)l * 1048576, 1024, 1024, 0, 1024, (bf16_t*)(ws + O_PT) + 2 * 1048576, bid, nb, sT);
  tconv_job(p.in[I_WOUT] + (size_t)l * 1048576, 1024, 1024, 0, 1024, (bf16_t*)(ws + O_WOUT), bid, nb, sT);
  tconv_job(p.in[I_WQ] + (size_t)l * 1024 * 2048, 2048, 1024, 0, 2048, (bf16_t*)(ws + O_WQ), bid, nb, sT);
  tconv_job(p.in[I_WW2] + (size_t)l * 64 * 1024, 1024, 64, 0, 1024, (bf16_t*)(ws + O_WW2), bid, nb, sT);
  tconv_job(p.in[I_WA2] + (size_t)l * 64 * 1024, 1024, 64, 0, 1024, (bf16_t*)(ws + O_WA2), bid, nb, sT);
  tconv_job(p.in[I_WG2] + (size_t)l * 128 * 1024, 1024, 128, 0, 1024, (bf16_t*)(ws + O_WG2), bid, nb, sT);
  conv_plain(p.in[I_K1] + (size_t)l * 16384, (bf16_t*)(ws + O_K1), 16384, bid, nb);
  conv_plain(p.in[I_K2] + (size_t)l * 16384, (bf16_t*)(ws + O_K2), 16384, bid, nb);
  { int* cz = (int*)(ws + O_CNT); for (int i = bid * 256 + tidx(); i < 2 * 3072; i += nb * 256) cz[i] = 0; }
  const float* xin = l == 0 ? p.in[I_X] : p.out;
  rmsnorm_phase(xin, p.in[I_N1G] + l * 1024, slab(p, 0), bid, nb);
}

struct Route { int packed; int seg0; };
DI void gemm_in_phase(const Params& p, int l, const Route rt, int nt, int t0a, int t0b_from, int t0b, int bid, int nb, char* smem) {
  bf16_t* sA = (bf16_t*)smem; bf16_t* sB = sA + 128 * LDT;
  const bf16_t* h = slab(p, 0);
  const bf16_t* wt = (const bf16_t*)(p.ws + O_WIN);
  bf16_t* lora = slab(p, 3); float* dtp = (float*)(p.ws + O_DT); const float* dtb = p.in[I_DTB] + l * 16;
  for (int t = bid; t < 256 * nt; t += nb) {
    const int tm = t / nt, tl = t % nt;
    const int tn = tl < t0b_from ? t0a + tl : t0b + (tl - t0b_from);
    f32x16 acc[2][2]; acc_zero<2>(acc);
    gemm_core<2>(h + (size_t)tm * 128 * 1024, 1024, wt + (size_t)tn * 128 * 1024, 1024, 1024, sA, sB, acc);
    const int row0 = tm * 128, col0 = tn * 128, seg = col0 >> 10;
    if (seg < 9) {
      bf16_t* d = slab(p, (rt.packed >> (4 * (seg - rt.seg0))) & 15) + (size_t)row0 * 1024 + (col0 & 1023);
      ACC_FOREACH(2, acc, { d[(size_t)r * 1024 + c] = f2bf(v); })
    } else {
      const int cc0 = col0 - 9216;
      ACC_FOREACH(2, acc, {
        const int cc = cc0 + c;
        if (cc < 256) lora[(size_t)(row0 + r) * 256 + cc] = f2bf(v);
        else if (cc < 272) dtp[(size_t)(row0 + r) * 16 + (cc - 256)] = softplusf_(v + dtb[cc - 256]);
      })
    }
  }
}

DI void phase_lora_prep(const Params& p, int l, int bid, int nb) {
  const bf16_t* raw = slab(p, 3);
  bf16_t* act = (bf16_t*)(p.ws + O_LACT);
  const float* mu = p.in[I_MU] + l * 3328 + 3072;
  for (int it = bid * 256 + tidx(); it < T_ * 32; it += nb * 256) {
    const int t = it >> 5, c8 = (it & 31) * 8;
    uint4 cur = *(const uint4*)(raw + (size_t)t * 256 + c8);
    uint4 prv = {0, 0, 0, 0};
    if (t & (S_ - 1)) prv = *(const uint4*)(raw + (size_t)(t - 1) * 256 + c8);
    float x[8], xp[8], o[8];
    unpack8(cur, x); unpack8(prv, xp);
#pragma unroll
    for (int e = 0; e < 8; ++e) {
      const int j = c8 + e;
      const float xs = x[e] + (xp[e] - x[e]) * mu[j];
      o[e] = j < 64 ? tanhf(xs) : (j < 128 ? xs : sigmoidf_(xs));
    }
    *(uint4*)(act + (size_t)t * 256 + c8) = pack8(o);
  }
}
template <class F>
DI void gemm_lora_phase(const Params& p, int aoff, int K, const bf16_t* wt, int bid, int nb, char* smem, F epi) {
  bf16_t* sA = (bf16_t*)smem; bf16_t* sB = sA + 128 * LDT;
  const bf16_t* A = (const bf16_t*)(p.ws + O_LACT) + aoff;
  for (int t = bid; t < 256 * 8; t += nb) {
    const int tm = t >> 3, tn = t & 7;
    f32x16 acc[2][2]; acc_zero<2>(acc);
    gemm_core<2>(A + (size_t)tm * 128 * 256, 256, wt + (size_t)tn * 128 * K, K, K, sA, sB, acc);
    const int row0 = tm * 128, col0 = tn * 128;
    ACC_FOREACH(2, acc, { epi(row0 + r, col0 + c, v); })
  }
}
DI void phase_lora_wa(const Params& p, int l, int bid, int nb, char* smem) {
  const float* w0 = p.in[I_W0] + l * 1024; const float* a0 = p.in[I_A0] + l * 1024;
  bf16_t* ew = slab(p, 1); bf16_t* av = slab(p, 2);
  gemm_lora_phase(p, 0, 64, (const bf16_t*)(p.ws + O_WW2), bid, nb, smem, [&](int r, int c, float v) {
    const float wpre = w0[c] + v;
    const float w = -softplusf_(-wpre) - 0.5f;
    ew[(size_t)r * 1024 + c] = f2bf(__expf(w));
  });
  gemm_lora_phase(p, 64, 64, (const bf16_t*)(p.ws + O_WA2), bid, nb, smem, [&](int r, int c, float v) {
    av[(size_t)r * 1024 + c] = f2bf(sigmoidf_(a0[c] + v));
  });
}
DI void phase_rwkv_scan(const Params& p, int l, int bid, int nb, char* smem) {
  float* fbase = (float*)smem;
  constexpr int BUF = 5376;
  const int tid = tidx(), lane = tid & 63, wave = tid >> 6;
  const bf16_t* R = slab(p, 4); const bf16_t* Kx = slab(p, 5); const bf16_t* V = slab(p, 6);
  const bf16_t* EW = slab(p, 1); const bf16_t* AV = slab(p, 2);
  bf16_t* Y = slab(p, 3);
  float* rbout = (float*)(p.ws + O_RB);
  for (int task = bid; task < 256; task += nb) {
    const int qd = task & 7, head = (task >> 3) & 15, b = task >> 7;
    __syncthreads();
    if (wave >= 2) {
      const int st = (tid & 127) >> 3, c8 = tid & 7, ch0 = head * 64 + c8 * 8;
      float mur[8], muk[8], muv[8], ckk[8], cka[8], crk[8];
#pragma unroll
      for (int e = 0; e < 8; ++e) {
        mur[e] = p.in[I_MU][l * 3328 + ch0 + e]; muk[e] = p.in[I_MU][l * 3328 + 1024 + ch0 + e]; muv[e] = p.in[I_MU][l * 3328 + 2048 + ch0 + e];
        ckk[e] = p.in[I_KK][l * 1024 + ch0 + e]; cka[e] = p.in[I_KA][l * 1024 + ch0 + e]; crk[e] = p.in[I_RK][l * 1024 + ch0 + e];
      }
      uint4 gr, gk, gv, gw, ga, gpr, gpk, gpv;
      auto gload = [&](int c) {
        const int ts = c * 16 + st;
        const size_t o = ((size_t)b * S_ + ts) * 1024 + ch0;
        gr = *(const uint4*)(R + o); gk = *(const uint4*)(Kx + o); gv = *(const uint4*)(V + o);
        gw = *(const uint4*)(EW + o); ga = *(const uint4*)(AV + o);
        if (ts > 0) { gpr = *(const uint4*)(R + o - 1024); gpk = *(const uint4*)(Kx + o - 1024); gpv = *(const uint4*)(V + o - 1024); }
        else { gpr = make_uint4(0, 0, 0, 0); gpk = gpr; gpv = gpr; }
      };
      auto stage = [&](int c) {
        float* bufp = fbase + (c & 1) * BUF;
        float* sa = bufp; float* sw = sa + 1024; float* sb = sw + 1024; float* sk = sb + 1024; float* sr = sk + 1024; float* sv = sr + 1024;
        float r[8], k[8], v[8], w[8], a[8], pr[8], pk[8], pv[8];
        unpack8(gr, r); unpack8(gk, k); unpack8(gv, v); unpack8(gw, w); unpack8(ga, a); unpack8(gpr, pr); unpack8(gpk, pk); unpack8(gpv, pv);
        float kk[8], ss = 0.f, rbs = 0.f;
#pragma unroll
        for (int e = 0; e < 8; ++e) {
          r[e] = r[e] + (pr[e] - r[e]) * mur[e];
          k[e] = k[e] + (pk[e] - k[e]) * muk[e];
          v[e] = v[e] + (pv[e] - v[e]) * muv[e];
          kk[e] = k[e] * ckk[e]; ss += kk[e] * kk[e];
        }
        ss = red8(ss);
        const float inv = rsqrtf(fmaxf(ss, 1e-12f));
        float oa[8], ow[8], ob[8], ok[8];
#pragma unroll
        for (int e = 0; e < 8; ++e) {
          kk[e] *= inv;
          ok[e] = k[e] * (1.f + (a[e] - 1.f) * cka[e]);
          oa[e] = -kk[e]; ob[e] = kk[e] * a[e]; ow[e] = __expf(-w[e]);
          rbs += r[e] * ok[e] * crk[e];
        }
        rbs = red8(rbs);
        float* d;
        d = sa + st * 64 + c8 * 8; *(float4*)d = make_float4(oa[0], oa[1], oa[2], oa[3]); *(float4*)(d + 4) = make_float4(oa[4], oa[5], oa[6], oa[7]);
        d = sw + st * 64 + c8 * 8; *(float4*)d = make_float4(ow[0], ow[1], ow[2], ow[3]); *(float4*)(d + 4) = make_float4(ow[4], ow[5], ow[6], ow[7]);
        d = sb + st * 64 + c8 * 8; *(float4*)d = make_float4(ob[0], ob[1], ob[2], ob[3]); *(float4*)(d + 4) = make_float4(ob[4], ob[5], ob[6], ob[7]);
        d = sk + st * 64 + c8 * 8; *(float4*)d = make_float4(ok[0], ok[1], ok[2], ok[3]); *(float4*)(d + 4) = make_float4(ok[4], ok[5], ok[6], ok[7]);
        d = sr + st * 64 + c8 * 8; *(float4*)d = make_float4(r[0], r[1], r[2], r[3]); *(float4*)(d + 4) = make_float4(r[4], r[5], r[6], r[7]);
        if (c8 == qd) { d = sv + st * 8; *(float4*)d = make_float4(v[0], v[1], v[2], v[3]); *(float4*)(d + 4) = make_float4(v[4], v[5], v[6], v[7]); }
        if (qd == 0 && c8 == 0) rbout[((size_t)b * S_ + c * 16 + st) * 16 + head] = rbs;
      };
      auto ywrite = [&](int c) {
        const int j = tid & 127;
        if (j < 16) {
          const float* sy = fbase + (c & 1) * BUF + 5248;
          float f[8];
#pragma unroll
          for (int e = 0; e < 8; ++e) f[e] = sy[j * 8 + e];
          *(uint4*)(Y + ((size_t)b * S_ + c * 16 + j) * 1024 + head * 64 + qd * 8) = pack8(f);
        }
      };
      gload(0);
      stage(0);
      gload(1);
      __syncthreads();
      for (int c = 0; c < 1024; ++c) {
        if (c + 1 < 1024) stage(c + 1);
        if (c + 2 < 1024) gload(c + 2);
        if (c > 0) ywrite(c - 1);
        __syncthreads();
      }
      ywrite(1023);
    } else {
      const int rowl = wave * 4 + (lane >> 4), pp = lane & 15;
      f32x2 st01 = {0.f, 0.f}, st23 = {0.f, 0.f};
      __syncthreads();
      for (int c = 0; c < 1024; ++c) {
        const float* bufp = fbase + (c & 1) * BUF;
        const float* sa = bufp; const float* sw = sa + 1024; const float* sb = sw + 1024; const float* sk = sb + 1024; const float* sr = sk + 1024;
        const float* sv = sr + 1024; float* sy = (float*)sv + 128;
        float yk0 = 0.f;
        f32x4 a4 = *(const f32x4*)(sa + 4 * pp), w4 = *(const f32x4*)(sw + 4 * pp), b4 = *(const f32x4*)(sb + 4 * pp);
        f32x4 k4 = *(const f32x4*)(sk + 4 * pp), r4 = *(const f32x4*)(sr + 4 * pp);
        float vv = sv[rowl];
#pragma unroll
        for (int s = 0; s < 16; ++s) {
          f32x4 a4n = a4, w4n = w4, b4n = b4, k4n = k4, r4n = r4; float vvn = vv;
          if (s + 1 < 16) {
            a4n = *(const f32x4*)(sa + (s + 1) * 64 + 4 * pp); w4n = *(const f32x4*)(sw + (s + 1) * 64 + 4 * pp);
            b4n = *(const f32x4*)(sb + (s + 1) * 64 + 4 * pp); k4n = *(const f32x4*)(sk + (s + 1) * 64 + 4 * pp);
            r4n = *(const f32x4*)(sr + (s + 1) * 64 + 4 * pp); vvn = sv[(s + 1) * 8 + rowl];
          }
          f32x2 t = st01 * a4.xy + st23 * a4.zw;
          const float d = red16(t.x + t.y);
          st01 = st01 * w4.xy + b4.xy * d + k4.xy * vv;
          st23 = st23 * w4.zw + b4.zw * d + k4.zw * vv;
          f32x2 u = st01 * r4.xy + st23 * r4.zw;
          const float y = red16(u.x + u.y);
          yk0 = (pp == s) ? y : yk0;
          a4 = a4n; w4 = w4n; b4 = b4n; k4 = k4n; r4 = r4n; vv = vvn;
        }
        sy[pp * 8 + rowl] = yk0;
        __syncthreads();
      }
    }
  }
}
DI void phase_rwkv_ln(const Params& p, int l, int bid, int nb) {
  bf16_t* Y = slab(p, 3); const bf16_t* V = slab(p, 6);
  const float* rb = (const float*)(p.ws + O_RB);
  const float* lng = p.in[I_LNG] + l * 1024; const float* lnb = p.in[I_LNB] + l * 1024; const float* muv = p.in[I_MU] + l * 3328 + 2048;
  for (int it = bid * 256 + tidx(); it < T_ * 128; it += nb * 256) {
    const int t = it >> 7, c8 = (it & 127) * 8, head = c8 >> 6;
    float y[8], v[8], pv[8], o[8];
    unpack8(*(const uint4*)(Y + (size_t)t * 1024 + c8), y);
    unpack8(*(const uint4*)(V + (size_t)t * 1024 + c8), v);
    uint4 pz = {0, 0, 0, 0};
    if (t & (S_ - 1)) pz = *(const uint4*)(V + (size_t)(t - 1) * 1024 + c8);
    unpack8(pz, pv);
    float s = 0.f;
#pragma unroll
    for (int e = 0; e < 8; ++e) s += y[e];
    s = red8(s);
    const float mean = s * (1.f / 64.f);
    float q = 0.f;
#pragma unroll
    for (int e = 0; e < 8; ++e) { const float d = y[e] - mean; q += d * d; }
    q = red8(q);
    const float rstd = rsqrtf(q * (1.f / 64.f) + 64e-5f);
    const float rbv = rb[(size_t)t * 16 + head];
#pragma unroll
    for (int e = 0; e < 8; ++e) {
      const float vs = v[e] + (pv[e] - v[e]) * muv[c8 + e];
      o[e] = (y[e] - mean) * rstd * lng[c8 + e] + lnb[c8 + e] + rbv * vs;
    }
    *(uint4*)(Y + (size_t)t * 1024 + c8) = pack8(o);
  }
}
DI void phase_rwkv_g(const Params& p, int l, int bid, int nb, char* smem) {
  bf16_t* Y = slab(p, 3);
  gemm_lora_phase(p, 128, 128, (const bf16_t*)(p.ws + O_WG2), bid, nb, smem, [&](int r, int c, float v) {
    const size_t o = (size_t)r * 1024 + c;
    Y[o] = f2bf(bf2f(Y[o]) * v);
  });
}

DI void phase_ssd_conv(const Params& p, int l, int bid, int nb) {
  const bf16_t* rx = slab(p, 2); const bf16_t* rbc = slab(p, 4);
  bf16_t* xs = slab(p, 5); bf16_t* bc = slab(p, 6);
  const float* cw = p.in[I_CONVW] + l * 4 * 2048; const float* cb = p.in[I_CONVB] + l * 2048;
  for (int it = bid * 256 + tidx(); it < T_ * 256; it += nb * 256) {
    const int t = it >> 8, c8 = (it & 255) * 8;
    const bf16_t* src = c8 < 1024 ? rx : rbc; bf16_t* dst = c8 < 1024 ? xs : bc;
    const int cc = c8 & 1023, ts = t & (S_ - 1);
    float acc[8];
#pragma unroll
    for (int e = 0; e < 8; ++e) acc[e] = cb[c8 + e];
#pragma unroll
    for (int k = 0; k < 4; ++k) {
      if (ts - 3 + k >= 0) {
        float x[8]; unpack8(*(const uint4*)(src + (size_t)(t - 3 + k) * 1024 + cc), x);
#pragma unroll
        for (int e = 0; e < 8; ++e) acc[e] += x[e] * cw[k * 2048 + c8 + e];
      }
    }
#pragma unroll
    for (int e = 0; e < 8; ++e) acc[e] = siluf_(acc[e]);
    *(uint4*)(dst + (size_t)t * 1024 + cc) = pack8(acc);
  }
}
DI float* scan128(float* a, float* b) {
  const int tid = tidx();
  float* src = a; float* dst = b;
  for (int off = 1; off < 128; off <<= 1) {
    if (tid < 128) dst[tid] = src[tid] + (tid >= off ? src[tid - off] : 0.f);
    __syncthreads();
    float* t = src; src = dst; dst = t;
  }
  return src;
}
DI void phase_ssd_states(const Params& p, int l, int bid, int nb, char* smem) {
  bf16_t* sXT = (bf16_t*)smem;
  bf16_t* sBT = sXT + 64 * 136;
  float* fa = (float*)(sBT + 128 * 136);
  float* fb = fa + 128; float* fdt = fb + 128;
  const int tid = tidx(), lane = tid & 63, wave = tid >> 6;
  const bf16_t* xs = slab(p, 5); const bf16_t* bc = slab(p, 6);
  const float* dt = (const float*)(p.ws + O_DT);
  float* cdec = (float*)(p.ws + O_CDEC);
  for (int task = bid; task < 4096; task += nb) {
    const int head = task & 15, c = (task >> 4) & 127, b = task >> 11, g = head >> 2;
    const size_t t0 = (size_t)b * S_ + c * 128;
    const float aneg = -__expf(p.in[I_ALOG][l * 16 + head]);
    __syncthreads();
    if (tid < 128) { const float d = dt[(t0 + tid) * 16 + head]; fdt[tid] = d; fa[tid] = d * aneg; }
    __syncthreads();
    float* acs = scan128(fa, fb);
    const float alast = acs[127];
    if (tid == 0) cdec[(b * 128 + c) * 16 + head] = __expf(alast);
#pragma unroll
    for (int j = 0; j < 4; ++j) {
      const int ci = tid + 256 * j, lr = ci >> 3, p8 = (ci & 7) * 8;
      float x[8]; unpack8(*(const uint4*)(xs + (t0 + lr) * 1024 + head * 64 + p8), x);
      const float sc = fdt[lr] * __expf(alast - acs[lr]);
#pragma unroll
      for (int e = 0; e < 8; ++e) sXT[(p8 + e) * 136 + lr] = f2bf(x[e] * sc);
    }
#pragma unroll
    for (int j = 0; j < 8; ++j) {
      const int ci = tid + 256 * j, lr = ci >> 4, n8 = (ci & 15) * 8;
      const uint4 u = *(const uint4*)(bc + (t0 + lr) * 1024 + g * 128 + n8);
#pragma unroll
      for (int e = 0; e < 8; ++e) sBT[(n8 + e) * 136 + lr] = get16(u, e);
    }
    __syncthreads();
    f32x16 acc[2];
#pragma unroll
    for (int mi = 0; mi < 2; ++mi)
#pragma unroll
      for (int i = 0; i < 16; ++i) acc[mi][i] = 0.f;
#pragma unroll
    for (int kk = 0; kk < 8; ++kk) {
      const bf16x8 bf = *(const bf16x8*)(sBT + (wave * 32 + (lane & 31)) * 136 + kk * 16 + (lane >> 5) * 8);
#pragma unroll
      for (int mi = 0; mi < 2; ++mi) {
        const bf16x8 af = *(const bf16x8*)(sXT + (mi * 32 + (lane & 31)) * 136 + kk * 16 + (lane >> 5) * 8);
        acc[mi] = MFMA32(af, bf, acc[mi]);
      }
    }
    float* st = (float*)slab(p, b == 0 ? 2 : 4) + ((size_t)(c * 16 + head) * 64) * 128;
#pragma unroll
    for (int mi = 0; mi < 2; ++mi)
#pragma unroll
      for (int i = 0; i < 16; ++i) st[(size_t)(mi * 32 + crow(i, lane >> 5)) * 128 + wave * 32 + (lane & 31)] = acc[mi][i];
  }
}
DI void phase_ssd_scan(const Params& p, int bid, int nb) {
  const float* cdec = (const float*)(p.ws + O_CDEC);
  for (int it = bid * 256 + tidx(); it < 2 * 16 * 8192; it += nb * 256) {
    const int b = it >> 17, rem = it & 131071, head = rem >> 13;
    float* st = (float*)slab(p, b == 0 ? 2 : 4) + rem;
    float h = 0.f;
#pragma unroll 8
    for (int c = 0; c < 128; ++c) {
      const float s = st[(size_t)c * 131072];
      st[(size_t)c * 131072] = h;
      h = h * cdec[(b * 128 + c) * 16 + head] + s;
    }
  }
}
DI void phase_ssd_out(const Params& p, int l, int bid, int nb, char* smem) {
  bf16_t* sM = (bf16_t*)smem;
  bf16_t* sXT = sM + 128 * 136;
  float* fa = (float*)(sXT + 64 * 136); float* fb = fa + 128; float* fdt = fb + 128; float* frs = fdt + 128;
  const int tid_ = tidx(), lane = tid_ & 63, wave_ = __builtin_amdgcn_readfirstlane(tid_ >> 6), hh_ = lane >> 5, l31_ = lane & 31;
  const bf16_t* xs = slab(p, 5); const bf16_t* bc = slab(p, 6);
  bf16_t* zy = slab(p, 1);
  const float* dt = (const float*)(p.ws + O_DT);
  const float* ng = p.in[I_SSDNG] + l * 1024;
  for (int task = bid; task < 1024; task += nb) {
    const int g = task & 3, c = (task >> 2) & 127, b = task >> 9;
    const size_t t0 = (size_t)b * S_ + c * 128;
    int tid = tid_; asm volatile("" : "+v"(tid));
    __syncthreads();
#pragma unroll 2
    for (int j = 0; j < 8; ++j) {
      const int ci = tid + 256 * j, lr = ci >> 4, n8 = (ci & 15) * 8;
      *(uint4*)(sM + lr * 136 + n8) = *(const uint4*)(bc + (t0 + lr) * 1024 + g * 128 + n8);
    }
    const int wave = wave_, hh = hh_, l31 = l31_;
    const bf16_t* cptr = bc + (t0 + wave * 32 + l31) * 1024 + 512 + g * 128 + hh * 8;
    __syncthreads();
    f32x16 cb[4];
#pragma unroll
    for (int ni = 0; ni < 4; ++ni)
#pragma unroll
      for (int i = 0; i < 16; ++i) cb[ni][i] = 0.f;
#pragma unroll
    for (int kk = 0; kk < 8; ++kk) {
      const bf16x8 cfk = *(const bf16x8*)(cptr + kk * 16);
#pragma unroll
      for (int ni = 0; ni < 4; ++ni) {
        const bf16x8 bf = *(const bf16x8*)(sM + (ni * 32 + l31) * 136 + kk * 16 + hh * 8);
        cb[ni] = MFMA32(cfk, bf, cb[ni]);
      }
    }
    float ssq[16];
#pragma unroll
    for (int i = 0; i < 16; ++i) ssq[i] = 0.f;
#pragma unroll 1
    for (int e = 0; e < 4; ++e) {
      int l31 = l31_, hh = hh_, wave = wave_;
      asm volatile("" : "+v"(l31), "+v"(hh));
      asm volatile("" : "+s"(wave));
      const int head = g * 4 + e;
      const float aneg = -__expf(p.in[I_ALOG][l * 16 + head]);
      const float dsk = p.in[I_DSKIP][l * 16 + head];
      __syncthreads();
      if (tid < 128) { const float d = dt[(t0 + tid) * 16 + head]; fdt[tid] = d; fa[tid] = d * aneg; }
      __syncthreads();
      float* acs = scan128(fa, fb);
#pragma unroll 2
      for (int j = 0; j < 4; ++j) {
        const int ci = tid + 256 * j, lr = ci >> 3, p8 = (ci & 7) * 8;
        const uint4 u = *(const uint4*)(xs + (t0 + lr) * 1024 + head * 64 + p8);
#pragma unroll
        for (int q = 0; q < 8; ++q) sXT[(p8 + q) * 136 + lr] = get16(u, q);
      }
#pragma unroll
      for (int ni = 0; ni < 4; ++ni)
#pragma unroll
        for (int i = 0; i < 16; ++i) {
          const int lr = wave * 32 + crow(i, hh), sc = ni * 32 + l31;
          const float m = sc <= lr ? cb[ni][i] * __expf(acs[lr] - acs[sc]) * fdt[sc] : 0.f;
          sM[lr * 136 + sc] = f2bf(m);
        }
      __syncthreads();
      const float* hin = (const float*)slab(p, b == 0 ? 2 : 4) + ((size_t)(c * 16 + head) * 64) * 128;
#pragma unroll 1
      for (int ni = 0; ni < 2; ++ni) {
        f32x16 yd;
#pragma unroll
        for (int i = 0; i < 16; ++i) yd[i] = 0.f;
#pragma unroll 2
        for (int kk = 0; kk < 8; ++kk) {
          const bf16x8 cfk = *(const bf16x8*)(cptr + kk * 16);
          const float* hp = hin + (size_t)(ni * 32 + l31) * 128 + kk * 16 + hh * 8;
          const float4 h0 = *(const float4*)hp, h1 = *(const float4*)(hp + 4);
          u32x4 u; u.x = pack2(h0.x, h0.y); u.y = pack2(h0.z, h0.w); u.z = pack2(h1.x, h1.y); u.w = pack2(h1.z, h1.w);
          yd = MFMA32(cfk, __builtin_bit_cast(bf16x8, u), yd);
        }
#pragma unroll
        for (int i = 0; i < 16; ++i) yd[i] *= (SSD_PROBE == 2 ? 0.f : __expf(acs[wave * 32 + crow(i, hh)]));
#pragma unroll
        for (int kk = 0; kk < 8; ++kk) {
          const bf16x8 af = *(const bf16x8*)(sM + (wave * 32 + l31) * 136 + kk * 16 + hh * 8);
          const bf16x8 bf = *(const bf16x8*)(sXT + (ni * 32 + l31) * 136 + kk * 16 + hh * 8);
          yd = MFMA32(af, bf, yd);
        }
#pragma unroll
        for (int i = 0; i < 16; ++i) {
          const int lr = wave * 32 + crow(i, hh), pc = ni * 32 + l31;
          const float xv = bf2f(sXT[pc * 136 + lr]);
          float y = (SSD_PROBE == 1 ? 0.f : yd[i]) + xv * dsk;
          const size_t o = (t0 + lr) * 1024 + head * 64 + pc;
          const float zv = bf2f(zy[o]);
          y *= siluf_(zv);
          ssq[i] += y * y;
          zy[o] = f2bf(y);
        }
      }
    }
#pragma unroll
    for (int i = 0; i < 16; ++i) {
      float s = ssq[i];
      for (int o = 16; o > 0; o >>= 1) s += __shfl_xor(s, o);
      if (l31 == 0) frs[wave * 32 + crow(i, hh)] = rsqrtf(s * (1.f / 256.f) + 1e-6f);
    }
    __syncthreads();
#pragma unroll 1
    for (int j = 0; j < (DBG == 2 ? 0 : 16); ++j) {
      const int ci = tid + 256 * j, lr = ci >> 5, c8 = (ci & 31) * 8;
      bf16_t* ptr = zy + (t0 + lr) * 1024 + g * 256 + c8;
      float f[8]; unpack8(*(const uint4*)ptr, f);
      const float rs = frs[lr];
#pragma unroll
      for (int q = 0; q < 8; ++q) f[q] *= rs * ng[g * 256 + c8 + q];
      *(uint4*)ptr = pack8(f);
    }
  }
}

DI void phase_moba_norm(const Params& p, int l, int bid, int nb, char* smem) {
  float* sK = (float*)smem;
  const int tid = tidx(), rg = tid >> 4, ln = tid & 15;
  bf16_t* Q = slab(p, 2); bf16_t* Kx = slab(p, 4);
  float* kmean = (float*)(p.ws + O_KMEAN);
  float qg[8], kg[8];
#pragma unroll
  for (int e = 0; e < 8; ++e) { qg[e] = p.in[I_QNG][l * 128 + ln * 8 + e]; kg[e] = p.in[I_KNG][l * 128 + ln * 8 + e]; }
  for (int task = bid; task < 1024; task += nb) {
    const int blk = task & 63, h = (task >> 6) & 7, b = task >> 9;
    const size_t t0 = (size_t)b * S_ + blk * 256;
    float ks[8];
#pragma unroll
    for (int e = 0; e < 8; ++e) ks[e] = 0.f;
    for (int j = 0; j < 16; ++j) {
      const size_t o = (t0 + rg + 16 * j) * 1024 + h * 128 + ln * 8;
      float f[8]; float ss = 0.f;
      unpack8(*(const uint4*)(Q + o), f);
#pragma unroll
      for (int e = 0; e < 8; ++e) ss += f[e] * f[e];
      ss = red16(ss);
      float r = rsqrtf(ss * (1.f / 128.f) + 1e-6f);
#pragma unroll
      for (int e = 0; e < 8; ++e) f[e] *= r * qg[e];
      *(uint4*)(Q + o) = pack8(f);
      unpack8(*(const uint4*)(Kx + o), f);
      ss = 0.f;
#pragma unroll
      for (int e = 0; e < 8; ++e) ss += f[e] * f[e];
      ss = red16(ss);
      r = rsqrtf(ss * (1.f / 128.f) + 1e-6f);
#pragma unroll
      for (int e = 0; e < 8; ++e) { f[e] *= r * kg[e]; ks[e] += f[e]; }
      *(uint4*)(Kx + o) = pack8(f);
    }
    __syncthreads();
#pragma unroll
    for (int e = 0; e < 8; ++e) sK[rg * 128 + ln * 8 + e] = ks[e];
    __syncthreads();
    if (tid < 128) {
      float s = 0.f;
#pragma unroll
      for (int j = 0; j < 16; ++j) s += sK[j * 128 + tid];
      kmean[((size_t)(b * 8 + h) * 64 + blk) * 128 + tid] = s * (1.f / 256.f);
    }
  }
}
DI void phase_moba_gate(const Params& p, int bid, int nb, char* smem) {
  float* sKm = (float*)smem;
  const int tid = tidx();
  const bf16_t* Q = slab(p, 2);
  const float* kmean = (const float*)(p.ws + O_KMEAN);
  int* sel = (int*)(p.ws + O_SEL); int* cnt = (int*)(p.ws + O_CNT);
  for (int task = bid; task < 1024; task += nb) {
    const int blk = task & 63, h = (task >> 6) & 7, b = task >> 9;
    __syncthreads();
    for (int i = tid; i < blk * 128; i += 256) sKm[i] = kmean[((size_t)(b * 8 + h) * 64) * 128 + i];
    __syncthreads();
    const size_t t = (size_t)b * S_ + blk * 256 + tid;
    float q[128];
#pragma unroll
    for (int j = 0; j < 16; ++j) unpack8(*(const uint4*)(Q + t * 1024 + h * 128 + j * 8), q + j * 8);
    float v0 = -3e38f, v1 = -3e38f, v2 = -3e38f; int i0 = -1, i1 = -1, i2 = -1;
    for (int j = 0; j < blk; ++j) {
      float d = 0.f;
#pragma unroll
      for (int e = 0; e < 128; ++e) d += q[e] * sKm[j * 128 + e];
      if (d > v0) { v2 = v1; i2 = i1; v1 = v0; i1 = i0; v0 = d; i0 = j; }
      else if (d > v1) { v2 = v1; i2 = i1; v1 = d; i1 = j; }
      else if (d > v2) { v2 = d; i2 = j; }
    }
    int* so = sel + (t * 8 + h) * 3;
    so[0] = i0; so[1] = i1; so[2] = i2;
    const int base = (b * 8 + h) * 64;
    if (i0 >= 0) atomicAdd(cnt + 0 * 1024 + base + i0, 1);
    if (i1 >= 0) atomicAdd(cnt + 1 * 1024 + base + i1, 1);
    if (i2 >= 0) atomicAdd(cnt + 2 * 1024 + base + i2, 1);
  }
}
DI void phase_moba_fill(const Params& p, int bid, int nb, char* smem) {
  int* sBase = (int*)smem;
  const int tid = tidx();
  const int* sel = (const int*)(p.ws + O_SEL); const int* cnt = (const int*)(p.ws + O_CNT);
  int* fill = (int*)(p.ws + O_FILL); int* lists = (int*)(p.ws + O_LISTS);
  for (int task = bid; task < 1024; task += nb) {
    const int blk = task & 63, h = (task >> 6) & 7, b = task >> 9;
    const int base = (b * 8 + h) * 64;
    __syncthreads();
    if (tid < 3) { int a = 0; for (int j = 0; j < 64; ++j) { sBase[tid * 64 + j] = a; a += cnt[tid * 1024 + base + j]; } }
    __syncthreads();
    const int ts = blk * 256 + tid;
    const size_t t = (size_t)b * S_ + ts;
    for (int s = 0; s < 3; ++s) {
      const int j = sel[(t * 8 + h) * 3 + s];
      if (j >= 0) {
        const int pos = sBase[s * 64 + j] + atomicAdd(fill + s * 1024 + base + j, 1);
        lists[(size_t)s * (T_ * 8) + (size_t)(b * 8 + h) * S_ + pos] = ts;
      }
    }
  }
}
DI int t5_bucket(int d) {
  if (d < 16) return d;
  const int large = 16 + (int)(__logf((float)d * (1.f / 16.f)) / 4.1588830833596715f * 16.f);
  return large < 31 ? large : 31;
}
struct MobaLds { bf16_t* sK; bf16_t* sVT; float* sBias; };
DI void moba_block(const Params& p, const MobaLds& L, int b, int h, int tsq  , int kb  ,
                   int ntiles, bool causal, bool init) {
  const int tid = tidx(), lane = tid & 63, hh = lane >> 5, l31 = lane & 31;
  const bf16_t* Q = slab(p, 2); const bf16_t* Kx = slab(p, 4); const bf16_t* V = slab(p, 5);
  bf16_t* ACC = slab(p, 6);
  float* MM = (float*)(p.ws + O_MM); float* ML = (float*)(p.ws + O_ML);
  const bool valid = tsq >= 0;
  const size_t tq = (size_t)b * S_ + (valid ? tsq : 0);
  bf16x8 qf[8];
#pragma unroll
  for (int kk = 0; kk < 8; ++kk) {
    uint4 u = {0, 0, 0, 0};
    if (valid) u = *(const uint4*)(Q + tq * 1024 + h * 128 + kk * 16 + hh * 8);
    qf[kk] = __builtin_bit_cast(bf16x8, u);
  }
  float m = -1e30f, lsum = 0.f;
  f32x16 o[4];
#pragma unroll
  for (int dt = 0; dt < 4; ++dt)
#pragma unroll
    for (int i = 0; i < 16; ++i) o[dt][i] = 0.f;
  if (!init && valid) {
    m = MM[tq * 8 + h]; lsum = ML[tq * 8 + h];
#pragma unroll
    for (int dt = 0; dt < 4; ++dt)
#pragma unroll
      for (int g4 = 0; g4 < 4; ++g4) {
        const uint2 u = *(const uint2*)(ACC + tq * 1024 + h * 128 + dt * 32 + g4 * 8 + hh * 4);
        o[dt][g4 * 4 + 0] = lo16(u.x) * lsum; o[dt][g4 * 4 + 1] = hi16(u.x) * lsum;
        o[dt][g4 * 4 + 2] = lo16(u.y) * lsum; o[dt][g4 * 4 + 3] = hi16(u.y) * lsum;
      }
  }
  int wmaxq = valid ? tsq : -1;
  for (int of = 32; of > 0; of >>= 1) wmaxq = max(wmaxq, __shfl_xor(wmaxq, of));
  const float bias31 = L.sBias[1023];
  const float scale = 0.08838834764831845f;
  const size_t k0 = (size_t)b * S_ + (size_t)kb * 256;
  for (int kt = 0; kt < ntiles; ++kt) {
    __syncthreads();
#pragma unroll
    for (int j = 0; j < 4; ++j) {
      const int ci = tid + 256 * j, kr = ci >> 4, d8 = (ci & 15) * 8;
      const size_t go = (k0 + kt * 64 + kr) * 1024 + h * 128 + d8;
      *(uint4*)(L.sK + kr * 136 + d8) = *(const uint4*)(Kx + go);
      const uint4 u = *(const uint4*)(V + go);
#pragma unroll
      for (int e = 0; e < 8; ++e) L.sVT[(d8 + e) * 72 + kr] = get16(u, e);
    }
    __syncthreads();
    const int kpos0 = kb * 256 + kt * 64;
    if (causal && kpos0 > wmaxq) continue;
    f32x16 st[2];
#pragma unroll
    for (int t2 = 0; t2 < 2; ++t2)
#pragma unroll
      for (int i = 0; i < 16; ++i) st[t2][i] = 0.f;
#pragma unroll
    for (int kk = 0; kk < 8; ++kk)
#pragma unroll
      for (int t2 = 0; t2 < 2; ++t2) {
        const bf16x8 af = *(const bf16x8*)(L.sK + (t2 * 32 + l31) * 136 + kk * 16 + hh * 8);
        st[t2] = MFMA32(af, qf[kk], st[t2]);
      }
    float mloc = -1e30f;
#pragma unroll
    for (int t2 = 0; t2 < 2; ++t2)
#pragma unroll
      for (int i = 0; i < 16; ++i) {
        const int kp = kpos0 + t2 * 32 + crow(i, hh);
        const int dist = tsq - kp;
        float s;
        if (causal && dist < 0) s = -1e30f;
        else {
          const int dd = dist < 0 ? 0 : dist;
          s = st[t2][i] * scale + (dd < 1024 ? L.sBias[dd] : bias31);
        }
        st[t2][i] = s;
        mloc = fmaxf(mloc, s);
      }
    mloc = fmaxf(mloc, __shfl_xor(mloc, 32));
    const float mnew = fmaxf(m, mloc);
    const float alpha = __expf(m - mnew);
    float ls = 0.f;
#pragma unroll
    for (int t2 = 0; t2 < 2; ++t2)
#pragma unroll
      for (int i = 0; i < 16; ++i) {
        const float pv = st[t2][i] <= -1e29f ? 0.f : __expf(st[t2][i] - mnew);
        st[t2][i] = pv; ls += pv;
      }
    ls += __shfl_xor(ls, 32);
    lsum = lsum * alpha + ls;
    m = mnew;
#pragma unroll
    for (int dt = 0; dt < 4; ++dt)
#pragma unroll
      for (int i = 0; i < 16; ++i) o[dt][i] *= alpha;
#pragma unroll
    for (int t2 = 0; t2 < 2; ++t2)
#pragma unroll
      for (int s2 = 0; s2 < 2; ++s2) {
        uint4 pu;
        pu.x = pack2(st[t2][8 * s2 + 0], st[t2][8 * s2 + 1]); pu.y = pack2(st[t2][8 * s2 + 2], st[t2][8 * s2 + 3]);
        pu.z = pack2(st[t2][8 * s2 + 4], st[t2][8 * s2 + 5]); pu.w = pack2(st[t2][8 * s2 + 6], st[t2][8 * s2 + 7]);
        const bf16x8 pf = __builtin_bit_cast(bf16x8, pu);
#pragma unroll
        for (int dt = 0; dt < 4; ++dt) {
          const bf16_t* vp = L.sVT + (dt * 32 + l31) * 72 + t2 * 32 + s2 * 16 + hh * 4;
          uint4 vu; const uint2 a0 = *(const uint2*)vp, a1 = *(const uint2*)(vp + 8);
          vu.x = a0.x; vu.y = a0.y; vu.z = a1.x; vu.w = a1.y;
          o[dt] = MFMA32(__builtin_bit_cast(bf16x8, vu), pf, o[dt]);
        }
      }
  }
  if (valid) {
    const float inv = 1.f / lsum;
    if (hh == 0) { MM[tq * 8 + h] = m; ML[tq * 8 + h] = lsum; }
#pragma unroll
    for (int dt = 0; dt < 4; ++dt)
#pragma unroll
      for (int g4 = 0; g4 < 4; ++g4) {
        uint2 u; u.x = pack2(o[dt][g4 * 4] * inv, o[dt][g4 * 4 + 1] * inv); u.y = pack2(o[dt][g4 * 4 + 2] * inv, o[dt][g4 * 4 + 3] * inv);
        *(uint2*)(ACC + tq * 1024 + h * 128 + dt * 32 + g4 * 8 + hh * 4) = u;
      }
  }
}
DI void moba_bias_table(const Params& p, float* sBias, int h) {
  for (int d = tidx(); d < 1024; d += 256) sBias[d] = p.in[I_RELB][t5_bucket(d) * 8 + h];
}
DI void phase_moba_own(const Params& p, int bid, int nb, char* smem) {
  MobaLds L; L.sK = (bf16_t*)smem; L.sVT = L.sK + 64 * 136; L.sBias = (float*)(L.sVT + 128 * 72);
  const int tid = tidx(), lane = tid & 63, wave = tid >> 6;
  for (int task = bid; task < 2048; task += nb) {
    const int qt = task & 1, blk = (task >> 1) & 63, h = (task >> 7) & 7, b = task >> 10;
    __syncthreads();
    moba_bias_table(p, L.sBias, h);
    __syncthreads();
    const int tsq = blk * 256 + qt * 128 + wave * 32 + (lane & 31);
    moba_block(p, L, b, h, tsq, blk, 2 * (qt + 1), true, true);
  }
}
DI void phase_moba_past(const Params& p, int s, int bid, int nb, char* smem) {
  MobaLds L; L.sK = (bf16_t*)smem; L.sVT = L.sK + 64 * 136; L.sBias = (float*)(L.sVT + 128 * 72);
  int* sTb = (int*)(L.sBias + 1024);
  const int tid = tidx(), lane = tid & 63, wave = tid >> 6;
  const int* cnt = (const int*)(p.ws + O_CNT) + s * 1024;
  const int* lists = (const int*)(p.ws + O_LISTS) + (size_t)s * (T_ * 8);
  __syncthreads();
  if (tid < 16) { int a = 0; for (int j = 0; j < 64; ++j) { sTb[tid * 64 + j] = a; a += (cnt[tid * 64 + j] + 127) >> 7; } sTb[1040 + tid] = a; }
  __syncthreads();
  if (tid == 0) { int a = 0; for (int i = 0; i < 16; ++i) { const int c = sTb[1040 + i]; sTb[1040 + i] = a; a += c; } sTb[1056] = a; }
  __syncthreads();
  const int total = sTb[1056];
  for (int task = bid; task < total; task += nb) {
    int gi = 0;
    for (int i = 1; i < 16; ++i) if (sTb[1040 + i] <= task) gi = i;
    const int loc = task - sTb[1040 + gi];
    int j = 0;
    for (int i = 1; i < 64; ++i) if (sTb[gi * 64 + i] <= loc) j = i;
    while (j > 0 && ((cnt[gi * 64 + j] + 127) >> 7) == 0) --j;
    const int tile = loc - sTb[gi * 64 + j];
    const int b = gi >> 3, h = gi & 7;
    __syncthreads();
    moba_bias_table(p, L.sBias, h);
    __syncthreads();
    int lbase = 0;
    for (int i = 0; i < j; ++i) lbase += cnt[gi * 64 + i];
    const int n = cnt[gi * 64 + j];
    const int qi = tile * 128 + wave * 32 + (lane & 31);
    const int tsq = qi < n ? lists[(size_t)gi * S_ + lbase + qi] : -1;
    moba_block(p, L, b, h, tsq, j, 4, false, false);
  }
}

DI void phase_merge(const Params& p, int l, int bid, int nb, char* smem) {
  bf16_t* sA = (bf16_t*)smem; bf16_t* sB = sA + 128 * LDT;
  bf16_t* stash = sB + 128 * LDT;
  const int tid = tidx();
  const bf16_t* h = slab(p, 0);
  const bf16_t* wg = (const bf16_t*)(p.ws + O_WGATE); const bf16_t* pt = (const bf16_t*)(p.ws + O_PT);
  const float* bg = p.in[I_BGATE] + l * 3072;
  bf16_t* mg = slab(p, 2);
  for (int t = bid; t < 512 * 8; t += nb) {
    const int tm = t >> 3, tn = t & 7;
    f32x16 accm[1][2]; acc_zero<1>(accm);
    for (int br = 0; br < 3; ++br) {
      if ((SKIP_BR >> br) & 1) continue;
      const bf16_t* yb = slab(p, br == 0 ? 1 : (br == 1 ? 6 : 3));
      f32x16 acc[1][2]; acc_zero<1>(acc);
      gemm_core<1>(h + (size_t)tm * 64 * 1024, 1024, wg + (size_t)(br * 1024 + tn * 128) * 1024, 1024, 1024, sA, sB, acc);
      {
        const float* bgp = bg + br * 1024 + tn * 128;
        ACC_FOREACH(1, acc, { stash[((mi * 2 + ni) * 16 + i) * 256 + tid] = f2bf(sigmoidf_(v + bgp[c])); })
      }
      acc_zero<1>(acc);
      gemm_core<1>(yb + (size_t)tm * 64 * 1024, 1024, pt + (size_t)(br * 1024 + tn * 128) * 1024, 1024, 1024, sA, sB, acc);
      ACC_FOREACH(1, acc, { accm[mi][ni][i] += bf2f(stash[((mi * 2 + ni) * 16 + i) * 256 + tid]) * v; })
    }
    bf16_t* d = mg + (size_t)tm * 64 * 1024 + tn * 128;
    ACC_FOREACH(1, accm, { d[(size_t)r * 1024 + c] = f2bf(v); })
  }
}
DI void phase_wout(const Params& p, int l, int bid, int nb, char* smem) {
  bf16_t* sA = (bf16_t*)smem; bf16_t* sB = sA + 128 * LDT;
  const bf16_t* mg = slab(p, 2); const bf16_t* wo = (const bf16_t*)(p.ws + O_WOUT);
  const float* xin = l == 0 ? p.in[I_X] : p.out;
  for (int t = bid; t < 256 * 8; t += nb) {
    const int tm = t >> 3, tn = t & 7;
    f32x16 acc[2][2]; acc_zero<2>(acc);
    gemm_core<2>(mg + (size_t)tm * 128 * 1024, 1024, wo + (size_t)tn * 128 * 1024, 1024, 1024, sA, sB, acc);
    const size_t o0 = (size_t)tm * 128 * 1024 + tn * 128;
    ACC_FOREACH(2, acc, { const size_t o = o0 + (size_t)r * 1024 + c; p.out[o] = xin[o] + v; })
  }
}

DI void phase_peer_prep(const Params& p, int l, int bid, int nb) {
  rmsnorm_phase(p.out, p.in[I_N2G] + l * 1024, slab(p, 0), bid, nb);
  conv_fp8(p.in[I_U] + (size_t)l * 16777216, (unsigned char*)slab(p, 1), 16777216, 64.f, bid, nb);
  conv_fp8(p.in[I_V] + (size_t)l * 16777216, (unsigned char*)slab(p, 1) + 16777216, 16777216, 16.f, bid, nb);
}
DI void phase_peer_q(const Params& p, int bid, int nb, char* smem) {
  bf16_t* sA = (bf16_t*)smem; bf16_t* sB = sA + 128 * LDT;
  const bf16_t* h2 = slab(p, 0); const bf16_t* wq = (const bf16_t*)(p.ws + O_WQ);
  bf16_t* q = slab(p, 2);
  for (int t = bid; t < 256 * 16; t += nb) {
    const int tm = t >> 4, tn = t & 15;
    f32x16 acc[2][2]; acc_zero<2>(acc);
    gemm_core<2>(h2 + (size_t)tm * 128 * 1024, 1024, wq + (size_t)tn * 128 * 1024, 1024, 1024, sA, sB, acc);
    bf16_t* d = q + (size_t)tm * 128 * 2048 + tn * 128;
    ACC_FOREACH(2, acc, { d[(size_t)r * 2048 + c] = f2bf(v); })
  }
}
DI unsigned fkey(float f) { unsigned u = __float_as_uint(f); return (u & 0x80000000u) ? ~u : (u | 0x80000000u); }
DI void phase_peer_topk(const Params& p, int bid, int nb, char* smem, int rep) {
  bf16_t* sQ = (bf16_t*)smem;
  float* sS = (float*)smem;
  float* wsc = (float*)(smem + 66560);
  const int tid = tidx(), lane = tid & 63, wave = tid >> 6, wm = wave >> 1, wn = wave & 1, hh = lane >> 5, l31 = lane & 31;
  const bf16_t* q = slab(p, 2);
  const bf16_t* kb = (const bf16_t*)(p.ws + (wn == 0 ? O_K1 : O_K2));
  int* idx_out = (int*)slab(p, 4); float* gate_out = (float*)slab(p, 5);
  float* tv = wsc + wave * 384;
  const unsigned long long ltmask = (1ull << lane) - 1ull;
  for (int task = bid; task < 4096; task += nb) {
    const int hd = task & 7, tt = task >> 3;
    const size_t t0 = (size_t)tt * 64;
    __syncthreads();
#pragma unroll
    for (int j = 0; j < 8; ++j) {
      const int ci = tid + 256 * j, r = ci >> 5, c8 = (ci & 31) * 8;
      *(uint4*)(sQ + r * 264 + c8) = *(const uint4*)(q + (t0 + r) * 2048 + hd * 256 + c8);
    }
    __syncthreads();
    f32x16 acc[4];
#pragma unroll
    for (int ni = 0; ni < 4; ++ni)
#pragma unroll
      for (int i = 0; i < 16; ++i) acc[ni][i] = 0.f;
#pragma unroll
    for (int kk = 0; kk < 8; ++kk) {
      const bf16x8 af = *(const bf16x8*)(sQ + (wm * 32 + l31) * 264 + wn * 128 + kk * 16 + hh * 8);
#pragma unroll
      for (int ni = 0; ni < 4; ++ni) {
        const bf16x8 bf = *(const bf16x8*)(kb + (size_t)(ni * 32 + l31) * 128 + kk * 16 + hh * 8);
        acc[ni] = MFMA32(af, bf, acc[ni]);
      }
    }
    __syncthreads();
#pragma unroll
    for (int ni = 0; ni < 4; ++ni)
#pragma unroll
      for (int i = 0; i < 16; ++i) sS[(wm * 32 + crow(i, hh)) * 260 + wn * 128 + ni * 32 + l31] = acc[ni][i];
    __syncthreads();
#define WAVE_SYNC() do { __builtin_amdgcn_fence(__ATOMIC_RELEASE, "wavefront"); __builtin_amdgcn_wave_barrier(); __builtin_amdgcn_fence(__ATOMIC_ACQUIRE, "wavefront"); } while (0)
    for (int tk = 0; tk < 16; tk += 4) {
      float av[4][4]; unsigned ak[4][4]; unsigned thrA[4], thrB[4];
#pragma unroll
      for (int u = 0; u < 4; ++u) {
        const int r = wave * 16 + tk + u;
#pragma unroll
        for (int q = 0; q < 4; ++q) { av[u][q] = sS[r * 260 + q * 64 + lane]; ak[u][q] = fkey(av[u][q]); }
        thrA[u] = 0; thrB[u] = 0;
      }
      for (int bit = 31; bit >= 0; --bit) {
#pragma unroll
        for (int u = 0; u < 4; ++u) {
          const unsigned ca = thrA[u] | (1u << bit), cb = thrB[u] | (1u << bit);
          const int na = __popcll(__ballot(ak[u][0] >= ca)) + __popcll(__ballot(ak[u][1] >= ca));
          const int nb2 = __popcll(__ballot(ak[u][2] >= cb)) + __popcll(__ballot(ak[u][3] >= cb));
          thrA[u] = na >= 16 ? ca : thrA[u];
          thrB[u] = nb2 >= 16 ? cb : thrB[u];
        }
      }
#pragma unroll
      for (int u = 0; u < 4; ++u) {
        float* tvu = tv + u * 96; int* tiu = (int*)(tvu + 32);
        const unsigned long long q0 = __ballot(ak[u][0] >= thrA[u]), q1 = __ballot(ak[u][1] >= thrA[u]);
        const int p0 = __popcll(q0 & ltmask), p1 = __popcll(q0) + __popcll(q1 & ltmask);
        if (ak[u][0] >= thrA[u] && p0 < 16) { tvu[p0] = av[u][0]; tiu[p0] = lane; }
        if (ak[u][1] >= thrA[u] && p1 < 16) { tvu[p1] = av[u][1]; tiu[p1] = lane + 64; }
        const unsigned long long w0 = __ballot(ak[u][2] >= thrB[u]), w1 = __ballot(ak[u][3] >= thrB[u]);
        const int r0 = __popcll(w0 & ltmask), r1 = __popcll(w0) + __popcll(w1 & ltmask);
        if (ak[u][2] >= thrB[u] && r0 < 16) { tvu[16 + r0] = av[u][2]; tiu[16 + r0] = lane; }
        if (ak[u][3] >= thrB[u] && r1 < 16) { tvu[16 + r1] = av[u][3]; tiu[16 + r1] = lane + 64; }
      }
      WAVE_SYNC();
      float cv[4][4]; unsigned ck[4][4]; unsigned thr[4];
#pragma unroll
      for (int u = 0; u < 4; ++u) {
        const float* tvu = tv + u * 96;
#pragma unroll
        for (int q4 = 0; q4 < 4; ++q4) { const int c = lane + 64 * q4; cv[u][q4] = tvu[c >> 4] + tvu[16 + (c & 15)]; ck[u][q4] = fkey(cv[u][q4]); }
        thr[u] = 0;
      }
      for (int bit = 31; bit >= 0; --bit) {
#pragma unroll
        for (int u = 0; u < 4; ++u) {
          const unsigned cand = thr[u] | (1u << bit);
          const int c = __popcll(__ballot(ck[u][0] >= cand)) + __popcll(__ballot(ck[u][1] >= cand)) + __popcll(__ballot(ck[u][2] >= cand)) + __popcll(__ballot(ck[u][3] >= cand));
          thr[u] = c >= 16 ? cand : thr[u];
        }
      }
#pragma unroll
      for (int u = 0; u < 4; ++u) {
        float* tvu = tv + u * 96; const int* tiu = (const int*)(tvu + 32); float* fvu = tvu + 64; int* fiu = (int*)(tvu + 80);
        int basep = 0;
#pragma unroll
        for (int q4 = 0; q4 < 4; ++q4) {
          const unsigned long long bb = __ballot(ck[u][q4] >= thr[u]);
          const int pos = basep + __popcll(bb & ltmask);
          if (ck[u][q4] >= thr[u] && pos < 16) { const int c = lane + 64 * q4; fvu[pos] = cv[u][q4]; fiu[pos] = tiu[c >> 4] * 128 + tiu[16 + (c & 15)]; }
          basep += __popcll(bb);
        }
      }
      WAVE_SYNC();
      {
        const int u = lane >> 4, e16 = lane & 15;
        const float* fvu = tv + u * 96 + 64; const int* fiu = (const int*)(tv + u * 96 + 80);
        float mx = -3e38f;
#pragma unroll
        for (int e = 0; e < 16; ++e) mx = fmaxf(mx, fvu[e]);
        float sm = 0.f;
#pragma unroll
        for (int e = 0; e < 16; ++e) sm += __expf(fvu[e] - mx);
        const size_t o = ((t0 + wave * 16 + tk + u) * 8 + hd) * 16 + e16;
        idx_out[o] = fiu[e16];
        gate_out[o] = __expf(fvu[e16] - mx) / sm;
      }
      WAVE_SYNC();
    }
  }
}
DI void fp8x16_to_f32(const u32x4& v, float* f) {
#pragma unroll
  for (int j = 0; j < 4; ++j) {
    const f32x2 lo = __builtin_amdgcn_cvt_pk_f32_fp8((int)v[j], false), hi = __builtin_amdgcn_cvt_pk_f32_fp8((int)v[j], true);
    f[4 * j] = lo.x; f[4 * j + 1] = lo.y; f[4 * j + 2] = hi.x; f[4 * j + 3] = hi.y;
  }
}
DI void phase_peer_gather(const Params& p, int bid, int nb, char* smem) {
  const int tid = tidx(), lane = tid & 63, wave = tid >> 6;
  const bf16_t* h2 = slab(p, 0);
  const unsigned char* ub = (const unsigned char*)slab(p, 1); const unsigned char* vb = ub + 16777216;
  const int* idx = (const int*)slab(p, 4); const float* gate = (const float*)slab(p, 5);
  for (int t = bid * 4 + wave; t < T_; t += nb * 4) {
    float h[16];
    unpack8(*(const uint4*)(h2 + (size_t)t * 1024 + lane * 16), h);
    unpack8(*(const uint4*)(h2 + (size_t)t * 1024 + lane * 16 + 8), h + 8);
    const int ia = idx[(size_t)t * 128 + lane], ib = idx[(size_t)t * 128 + 64 + lane];
    float c_lo = 0.f, c_hi = 0.f;
#pragma unroll 1
    for (int g = 0; g < 8; ++g) {
      float part[16];
#pragma unroll
      for (int hf = 0; hf < 2; ++hf) {
        u32x4 rows[8];
#pragma unroll
        for (int j = 0; j < 8; ++j) {
          const int e = g * 16 + hf * 8 + j;
          const int id = __builtin_amdgcn_readlane(g < 4 ? ia : ib, e & 63);
          rows[j] = *(const u32x4*)(ub + (size_t)id * 1024 + lane * 16);
        }
#pragma unroll
        for (int j = 0; j < 8; ++j) {
          float f[16]; fp8x16_to_f32(rows[j], f);
          float a = 0.f;
#pragma unroll
          for (int i = 0; i < 16; ++i) a += h[i] * f[i];
          part[hf * 8 + j] = a;
        }
      }
#pragma unroll
      for (int n = 8, m = 32; n >= 1; n >>= 1, m >>= 1) {
        const bool up = (lane & m) != 0;
#pragma unroll
        for (int i = 0; i < n; ++i) {
          const float keep = up ? part[i + n] : part[i];
          const float send = up ? part[i] : part[i + n];
          part[i] = keep + __shfl_xor(send, m);
        }
      }
      float a = part[0];
      a += __shfl_xor(a, 2);
      a += __shfl_xor(a, 1);
      a *= (1.f / 64.f);
      const float ge = 0.5f * a * (1.f + erff(a * 0.7071067811865476f));
      const float cj = __shfl(ge, 4 * (lane & 15));
      const float cv = cj * gate[(size_t)t * 128 + g * 16 + (lane & 15)];
      const bool mine = (lane >> 4) == (g & 3);
      if (g < 4) c_lo = mine ? cv : c_lo; else c_hi = mine ? cv : c_hi;
    }
    float o[16];
#pragma unroll
    for (int i = 0; i < 16; ++i) o[i] = 0.f;
#pragma unroll 1
    for (int g = 0; g < 16; ++g) {
      u32x4 rows[8];
#pragma unroll
      for (int j = 0; j < 8; ++j) {
        const int e = g * 8 + j;
        const int id = __builtin_amdgcn_readlane(g < 8 ? ia : ib, e & 63);
        rows[j] = *(const u32x4*)(vb + (size_t)id * 1024 + lane * 16);
      }
#pragma unroll
      for (int j = 0; j < 8; ++j) {
        const int e = g * 8 + j;
        const float c = __builtin_bit_cast(float, __builtin_amdgcn_readlane(__builtin_bit_cast(int, g < 8 ? c_lo : c_hi), e & 63));
        float f[16]; fp8x16_to_f32(rows[j], f);
#pragma unroll
        for (int i = 0; i < 16; ++i) o[i] += c * f[i];
      }
    }
    float4* xo = (float4*)(p.out + (size_t)t * 1024 + lane * 16);
#pragma unroll
    for (int q = 0; q < 4; ++q) {
      float4 a = xo[q];
      a.x += o[4 * q] * (1.f / 16.f); a.y += o[4 * q + 1] * (1.f / 16.f); a.z += o[4 * q + 2] * (1.f / 16.f); a.w += o[4 * q + 3] * (1.f / 16.f);
      xo[q] = a;
    }
  }
}

constexpr int NPH = 26;
DI void run_phase(const Params& p, int lrep, int ph, int bid, int nb, char* smem) {
  const int l = lrep & 15, rep = lrep >> 4;
#ifdef ONLY_PH
  ph = ONLY_PH;
#endif
  switch (ph) {
    case 0: phase_prep(p, l, bid, nb, smem); break;
    case 1: {
      Route rt; rt.seg0 = 6; rt.packed = 4 | (5 << 4) | (6 << 8);
      gemm_in_phase(p, l, rt, 26, 48, 26, 0, bid, nb, smem);
    } break;
    case 2: phase_lora_prep(p, l, bid, nb); break;
    case 3: phase_lora_wa(p, l, bid, nb, smem); break;
    case 4: phase_rwkv_scan(p, l, bid, nb, smem); break;
    case 5: phase_rwkv_ln(p, l, bid, nb); break;
    case 6: phase_rwkv_g(p, l, bid, nb, smem); break;
    case 7: {
      Route rt; rt.seg0 = 0; rt.packed = 1 | (2 << 4) | (4 << 8);
      gemm_in_phase(p, l, rt, 25, 0, 24, 74, bid, nb, smem);
    } break;
    case 8: phase_ssd_conv(p, l, bid, nb); break;
    case 9: phase_ssd_states(p, l, bid, nb, smem); break;
    case 10: phase_ssd_scan(p, bid, nb); break;
    case 11: phase_ssd_out(p, l, bid, nb, smem); break;
    case 12: {
      Route rt; rt.seg0 = 3; rt.packed = 2 | (4 << 4) | (5 << 8);
      gemm_in_phase(p, l, rt, 24, 24, 24, 0, bid, nb, smem);
    } break;
    case 13: phase_moba_norm(p, l, bid, nb, smem); break;
    case 14: phase_moba_gate(p, bid, nb, smem); break;
    case 15: phase_moba_fill(p, bid, nb, smem); break;
    case 16: phase_moba_own(p, bid, nb, smem); break;
    case 17: phase_moba_past(p, 0, bid, nb, smem); break;
    case 18: phase_moba_past(p, 1, bid, nb, smem); break;
    case 19: phase_moba_past(p, 2, bid, nb, smem); break;
    case 20: phase_merge(p, l, bid, nb, smem); break;
    case 21: phase_wout(p, l, bid, nb, smem); break;
    case 22: phase_peer_prep(p, l, bid, nb); break;
    case 23: phase_peer_q(p, bid, nb, smem); break;
    case 24: phase_peer_topk(p, bid, nb, smem, rep); break;
    case 25: phase_peer_gather(p, bid, nb, smem); break;
  }
}

#if !MULTI
#define XB_TMO      128
#define XB_XCNT(j)  (256  + 64 * (j))
#define XB_XSUB(j)  (1280 + 64 * (j))
#define XB_XGEN(j)  (2304 + 64 * (j))
#define XB_TOP      3328
#define XB_TOPGEN   3392
#define XCD_BAR_WORDS 3456
#define XB_SPIN_CAP (1u << 22)
#define LAS __attribute__((address_space(3)))
DI unsigned xb_ld(unsigned* p)              { return __hip_atomic_load(p, __ATOMIC_RELAXED, __HIP_MEMORY_SCOPE_AGENT); }
DI unsigned xb_add(unsigned* p, unsigned v) { return __hip_atomic_fetch_add(p, v, __ATOMIC_RELAXED, __HIP_MEMORY_SCOPE_AGENT); }
DI unsigned xb_xcc_id() { return (unsigned)__builtin_amdgcn_s_getreg((3 << 11) | 20) & 0xFu; }
#define XB_SPIN(cond, bar) do { unsigned _sp = 0; while (cond) { __builtin_amdgcn_s_sleep(1); \
    if ((++_sp & 255u) == 0u) { if (xb_ld(&(bar)[XB_TMO])) break; if (_sp > XB_SPIN_CAP) { atomicAdd(&(bar)[XB_TMO], 1u); break; } } } } while (0)
struct XcdBarrier { unsigned* bar; unsigned x; volatile LAS unsigned* st; };
DI XcdBarrier xcd_barrier_post(unsigned* bar, volatile LAS unsigned* st) {
  XcdBarrier b; b.bar = bar; b.x = xb_xcc_id(); b.st = st;
  if (__builtin_amdgcn_workitem_id_x() == 0) (void)xb_add(&bar[XB_XCNT(b.x)], 1u);
  return b;
}
DI void xcd_barrier_complete(unsigned* bar, unsigned x, unsigned& nloc, unsigned& nx) {
  const unsigned G = gridDim.x * gridDim.y * gridDim.z;
  unsigned sum, cnt, mine, sp = 0u;
  for (;;) {
    sum = 0u; cnt = 0u; mine = 0u;
#pragma unroll
    for (unsigned j = 0; j < 16; ++j) { const unsigned c = xb_ld(&bar[XB_XCNT(j)]); sum += c; cnt += (c > 0u) ? 1u : 0u; mine = (j == x) ? c : mine; }
    if (sum == G) break;
    __builtin_amdgcn_s_sleep(1);
    if ((++sp & 255u) == 0u) { if (xb_ld(&bar[XB_TMO])) break; if (sp > XB_SPIN_CAP) { atomicAdd(&bar[XB_TMO], 1u); break; } }
  }
  nloc = mine > 0u ? mine : 1u; nx = cnt > 0u ? cnt : 1u;
}
DI void xcd_barrier(const XcdBarrier& b) {
  asm volatile("s_waitcnt vmcnt(0)" ::: "memory");
  __syncthreads();
  if (__builtin_amdgcn_workitem_id_x() == 0) {
    unsigned* bar = b.bar;
    __builtin_amdgcn_s_waitcnt(0);
    unsigned nloc = b.st[0], nx = b.st[1];
    if (nloc == 0u) { xcd_barrier_complete(bar, b.x, nloc, nx); b.st[0] = nloc; b.st[1] = nx; }
    const unsigned old = xb_add(&bar[XB_XSUB(b.x)], 1u);
    const unsigned gen = old / nloc;
    if (old + 1u == (gen + 1u) * nloc) {
      __builtin_amdgcn_fence(__ATOMIC_RELEASE, "agent");
      asm volatile("s_waitcnt vmcnt(0)" ::: "memory");
      const unsigned og = xb_add(&bar[XB_TOP], 1u);
      const unsigned tg = og / nx;
      if (og + 1u == (tg + 1u) * nx) xb_add(&bar[XB_TOPGEN], 1u);
      else XB_SPIN(xb_ld(&bar[XB_TOPGEN]) == tg, bar);
      __builtin_amdgcn_fence(__ATOMIC_ACQUIRE, "agent");
      xb_add(&bar[XB_XGEN(b.x)], 1u);
      asm volatile("s_waitcnt vmcnt(0)" ::: "memory");
    } else {
      XB_SPIN(xb_ld(&bar[XB_XGEN(b.x)]) == gen, bar);
      __builtin_amdgcn_fence(__ATOMIC_ACQUIRE, "agent");
      asm volatile("s_waitcnt vmcnt(0)" ::: "memory");
    }
  }
  __syncthreads();
}
__global__ void __launch_bounds__(256, 2) mega(Params p) {
  __shared__ __attribute__((aligned(16))) char smem[LDS_BYTES];
  __shared__ uint4 xb_words;
  cg::grid_group grid = cg::this_grid();
  if (__builtin_amdgcn_workitem_id_x() == 0) xb_words = make_uint4(0u, 0u, 0u, 0u);
  __syncthreads();
  XcdBarrier xb = xcd_barrier_post((unsigned*)(p.ws + O_BAR), (volatile LAS unsigned*)&xb_words);
  for (int it = 0; it < 2 * NPH; ++it) {
    int itv = it; asm volatile("" : "+v"(itv));
    const int its = __builtin_amdgcn_readfirstlane(itv);
    const int l = its / NPH, ph = its % NPH;
    int bv = blockIdx.x, nv = gridDim.x; asm volatile("" : "+v"(bv), "+v"(nv));
    const int nrep = ((REPMASK >> ph) & 1) ? 2 : 1;
    for (int r = 0; r < nrep; ++r) {
      run_phase(p, l + 16 * r, ph, __builtin_amdgcn_readfirstlane(bv), __builtin_amdgcn_readfirstlane(nv), smem);
      if (it == 0 && r == 0) grid.sync();
      else xcd_barrier(xb);
    }
  }
}
#else
__global__ void __launch_bounds__(256, 2) phase_kernel(Params p, int l, int ph) {
  __shared__ __attribute__((aligned(16))) char smem[LDS_BYTES];
  run_phase(p, l, ph, blockIdx.x, gridDim.x, smem);
}
#endif


#if DBG
DI int dbg_tok(int i) { return i == 0 ? 3 : (i == 1 ? 130 : (i == 2 ? 300 : 16384 + 511)); }
__global__ void __launch_bounds__(256) dbgA_kernel(Params p) {
  const int tid = tidx();
  for (size_t i = (size_t)blockIdx.x * 256 + tid; i < (size_t)T_ * 1024; i += (size_t)gridDim.x * 256) p.out[i] = p.in[I_X][i];
  if (blockIdx.x < 4) {
    const int t = dbg_tok(blockIdx.x);
    bf16_t* d = (bf16_t*)(p.ws + O_LISTS);
    for (int c = tid; c < 1024; c += 256) d[blockIdx.x * 1024 + c] = slab(p, 1)[(size_t)t * 1024 + c];
  }
}
__global__ void __launch_bounds__(256) dbgB_kernel(Params p, int l) {
  __shared__ float sred[256];
  const int tid = tidx();
  const int ti = blockIdx.x >> 2, g = blockIdx.x & 3;
  const int t = dbg_tok(ti), b = t >> 14, ts = t & (S_ - 1);
  const bf16_t* xs = slab(p, 5) + (size_t)b * S_ * 1024; const bf16_t* bc = slab(p, 6) + (size_t)b * S_ * 1024;
  const float* dt = (const float*)(p.ws + O_DT) + (size_t)b * S_ * 16;
  const bf16_t* zsave = (const bf16_t*)(p.ws + O_LISTS);
  const int ch = g * 256 + tid, head = ch >> 6;
  const float a = -__expf(p.in[I_ALOG][l * 16 + head]);
  float y = 0.f;
  for (int n = 0; n < (SSD_PROBE == 1 ? 0 : 128); ++n) {
    float h = 0.f;
    for (int s = 0; s <= ts; ++s) {
      const float d = dt[(size_t)s * 16 + head];
      h = h * __expf(d * a) + d * bf2f(bc[(size_t)s * 1024 + g * 128 + n]) * bf2f(xs[(size_t)s * 1024 + ch]);
    }
    y += bf2f(bc[(size_t)ts * 1024 + 512 + g * 128 + n]) * h;
  }
  y += p.in[I_DSKIP][l * 16 + head] * bf2f(xs[(size_t)ts * 1024 + ch]);
  y *= siluf_(bf2f(zsave[ti * 1024 + ch]));
  sred[tid] = y * y;
  __syncthreads();
  for (int o = 128; o > 0; o >>= 1) { if (tid < o) sred[tid] += sred[tid + o]; __syncthreads(); }
  const float rs = rsqrtf(sred[0] * (1.f / 256.f) + 1e-6f);
  __syncthreads();
  const float ref = DBG == 2 ? y : y * rs * p.in[I_SSDNG][l * 1024 + ch];
  const float mine = bf2f(slab(p, 1)[(size_t)t * 1024 + ch]);
  sred[tid] = fabsf(mine - ref);
  __syncthreads();
  for (int o = 128; o > 0; o >>= 1) { if (tid < o) sred[tid] = fmaxf(sred[tid], sred[tid + o]); __syncthreads(); }
  if (tid == 0) p.out[blockIdx.x] = 1000.f * sred[0] + 100.f;
}
#endif

#if DBG
__global__ void __launch_bounds__(256) dbgS_kernel(Params p, int l) {
  for (size_t i = (size_t)blockIdx.x * 256 + tidx(); i < (size_t)T_ * 1024; i += (size_t)gridDim.x * 256) {
    const int ch = (int)(i & 1023), head = ch >> 6;
    const float xv = bf2f(slab(p, 5)[i]);
    const float zv = bf2f(slab(p, 1)[i]);
    slab(p, 1)[i] = f2bf(xv * p.in[I_DSKIP][l * 16 + head] * siluf_(zv));
  }
}
#endif

extern "C" void kernel_launch(void* const* d_in, const int* in_sizes, int n_in, void* d_out, int out_size, void* d_ws, size_t ws_size,
                              hipStream_t stream) {
  Params p{};
  for (int i = 0; i < 35; ++i) p.in[i] = (const float*)d_in[i];
  p.out = (float*)d_out;
  p.ws = (char*)d_ws;
  if (ws_size < WS_END) { fprintf(stderr, "workspace too small\n"); return; }
#if MULTI
#if DBG
  for (int ph = 0; ph < 11; ++ph) hipLaunchKernelGGL(phase_kernel, dim3(512), dim3(256), 0, stream, p, 0, ph);
  hipLaunchKernelGGL(dbgA_kernel, dim3(512), dim3(256), 0, stream, p);
  hipLaunchKernelGGL(dbgS_kernel, dim3(512), dim3(256), 0, stream, p, 0);
  hipLaunchKernelGGL(dbgB_kernel, dim3(16), dim3(256), 0, stream, p, 0);
#else
  for (int l = 0; l < NLAYERS; ++l)
    for (int ph = 0; ph < (SKIP_PEER ? 22 : NPH); ++ph) hipLaunchKernelGGL(phase_kernel, dim3(512), dim3(256), 0, stream, p, l, ph);
#endif
#else
  static int grid_blocks = 0;
  if (!grid_blocks) {
    int dev = 0, cus = 0, per_cu = 0;
    (void)hipGetDevice(&dev);
    (void)hipDeviceGetAttribute(&cus, hipDeviceAttributeMultiprocessorCount, dev);
    (void)hipOccupancyMaxActiveBlocksPerMultiprocessor(&per_cu, mega, 256, 0);
    if (per_cu > 2) per_cu = 2;
    grid_blocks = cus * per_cu;
  }
  (void)hipMemsetAsync(p.ws + O_BAR, 0, 16384, stream);
  void* args[] = {&p};
  hipError_t e = hipLaunchCooperativeKernel((void*)mega, dim3(grid_blocks), dim3(256), args, 0, stream);
  if (e != hipSuccess) fprintf(stderr, "coop launch failed: %s (grid %d)\n", hipGetErrorString(e), grid_blocks);
#endif
}
```

```cpp
#include <hip/hip_runtime.h>
#include <hip/hip_cooperative_groups.h>
#include <cstdio>
#include <cstdint>
namespace cg = cooperative_groups;
#define DI __device__ __forceinline__
#ifndef MULTI
#define MULTI 0
#endif
#ifndef SKIP_BR
#define SKIP_BR 0
#endif
#ifndef SKIP_PEER
#define SKIP_PEER 0
#ifndef DBG
#define DBG 0
#endif
#ifndef SSD_PROBE
#define SSD_PROBE 0
#endif
#endif
#ifndef REPMASK
#define REPMASK 0
#endif
#ifndef NLAYERS
#define NLAYERS 2
#endif

typedef unsigned short bf16_t;
typedef __attribute__((ext_vector_type(8))) short bf16x8;
typedef __attribute__((ext_vector_type(16))) float f32x16;
typedef __attribute__((ext_vector_type(4))) float f32x4;
typedef __attribute__((ext_vector_type(4))) unsigned u32x4;
typedef __attribute__((ext_vector_type(2))) float f32x2;
#define MFMA32(a, b, c) __builtin_amdgcn_mfma_f32_32x32x16_bf16((a), (b), (c), 0, 0, 0)
#define MFMA16(a, b, c) __builtin_amdgcn_mfma_f32_16x16x32_bf16((a), (b), (c), 0, 0, 0)

constexpr int T_ = 32768, S_ = 16384;
constexpr size_t SLAB = 67108864;
constexpr int LDS_BYTES = 73728;

struct Params { const float* in[35]; float* out; char* ws; };

enum { I_X = 0, I_RELB, I_N1G, I_WIN, I_CONVW, I_CONVB, I_DTB, I_ALOG, I_DSKIP, I_SSDNG, I_QNG, I_KNG, I_MU, I_W0, I_WW2, I_A0,
       I_WA2, I_WG2, I_KK, I_KA, I_RK, I_LNG, I_LNB, I_PSSD, I_PMOBA, I_PRWKV, I_WGATE, I_BGATE, I_WOUT, I_N2G, I_WQ, I_K1, I_K2, I_U, I_V };

constexpr size_t OFF_W = 7 * SLAB;
constexpr size_t O_WIN = OFF_W;
constexpr size_t O_WGATE = O_WIN + 19660800;
constexpr size_t O_PT = O_WGATE + 6291456;
constexpr size_t O_WOUT = O_PT + 6291456;
constexpr size_t O_WQ = O_WOUT + 2097152;
constexpr size_t O_WW2 = O_WQ + 4194304;
constexpr size_t O_WA2 = O_WW2 + 131072;
constexpr size_t O_WG2 = O_WA2 + 131072;
constexpr size_t O_K1 = O_WG2 + 262144;
constexpr size_t O_K2 = O_K1 + 32768;
constexpr size_t OFF_X = O_K2 + 32768;
constexpr size_t O_DT = OFF_X;
constexpr size_t O_LACT = O_DT + 2097152;
constexpr size_t O_RB = O_LACT + 16777216;
constexpr size_t O_CDEC = O_RB + 2097152;
constexpr size_t O_KMEAN = O_CDEC + 16384;
constexpr size_t O_MM = O_KMEAN + 524288;
constexpr size_t O_ML = O_MM + 1048576;
constexpr size_t O_SEL = O_ML + 1048576;
constexpr size_t O_CNT = O_SEL + 3145728;
constexpr size_t O_FILL = O_CNT + 12288;
constexpr size_t O_LISTS = O_FILL + 12288;
constexpr size_t O_BAR = O_LISTS + 3145728;
constexpr size_t WS_END = O_BAR + 16384;

DI bf16_t* slab(const Params& p, int i) { return (bf16_t*)(p.ws + (size_t)i * SLAB); }

DI bf16_t f2bf(float x) { unsigned u = __float_as_uint(x); u += 0x7fffu + ((u >> 16) & 1u); return (bf16_t)(u >> 16); }
DI float bf2f(bf16_t b) { return __uint_as_float(((unsigned)b) << 16); }
DI unsigned pack2(float a, float b) { return (unsigned)f2bf(a) | ((unsigned)f2bf(b) << 16); }
DI float lo16(unsigned u) { return __uint_as_float(u << 16); }
DI float hi16(unsigned u) { return __uint_as_float(u & 0xffff0000u); }
DI bf16_t get16(const uint4& v, int e) { const unsigned w = (e >> 1) == 0 ? v.x : ((e >> 1) == 1 ? v.y : ((e >> 1) == 2 ? v.z : v.w)); return (bf16_t)((e & 1) ? (w >> 16) : (w & 0xffffu)); }
DI void unpack8(const uint4& v, float* f) {
  f[0] = lo16(v.x); f[1] = hi16(v.x); f[2] = lo16(v.y); f[3] = hi16(v.y);
  f[4] = lo16(v.z); f[5] = hi16(v.z); f[6] = lo16(v.w); f[7] = hi16(v.w);
}
DI uint4 pack8(const float* f) { uint4 v; v.x = pack2(f[0], f[1]); v.y = pack2(f[2], f[3]); v.z = pack2(f[4], f[5]); v.w = pack2(f[6], f[7]); return v; }
DI float sigmoidf_(float x) { return 1.f / (1.f + __expf(-x)); }
DI float softplusf_(float x) { return fmaxf(x, 0.f) + log1pf(__expf(-fabsf(x))); }
DI float siluf_(float x) { return x / (1.f + __expf(-x)); }
DI float wave_sum(float v) { for (int o = 32; o > 0; o >>= 1) v += __shfl_xor(v, o); return v; }
template <int CTRL> DI float dpp_add(float x) {
  int y = __builtin_amdgcn_update_dpp(0, __float_as_int(x), CTRL, 0xf, 0xf, true);
  return x + __int_as_float(y);
}
DI float red8(float x) { x = dpp_add<0xB1>(x); x = dpp_add<0x4E>(x); x = dpp_add<0x141>(x); return x; }
DI float red16(float x) { x = red8(x); x = dpp_add<0x140>(x); return x; }
DI int tidx() { int t = __builtin_amdgcn_workitem_id_x(); asm volatile("" : "+v"(t)); return t; }
DI int crow(int i, int h) { return (i & 3) + 8 * (i >> 2) + 4 * h; }

constexpr int LDT = 72;
template <int MI>
DI void gemm_core(const bf16_t* __restrict__ A, int lda, const bf16_t* __restrict__ Bt, int ldb, int K,
                  bf16_t* sA, bf16_t* sB, f32x16 (&acc)[MI][2]) {
  const int tid = tidx(), lane = tid & 63, wave = tid >> 6, wm = wave >> 1, wn = wave & 1;
  u32x4 ra[2 * MI], rb[4];
#pragma unroll
  for (int j = 0; j < 2 * MI; ++j) { const int c = tid + 256 * j; ra[j] = *(const u32x4*)(A + (size_t)(c >> 3) * lda + (c & 7) * 8); }
#pragma unroll
  for (int j = 0; j < 4; ++j) { const int c = tid + 256 * j; rb[j] = *(const u32x4*)(Bt + (size_t)(c >> 3) * ldb + (c & 7) * 8); }
  for (int k0 = 0; k0 < K; k0 += 64) {
#pragma unroll
    for (int j = 0; j < 2 * MI; ++j) { const int c = tid + 256 * j; *(u32x4*)(sA + (c >> 3) * LDT + (c & 7) * 8) = ra[j]; }
#pragma unroll
    for (int j = 0; j < 4; ++j) { const int c = tid + 256 * j; *(u32x4*)(sB + (c >> 3) * LDT + (c & 7) * 8) = rb[j]; }
    __syncthreads();
    const int kn = (k0 + 64 < K) ? k0 + 64 : k0;
#pragma unroll
    for (int j = 0; j < 2 * MI; ++j) { const int c = tid + 256 * j; ra[j] = *(const u32x4*)(A + (size_t)(c >> 3) * lda + kn + (c & 7) * 8); }
#pragma unroll
    for (int j = 0; j < 4; ++j) { const int c = tid + 256 * j; rb[j] = *(const u32x4*)(Bt + (size_t)(c >> 3) * ldb + kn + (c & 7) * 8); }
#pragma unroll
    for (int kk = 0; kk < 4; ++kk) {
      bf16x8 af[MI], bfr[2];
#pragma unroll
      for (int mi = 0; mi < MI; ++mi) af[mi] = *(const bf16x8*)(sA + (wm * 32 * MI + mi * 32 + (lane & 31)) * LDT + kk * 16 + (lane >> 5) * 8);
#pragma unroll
      for (int ni = 0; ni < 2; ++ni) bfr[ni] = *(const bf16x8*)(sB + (wn * 64 + ni * 32 + (lane & 31)) * LDT + kk * 16 + (lane >> 5) * 8);
#pragma unroll
      for (int mi = 0; mi < MI; ++mi)
#pragma unroll
        for (int ni = 0; ni < 2; ++ni) acc[mi][ni] = MFMA32(af[mi], bfr[ni], acc[mi][ni]);
    }
    __syncthreads();
  }
}
template <int MI> DI void acc_zero(f32x16 (&acc)[MI][2]) {
#pragma unroll
  for (int mi = 0; mi < MI; ++mi)
#pragma unroll
    for (int ni = 0; ni < 2; ++ni)
#pragma unroll
      for (int i = 0; i < 16; ++i) acc[mi][ni][i] = 0.f;
}
DI void tile_remap(int t, int ntm, int nt, int& tm, int& tn) {
  const int x = t & 7, q = t >> 3, per = ntm >> 3;
  const int grp = q / (8 * nt), rem = q - grp * 8 * nt;
  tn = rem >> 3;
  tm = x * per + grp * 8 + (rem & 7);
}
#define ACC_FOREACH(MI, acc, BODY)                                                        \
  {                                                                                       \
    int lane_ = tidx() & 63; asm volatile("" : "+v"(lane_));                        \
    const int wave_ = tidx() >> 6, wm_ = wave_ >> 1, wn_ = wave_ & 1;                \
    _Pragma("unroll") for (int mi = 0; mi < MI; ++mi)                                     \
    _Pragma("unroll") for (int ni = 0; ni < 2; ++ni)                                      \
    _Pragma("unroll") for (int i = 0; i < 16; ++i) {                                      \
      const int r = wm_ * 32 * MI + mi * 32 + crow(i, lane_ >> 5);                        \
      const int c = wn_ * 64 + ni * 32 + (lane_ & 31);                                    \
      const float v = acc[mi][ni][i];                                                       \
      BODY                                                                                \
    }                                                                                     \
  }

DI void tconv_job(const float* __restrict__ src, int ld, int K, int c0, int ncols, bf16_t* __restrict__ dst, int bid, int nb, float* sT) {
  const int ntn = (ncols + 63) >> 6, ntk = K >> 6, tid = tidx();
  for (int t = bid; t < ntn * ntk; t += nb) {
    const int tk = t % ntk, tn = t / ntk;
    const int kr = tid >> 4, nx = (tid & 15) * 4;
#pragma unroll
    for (int j = 0; j < 4; ++j) {
      const int k = kr + 16 * j;
      const float* s = src + (size_t)(tk * 64 + k) * ld + c0 + tn * 64 + nx;
      float4 v;
      if (tn * 64 + nx + 3 < ncols) v = *(const float4*)s;
      else { v.x = (tn * 64 + nx < ncols) ? s[0] : 0.f; v.y = (tn * 64 + nx + 1 < ncols) ? s[1] : 0.f; v.z = (tn * 64 + nx + 2 < ncols) ? s[2] : 0.f; v.w = 0.f; }
      sT[k * 65 + nx] = v.x; sT[k * 65 + nx + 1] = v.y; sT[k * 65 + nx + 2] = v.z; sT[k * 65 + nx + 3] = v.w;
    }
    __syncthreads();
    const int n = tid >> 2, kq = tid & 3;
    if (tn * 64 + n < ncols) {
      float f[16];
#pragma unroll
      for (int j = 0; j < 16; ++j) f[j] = sT[(kq * 16 + j) * 65 + n];
      uint4* d = (uint4*)(dst + (size_t)(tn * 64 + n) * K + tk * 64 + kq * 16);
      d[0] = pack8(f); d[1] = pack8(f + 8);
    }
    __syncthreads();
  }
}
DI void conv_plain(const float* __restrict__ src, bf16_t* __restrict__ dst, size_t n, int bid, int nb) {
  size_t i = ((size_t)bid * 256 + tidx()), st = (size_t)nb * 256;
  for (; i < n / 8; i += st) {
    float4 a = ((const float4*)src)[2 * i], b = ((const float4*)src)[2 * i + 1];
    uint4 o; o.x = pack2(a.x, a.y); o.y = pack2(a.z, a.w); o.z = pack2(b.x, b.y); o.w = pack2(b.z, b.w);
    ((uint4*)dst)[i] = o;
  }
}
DI void conv_fp8(const float* __restrict__ src, unsigned char* __restrict__ dst, size_t n, float scale, int bid, int nb) {
  size_t i = ((size_t)bid * 256 + tidx()), st = (size_t)nb * 256;
  for (; i < n / 16; i += st) {
    const float4* sp = (const float4*)src + 4 * i;
    u32x4 o;
#pragma unroll
    for (int j = 0; j < 4; ++j) {
      const float4 a = sp[j];
      int w = 0;
      w = __builtin_amdgcn_cvt_pk_fp8_f32(a.x * scale, a.y * scale, w, false);
      w = __builtin_amdgcn_cvt_pk_fp8_f32(a.z * scale, a.w * scale, w, true);
      o[j] = (unsigned)w;
    }
    ((u32x4*)dst)[i] = o;
  }
}
DI void rmsnorm_phase(const float* __restrict__ x, const float* __restrict__ g, bf16_t* __restrict__ h, int bid, int nb) {
  const int wave = tidx() >> 6, lane = tidx() & 63;
  for (int row = bid * 4 + wave; row < T_; row += nb * 4) {
    const float4* xr = (const float4*)(x + (size_t)row * 1024);
    float4 v[4]; float ss = 0.f;
#pragma unroll
    for (int j = 0; j < 4; ++j) { v[j] = xr[lane + 64 * j]; ss += v[j].x * v[j].x + v[j].y * v[j].y + v[j].z * v[j].z + v[j].w * v[j].w; }
    ss = wave_sum(ss);
    const float r = rsqrtf(ss * (1.f / 1024.f) + 1e-6f);
#pragma unroll
    for (int j = 0; j < 4; ++j) {
      float4 g4 = ((const float4*)g)[lane + 64 * j];
      uint2 o; o.x = pack2(v[j].x * r * g4.x, v[j].y * r * g4.y); o.y = pack2(v[j].z * r * g4.z, v[j].w * r * g4.w);
      ((uint2*)(h + (size_t)row * 1024))[lane + 64 * j] = o;
    }
  }
}
DI void phase_prep(const Params& p, int l, int bid, int nb, char* smem) {
  float* sT = (float*)smem;
  char* ws = p.ws;
  const float* win = p.in[I_WIN] + (size_t)l * 1024 * 9488;
  bf16_t* wt_in = (bf16_t*)(ws + O_WIN);
  tconv_job(win, 9488, 1024, 0, 3072, wt_in, bid, nb, sT);
  tconv_job(win, 9488, 1024, 3088, 6400, wt_in + (size_t)3072 * 1024, bid, nb, sT);
  tconv_job(win, 9488, 1024, 3072, 16, wt_in + (size_t)9472 * 1024, bid, nb, sT);
  {
    uint4 z = {0, 0, 0, 0};
    uint4* d = (uint4*)(wt_in + (size_t)9488 * 1024);
    for (int i = bid * 256 + tidx(); i < 112 * 1024 / 8; i += nb * 256) d[i] = z;
  }
  tconv_job(p.in[I_WGATE] + (size_t)l * 1024 * 3072, 3072, 1024, 0, 3072, (bf16_t*)(ws + O_WGATE), bid, nb, sT);
  tconv_job(p.in[I_PSSD] + (size_t)l * 1048576, 1024, 1024, 0, 1024, (bf16_t*)(ws + O_PT), bid, nb, sT);
  tconv_job(p.in[I_PMOBA] + (size_t)l * 1048576, 1024, 1024, 0, 1024, (bf16_t*)(ws + O_PT) + 1048576, bid, nb, sT);
  tconv_job(p.in[I_PRWKV] + (size_t)l * 1048576, 1024, 1024, 0, 1024, (bf16_t*)(ws + O_PT) + 2 * 1048576, bid, nb, sT);
  tconv_job(p.in[I_WOUT] + (size_t)l * 1048576, 1024, 1024, 0, 1024, (bf16_t*)(ws + O_WOUT), bid, nb, sT);
  tconv_job(p.in[I_WQ] + (size_t)l * 1024 * 2048, 2048, 1024, 0, 2048, (bf16_t*)(ws + O_WQ), bid, nb, sT);
  tconv_job(p.in[I_WW2] + (size_t)l * 64 * 1024, 1024, 64, 0, 1024, (bf16_t*)(ws + O_WW2), bid, nb, sT);
  tconv_job(p.in[I_WA2] + (size_t)l * 64 * 1024, 1024, 64, 0, 1024, (bf16_t*)(ws + O_WA2), bid, nb, sT);
  tconv_job(p.in[I_WG2] + (size_t)l * 128 * 1024, 1024, 128, 0, 1024, (bf16_t*)(ws + O_WG2), bid, nb, sT);
  conv_plain(p.in[I_K1] + (size_t)l * 16384, (bf16_t*)(ws + O_K1), 16384, bid, nb);
  conv_plain(p.in[I_K2] + (size_t)l * 16384, (bf16_t*)(ws + O_K2), 16384, bid, nb);
  { int* cz = (int*)(ws + O_CNT); for (int i = bid * 256 + tidx(); i < 2 * 3072; i += nb * 256) cz[i] = 0; }
  const float* xin = l == 0 ? p.in[I_X] : p.out;
  rmsnorm_phase(xin, p.in[I_N1G] + l * 1024, slab(p, 0), bid, nb);
}

struct Route { int packed; int seg0; };
DI void gemm_in_phase(const Params& p, int l, const Route rt, int nt, int t0a, int t0b_from, int t0b, int bid, int nb, char* smem) {
  bf16_t* sA = (bf16_t*)smem; bf16_t* sB = sA + 128 * LDT;
  const bf16_t* h = slab(p, 0);
  const bf16_t* wt = (const bf16_t*)(p.ws + O_WIN);
  bf16_t* lora = slab(p, 3); float* dtp = (float*)(p.ws + O_DT); const float* dtb = p.in[I_DTB] + l * 16;
  for (int t = bid; t < 256 * nt; t += nb) {
    int tm, tl; tile_remap(t, 256, nt, tm, tl);
    const int tn = tl < t0b_from ? t0a + tl : t0b + (tl - t0b_from);
    f32x16 acc[2][2]; acc_zero<2>(acc);
    gemm_core<2>(h + (size_t)tm * 128 * 1024, 1024, wt + (size_t)tn * 128 * 1024, 1024, 1024, sA, sB, acc);
    const int row0 = tm * 128, col0 = tn * 128, seg = col0 >> 10;
    if (seg < 9) {
      bf16_t* d = slab(p, (rt.packed >> (4 * (seg - rt.seg0))) & 15) + (size_t)row0 * 1024 + (col0 & 1023);
      ACC_FOREACH(2, acc, { d[(size_t)r * 1024 + c] = f2bf(v); })
    } else {
      const int cc0 = col0 - 9216;
      ACC_FOREACH(2, acc, {
        const int cc = cc0 + c;
        if (cc < 256) lora[(size_t)(row0 + r) * 256 + cc] = f2bf(v);
        else if (cc < 272) dtp[(size_t)(row0 + r) * 16 + (cc - 256)] = softplusf_(v + dtb[cc - 256]);
      })
    }
  }
}

DI void phase_lora_prep(const Params& p, int l, int bid, int nb) {
  const bf16_t* raw = slab(p, 3);
  bf16_t* act = (bf16_t*)(p.ws + O_LACT);
  const float* mu = p.in[I_MU] + l * 3328 + 3072;
  for (int it = bid * 256 + tidx(); it < T_ * 32; it += nb * 256) {
    const int t = it >> 5, c8 = (it & 31) * 8;
    uint4 cur = *(const uint4*)(raw + (size_t)t * 256 + c8);
    uint4 prv = {0, 0, 0, 0};
    if (t & (S_ - 1)) prv = *(const uint4*)(raw + (size_t)(t - 1) * 256 + c8);
    float x[8], xp[8], o[8];
    unpack8(cur, x); unpack8(prv, xp);
#pragma unroll
    for (int e = 0; e < 8; ++e) {
      const int j = c8 + e;
      const float xs = x[e] + (xp[e] - x[e]) * mu[j];
      o[e] = j < 64 ? tanhf(xs) : (j < 128 ? xs : sigmoidf_(xs));
    }
    *(uint4*)(act + (size_t)t * 256 + c8) = pack8(o);
  }
}
template <class F>
DI void gemm_lora_phase(const Params& p, int aoff, int K, const bf16_t* wt, int bid, int nb, char* smem, F epi) {
  bf16_t* sA = (bf16_t*)smem; bf16_t* sB = sA + 128 * LDT;
  const bf16_t* A = (const bf16_t*)(p.ws + O_LACT) + aoff;
  for (int t = bid; t < 256 * 8; t += nb) {
    const int tm = t >> 3, tn = t & 7;
    f32x16 acc[2][2]; acc_zero<2>(acc);
    gemm_core<2>(A + (size_t)tm * 128 * 256, 256, wt + (size_t)tn * 128 * K, K, K, sA, sB, acc);
    const int row0 = tm * 128, col0 = tn * 128;
    ACC_FOREACH(2, acc, { epi(row0 + r, col0 + c, v); })
  }
}
DI void phase_lora_wa(const Params& p, int l, int bid, int nb, char* smem) {
  const float* w0 = p.in[I_W0] + l * 1024; const float* a0 = p.in[I_A0] + l * 1024;
  bf16_t* ew = slab(p, 1); bf16_t* av = slab(p, 2);
  gemm_lora_phase(p, 0, 64, (const bf16_t*)(p.ws + O_WW2), bid, nb, smem, [&](int r, int c, float v) {
    const float wpre = w0[c] + v;
    const float w = -softplusf_(-wpre) - 0.5f;
    ew[(size_t)r * 1024 + c] = f2bf(__expf(w));
  });
  gemm_lora_phase(p, 64, 64, (const bf16_t*)(p.ws + O_WA2), bid, nb, smem, [&](int r, int c, float v) {
    av[(size_t)r * 1024 + c] = f2bf(sigmoidf_(a0[c] + v));
  });
}
DI void phase_rwkv_scan(const Params& p, int l, int bid, int nb, char* smem) {
  float* fbase = (float*)smem;
  constexpr int BUF = 5376;
  const int tid = tidx(), lane = tid & 63, wave = tid >> 6;
  const bf16_t* R = slab(p, 4); const bf16_t* Kx = slab(p, 5); const bf16_t* V = slab(p, 6);
  const bf16_t* EW = slab(p, 1); const bf16_t* AV = slab(p, 2);
  bf16_t* Y = slab(p, 3);
  float* rbout = (float*)(p.ws + O_RB);
  for (int task = bid; task < 256; task += nb) {
    const int qd = task & 7, head = (task >> 3) & 15, b = task >> 7;
    __syncthreads();
    if (wave >= 2) {
      const int st = (tid & 127) >> 3, c8 = tid & 7, ch0 = head * 64 + c8 * 8;
      float mur[8], muk[8], muv[8], ckk[8], cka[8], crk[8];
#pragma unroll
      for (int e = 0; e < 8; ++e) {
        mur[e] = p.in[I_MU][l * 3328 + ch0 + e]; muk[e] = p.in[I_MU][l * 3328 + 1024 + ch0 + e]; muv[e] = p.in[I_MU][l * 3328 + 2048 + ch0 + e];
        ckk[e] = p.in[I_KK][l * 1024 + ch0 + e]; cka[e] = p.in[I_KA][l * 1024 + ch0 + e]; crk[e] = p.in[I_RK][l * 1024 + ch0 + e];
      }
      uint4 gr, gk, gv, gw, ga, gpr, gpk, gpv;
      auto gload = [&](int c) {
        const int ts = c * 16 + st;
        const size_t o = ((size_t)b * S_ + ts) * 1024 + ch0;
        gr = *(const uint4*)(R + o); gk = *(const uint4*)(Kx + o); gv = *(const uint4*)(V + o);
        gw = *(const uint4*)(EW + o); ga = *(const uint4*)(AV + o);
        if (ts > 0) { gpr = *(const uint4*)(R + o - 1024); gpk = *(const uint4*)(Kx + o - 1024); gpv = *(const uint4*)(V + o - 1024); }
        else { gpr = make_uint4(0, 0, 0, 0); gpk = gpr; gpv = gpr; }
      };
      auto stage = [&](int c) {
        float* bufp = fbase + (c & 1) * BUF;
        float* sa = bufp; float* sw = sa + 1024; float* sb = sw + 1024; float* sk = sb + 1024; float* sr = sk + 1024; float* sv = sr + 1024;
        float r[8], k[8], v[8], w[8], a[8], pr[8], pk[8], pv[8];
        unpack8(gr, r); unpack8(gk, k); unpack8(gv, v); unpack8(gw, w); unpack8(ga, a); unpack8(gpr, pr); unpack8(gpk, pk); unpack8(gpv, pv);
        float kk[8], ss = 0.f, rbs = 0.f;
#pragma unroll
        for (int e = 0; e < 8; ++e) {
          r[e] = r[e] + (pr[e] - r[e]) * mur[e];
          k[e] = k[e] + (pk[e] - k[e]) * muk[e];
          v[e] = v[e] + (pv[e] - v[e]) * muv[e];
          kk[e] = k[e] * ckk[e]; ss += kk[e] * kk[e];
        }
        ss = red8(ss);
        const float inv = rsqrtf(fmaxf(ss, 1e-12f));
        float oa[8], ow[8], ob[8], ok[8];
#pragma unroll
        for (int e = 0; e < 8; ++e) {
          kk[e] *= inv;
          ok[e] = k[e] * (1.f + (a[e] - 1.f) * cka[e]);
          oa[e] = -kk[e]; ob[e] = kk[e] * a[e]; ow[e] = __expf(-w[e]);
          rbs += r[e] * ok[e] * crk[e];
        }
        rbs = red8(rbs);
        float* d;
        d = sa + st * 64 + c8 * 8; *(float4*)d = make_float4(oa[0], oa[1], oa[2], oa[3]); *(float4*)(d + 4) = make_float4(oa[4], oa[5], oa[6], oa[7]);
        d = sw + st * 64 + c8 * 8; *(float4*)d = make_float4(ow[0], ow[1], ow[2], ow[3]); *(float4*)(d + 4) = make_float4(ow[4], ow[5], ow[6], ow[7]);
        d = sb + st * 64 + c8 * 8; *(float4*)d = make_float4(ob[0], ob[1], ob[2], ob[3]); *(float4*)(d + 4) = make_float4(ob[4], ob[5], ob[6], ob[7]);
        d = sk + st * 64 + c8 * 8; *(float4*)d = make_float4(ok[0], ok[1], ok[2], ok[3]); *(float4*)(d + 4) = make_float4(ok[4], ok[5], ok[6], ok[7]);
        d = sr + st * 64 + c8 * 8; *(float4*)d = make_float4(r[0], r[1], r[2], r[3]); *(float4*)(d + 4) = make_float4(r[4], r[5], r[6], r[7]);
        if (c8 == qd) { d = sv + st * 8; *(float4*)d = make_float4(v[0], v[1], v[2], v[3]); *(float4*)(d + 4) = make_float4(v[4], v[5], v[6], v[7]); }
        if (qd == 0 && c8 == 0) rbout[((size_t)b * S_ + c * 16 + st) * 16 + head] = rbs;
      };
      auto ywrite = [&](int c) {
        const int j = tid & 127;
        if (j < 16) {
          const float* sy = fbase + (c & 1) * BUF + 5248;
          float f[8];
#pragma unroll
          for (int e = 0; e < 8; ++e) f[e] = sy[j * 8 + e];
          *(uint4*)(Y + ((size_t)b * S_ + c * 16 + j) * 1024 + head * 64 + qd * 8) = pack8(f);
        }
      };
      gload(0);
      stage(0);
      gload(1);
      __syncthreads();
      for (int c = 0; c < 1024; ++c) {
        if (c + 1 < 1024) stage(c + 1);
        if (c + 2 < 1024) gload(c + 2);
        if (c > 0) ywrite(c - 1);
        __syncthreads();
      }
      ywrite(1023);
    } else {
      const int rowl = wave * 4 + (lane >> 4), pp = lane & 15;
      f32x2 st01 = {0.f, 0.f}, st23 = {0.f, 0.f};
      __syncthreads();
      for (int c = 0; c < 1024; ++c) {
        const float* bufp = fbase + (c & 1) * BUF;
        const float* sa = bufp; const float* sw = sa + 1024; const float* sb = sw + 1024; const float* sk = sb + 1024; const float* sr = sk + 1024;
        const float* sv = sr + 1024; float* sy = (float*)sv + 128;
        float yk0 = 0.f;
        f32x4 a4 = *(const f32x4*)(sa + 4 * pp), w4 = *(const f32x4*)(sw + 4 * pp), b4 = *(const f32x4*)(sb + 4 * pp);
        f32x4 k4 = *(const f32x4*)(sk + 4 * pp), r4 = *(const f32x4*)(sr + 4 * pp);
        float vv = sv[rowl];
#pragma unroll
        for (int s = 0; s < 16; ++s) {
          f32x4 a4n = a4, w4n = w4, b4n = b4, k4n = k4, r4n = r4; float vvn = vv;
          if (s + 1 < 16) {
            a4n = *(const f32x4*)(sa + (s + 1) * 64 + 4 * pp); w4n = *(const f32x4*)(sw + (s + 1) * 64 + 4 * pp);
            b4n = *(const f32x4*)(sb + (s + 1) * 64 + 4 * pp); k4n = *(const f32x4*)(sk + (s + 1) * 64 + 4 * pp);
            r4n = *(const f32x4*)(sr + (s + 1) * 64 + 4 * pp); vvn = sv[(s + 1) * 8 + rowl];
          }
          f32x2 t = st01 * a4.xy + st23 * a4.zw;
          const float d = red16(t.x + t.y);
          st01 = st01 * w4.xy + b4.xy * d + k4.xy * vv;
          st23 = st23 * w4.zw + b4.zw * d + k4.zw * vv;
          f32x2 u = st01 * r4.xy + st23 * r4.zw;
          const float y = red16(u.x + u.y);
          yk0 = (pp == s) ? y : yk0;
          a4 = a4n; w4 = w4n; b4 = b4n; k4 = k4n; r4 = r4n; vv = vvn;
        }
        sy[pp * 8 + rowl] = yk0;
        __syncthreads();
      }
    }
  }
}
DI void phase_rwkv_ln(const Params& p, int l, int bid, int nb) {
  bf16_t* Y = slab(p, 3); const bf16_t* V = slab(p, 6);
  const float* rb = (const float*)(p.ws + O_RB);
  const float* lng = p.in[I_LNG] + l * 1024; const float* lnb = p.in[I_LNB] + l * 1024; const float* muv = p.in[I_MU] + l * 3328 + 2048;
  for (int it = bid * 256 + tidx(); it < T_ * 128; it += nb * 256) {
    const int t = it >> 7, c8 = (it & 127) * 8, head = c8 >> 6;
    float y[8], v[8], pv[8], o[8];
    unpack8(*(const uint4*)(Y + (size_t)t * 1024 + c8), y);
    unpack8(*(const uint4*)(V + (size_t)t * 1024 + c8), v);
    uint4 pz = {0, 0, 0, 0};
    if (t & (S_ - 1)) pz = *(const uint4*)(V + (size_t)(t - 1) * 1024 + c8);
    unpack8(pz, pv);
    float s = 0.f;
#pragma unroll
    for (int e = 0; e < 8; ++e) s += y[e];
    s = red8(s);
    const float mean = s * (1.f / 64.f);
    float q = 0.f;
#pragma unroll
    for (int e = 0; e < 8; ++e) { const float d = y[e] - mean; q += d * d; }
    q = red8(q);
    const float rstd = rsqrtf(q * (1.f / 64.f) + 64e-5f);
    const float rbv = rb[(size_t)t * 16 + head];
#pragma unroll
    for (int e = 0; e < 8; ++e) {
      const float vs = v[e] + (pv[e] - v[e]) * muv[c8 + e];
      o[e] = (y[e] - mean) * rstd * lng[c8 + e] + lnb[c8 + e] + rbv * vs;
    }
    *(uint4*)(Y + (size_t)t * 1024 + c8) = pack8(o);
  }
}
DI void phase_rwkv_g(const Params& p, int l, int bid, int nb, char* smem) {
  bf16_t* Y = slab(p, 3);
  gemm_lora_phase(p, 128, 128, (const bf16_t*)(p.ws + O_WG2), bid, nb, smem, [&](int r, int c, float v) {
    const size_t o = (size_t)r * 1024 + c;
    Y[o] = f2bf(bf2f(Y[o]) * v);
  });
}

DI void phase_ssd_conv(const Params& p, int l, int bid, int nb) {
  const bf16_t* rx = slab(p, 2); const bf16_t* rbc = slab(p, 4);
  bf16_t* xs = slab(p, 5); bf16_t* bc = slab(p, 6);
  const float* cw = p.in[I_CONVW] + l * 4 * 2048; const float* cb = p.in[I_CONVB] + l * 2048;
  for (int it = bid * 256 + tidx(); it < T_ * 256; it += nb * 256) {
    const int t = it >> 8, c8 = (it & 255) * 8;
    const bf16_t* src = c8 < 1024 ? rx : rbc; bf16_t* dst = c8 < 1024 ? xs : bc;
    const int cc = c8 & 1023, ts = t & (S_ - 1);
    float acc[8];
#pragma unroll
    for (int e = 0; e < 8; ++e) acc[e] = cb[c8 + e];
#pragma unroll
    for (int k = 0; k < 4; ++k) {
      if (ts - 3 + k >= 0) {
        float x[8]; unpack8(*(const uint4*)(src + (size_t)(t - 3 + k) * 1024 + cc), x);
#pragma unroll
        for (int e = 0; e < 8; ++e) acc[e] += x[e] * cw[k * 2048 + c8 + e];
      }
    }
#pragma unroll
    for (int e = 0; e < 8; ++e) acc[e] = siluf_(acc[e]);
    *(uint4*)(dst + (size_t)t * 1024 + cc) = pack8(acc);
  }
}
DI float* scan128(float* a, float* b) {
  const int tid = tidx();
  float* src = a; float* dst = b;
  for (int off = 1; off < 128; off <<= 1) {
    if (tid < 128) dst[tid] = src[tid] + (tid >= off ? src[tid - off] : 0.f);
    __syncthreads();
    float* t = src; src = dst; dst = t;
  }
  return src;
}
DI void phase_ssd_states(const Params& p, int l, int bid, int nb, char* smem) {
  bf16_t* sXT = (bf16_t*)smem;
  bf16_t* sBT = sXT + 64 * 136;
  float* fa = (float*)(sBT + 128 * 136);
  float* fb = fa + 128; float* fdt = fb + 128;
  const int tid = tidx(), lane = tid & 63, wave = tid >> 6;
  const bf16_t* xs = slab(p, 5); const bf16_t* bc = slab(p, 6);
  const float* dt = (const float*)(p.ws + O_DT);
  float* cdec = (float*)(p.ws + O_CDEC);
  for (int task = bid; task < 4096; task += nb) {
    const int head = task & 15, c = (task >> 4) & 127, b = task >> 11, g = head >> 2;
    const size_t t0 = (size_t)b * S_ + c * 128;
    const float aneg = -__expf(p.in[I_ALOG][l * 16 + head]);
    __syncthreads();
    if (tid < 128) { const float d = dt[(t0 + tid) * 16 + head]; fdt[tid] = d; fa[tid] = d * aneg; }
    __syncthreads();
    float* acs = scan128(fa, fb);
    const float alast = acs[127];
    if (tid == 0) cdec[(b * 128 + c) * 16 + head] = __expf(alast);
#pragma unroll
    for (int j = 0; j < 4; ++j) {
      const int ci = tid + 256 * j, lr = ci >> 3, p8 = (ci & 7) * 8;
      float x[8]; unpack8(*(const uint4*)(xs + (t0 + lr) * 1024 + head * 64 + p8), x);
      const float sc = fdt[lr] * __expf(alast - acs[lr]);
#pragma unroll
      for (int e = 0; e < 8; ++e) sXT[(p8 + e) * 136 + lr] = f2bf(x[e] * sc);
    }
#pragma unroll
    for (int j = 0; j < 8; ++j) {
      const int ci = tid + 256 * j, lr = ci >> 4, n8 = (ci & 15) * 8;
      const uint4 u = *(const uint4*)(bc + (t0 + lr) * 1024 + g * 128 + n8);
#pragma unroll
      for (int e = 0; e < 8; ++e) sBT[(n8 + e) * 136 + lr] = get16(u, e);
    }
    __syncthreads();
    f32x16 acc[2];
#pragma unroll
    for (int mi = 0; mi < 2; ++mi)
#pragma unroll
      for (int i = 0; i < 16; ++i) acc[mi][i] = 0.f;
#pragma unroll
    for (int kk = 0; kk < 8; ++kk) {
      const bf16x8 bf = *(const bf16x8*)(sBT + (wave * 32 + (lane & 31)) * 136 + kk * 16 + (lane >> 5) * 8);
#pragma unroll
      for (int mi = 0; mi < 2; ++mi) {
        const bf16x8 af = *(const bf16x8*)(sXT + (mi * 32 + (lane & 31)) * 136 + kk * 16 + (lane >> 5) * 8);
        acc[mi] = MFMA32(af, bf, acc[mi]);
      }
    }
    float* st = (float*)slab(p, b == 0 ? 2 : 4) + ((size_t)(c * 16 + head) * 64) * 128;
#pragma unroll
    for (int mi = 0; mi < 2; ++mi)
#pragma unroll
      for (int i = 0; i < 16; ++i) st[(size_t)(mi * 32 + crow(i, lane >> 5)) * 128 + wave * 32 + (lane & 31)] = acc[mi][i];
  }
}
DI void phase_ssd_scan(const Params& p, int bid, int nb) {
  const float* cdec = (const float*)(p.ws + O_CDEC);
  for (int it = bid * 256 + tidx(); it < 2 * 16 * 8192; it += nb * 256) {
    const int b = it >> 17, rem = it & 131071, head = rem >> 13;
    float* st = (float*)slab(p, b == 0 ? 2 : 4) + rem;
    float h = 0.f;
#pragma unroll 8
    for (int c = 0; c < 128; ++c) {
      const float s = st[(size_t)c * 131072];
      st[(size_t)c * 131072] = h;
      h = h * cdec[(b * 128 + c) * 16 + head] + s;
    }
  }
}
DI void phase_ssd_out(const Params& p, int l, int bid, int nb, char* smem) {
  bf16_t* sM = (bf16_t*)smem;
  bf16_t* sXT = sM + 128 * 136;
  float* fa = (float*)(sXT + 64 * 136); float* fb = fa + 128; float* fdt = fb + 128; float* frs = fdt + 128;
  const int tid_ = tidx(), lane = tid_ & 63, wave_ = __builtin_amdgcn_readfirstlane(tid_ >> 6), hh_ = lane >> 5, l31_ = lane & 31;
  const bf16_t* xs = slab(p, 5); const bf16_t* bc = slab(p, 6);
  bf16_t* zy = slab(p, 1);
  const float* dt = (const float*)(p.ws + O_DT);
  const float* ng = p.in[I_SSDNG] + l * 1024;
  for (int task = bid; task < 1024; task += nb) {
    const int g = task & 3, c = (task >> 2) & 127, b = task >> 9;
    const size_t t0 = (size_t)b * S_ + c * 128;
    int tid = tid_; asm volatile("" : "+v"(tid));
    __syncthreads();
#pragma unroll 2
    for (int j = 0; j < 8; ++j) {
      const int ci = tid + 256 * j, lr = ci >> 4, n8 = (ci & 15) * 8;
      *(uint4*)(sM + lr * 136 + n8) = *(const uint4*)(bc + (t0 + lr) * 1024 + g * 128 + n8);
    }
    const int wave = wave_, hh = hh_, l31 = l31_;
    const bf16_t* cptr = bc + (t0 + wave * 32 + l31) * 1024 + 512 + g * 128 + hh * 8;
    __syncthreads();
    f32x16 cb[4];
#pragma unroll
    for (int ni = 0; ni < 4; ++ni)
#pragma unroll
      for (int i = 0; i < 16; ++i) cb[ni][i] = 0.f;
#pragma unroll
    for (int kk = 0; kk < 8; ++kk) {
      const bf16x8 cfk = *(const bf16x8*)(cptr + kk * 16);
#pragma unroll
      for (int ni = 0; ni < 4; ++ni) {
        const bf16x8 bf = *(const bf16x8*)(sM + (ni * 32 + l31) * 136 + kk * 16 + hh * 8);
        cb[ni] = MFMA32(cfk, bf, cb[ni]);
      }
    }
    float ssq[16];
#pragma unroll
    for (int i = 0; i < 16; ++i) ssq[i] = 0.f;
#pragma unroll 1
    for (int e = 0; e < 4; ++e) {
      int l31 = l31_, hh = hh_, wave = wave_;
      asm volatile("" : "+v"(l31), "+v"(hh));
      asm volatile("" : "+s"(wave));
      const int head = g * 4 + e;
      const float aneg = -__expf(p.in[I_ALOG][l * 16 + head]);
      const float dsk = p.in[I_DSKIP][l * 16 + head];
      __syncthreads();
      if (tid < 128) { const float d = dt[(t0 + tid) * 16 + head]; fdt[tid] = d; fa[tid] = d * aneg; }
      __syncthreads();
      float* acs = scan128(fa, fb);
#pragma unroll 2
      for (int j = 0; j < 4; ++j) {
        const int ci = tid + 256 * j, lr = ci >> 3, p8 = (ci & 7) * 8;
        const uint4 u = *(const uint4*)(xs + (t0 + lr) * 1024 + head * 64 + p8);
#pragma unroll
        for (int q = 0; q < 8; ++q) sXT[(p8 + q) * 136 + lr] = get16(u, q);
      }
#pragma unroll
      for (int ni = 0; ni < 4; ++ni)
#pragma unroll
        for (int i = 0; i < 16; ++i) {
          const int lr = wave * 32 + crow(i, hh), sc = ni * 32 + l31;
          const float m = sc <= lr ? cb[ni][i] * __expf(acs[lr] - acs[sc]) * fdt[sc] : 0.f;
          sM[lr * 136 + sc] = f2bf(m);
        }
      __syncthreads();
      const float* hin = (const float*)slab(p, b == 0 ? 2 : 4) + ((size_t)(c * 16 + head) * 64) * 128;
#pragma unroll 1
      for (int ni = 0; ni < 2; ++ni) {
        f32x16 yd;
#pragma unroll
        for (int i = 0; i < 16; ++i) yd[i] = 0.f;
#pragma unroll 2
        for (int kk = 0; kk < 8; ++kk) {
          const bf16x8 cfk = *(const bf16x8*)(cptr + kk * 16);
          const float* hp = hin + (size_t)(ni * 32 + l31) * 128 + kk * 16 + hh * 8;
          const float4 h0 = *(const float4*)hp, h1 = *(const float4*)(hp + 4);
          u32x4 u; u.x = pack2(h0.x, h0.y); u.y = pack2(h0.z, h0.w); u.z = pack2(h1.x, h1.y); u.w = pack2(h1.z, h1.w);
          yd = MFMA32(cfk, __builtin_bit_cast(bf16x8, u), yd);
        }
#pragma unroll
        for (int i = 0; i < 16; ++i) yd[i] *= (SSD_PROBE == 2 ? 0.f : __expf(acs[wave * 32 + crow(i, hh)]));
#pragma unroll
        for (int kk = 0; kk < 8; ++kk) {
          const bf16x8 af = *(const bf16x8*)(sM + (wave * 32 + l31) * 136 + kk * 16 + hh * 8);
          const bf16x8 bf = *(const bf16x8*)(sXT + (ni * 32 + l31) * 136 + kk * 16 + hh * 8);
          yd = MFMA32(af, bf, yd);
        }
#pragma unroll
        for (int i = 0; i < 16; ++i) {
          const int lr = wave * 32 + crow(i, hh), pc = ni * 32 + l31;
          const float xv = bf2f(sXT[pc * 136 + lr]);
          float y = (SSD_PROBE == 1 ? 0.f : yd[i]) + xv * dsk;
          const size_t o = (t0 + lr) * 1024 + head * 64 + pc;
          const float zv = bf2f(zy[o]);
          y *= siluf_(zv);
          ssq[i] += y * y;
          zy[o] = f2bf(y);
        }
      }
    }
#pragma unroll
    for (int i = 0; i < 16; ++i) {
      float s = ssq[i];
      for (int o = 16; o > 0; o >>= 1) s += __shfl_xor(s, o);
      if (l31 == 0) frs[wave * 32 + crow(i, hh)] = rsqrtf(s * (1.f / 256.f) + 1e-6f);
    }
    __syncthreads();
#pragma unroll 1
    for (int j = 0; j < (DBG == 2 ? 0 : 16); ++j) {
      const int ci = tid + 256 * j, lr = ci >> 5, c8 = (ci & 31) * 8;
      bf16_t* ptr = zy + (t0 + lr) * 1024 + g * 256 + c8;
      float f[8]; unpack8(*(const uint4*)ptr, f);
      const float rs = frs[lr];
#pragma unroll
      for (int q = 0; q < 8; ++q) f[q] *= rs * ng[g * 256 + c8 + q];
      *(uint4*)ptr = pack8(f);
    }
  }
}

DI void phase_moba_norm(const Params& p, int l, int bid, int nb, char* smem) {
  float* sK = (float*)smem;
  const int tid = tidx(), rg = tid >> 4, ln = tid & 15;
  bf16_t* Q = slab(p, 2); bf16_t* Kx = slab(p, 4);
  float* kmean = (float*)(p.ws + O_KMEAN);
  float qg[8], kg[8];
#pragma unroll
  for (int e = 0; e < 8; ++e) { qg[e] = p.in[I_QNG][l * 128 + ln * 8 + e]; kg[e] = p.in[I_KNG][l * 128 + ln * 8 + e]; }
  for (int task = bid; task < 1024; task += nb) {
    const int blk = task & 63, h = (task >> 6) & 7, b = task >> 9;
    const size_t t0 = (size_t)b * S_ + blk * 256;
    float ks[8];
#pragma unroll
    for (int e = 0; e < 8; ++e) ks[e] = 0.f;
    for (int j = 0; j < 16; ++j) {
      const size_t o = (t0 + rg + 16 * j) * 1024 + h * 128 + ln * 8;
      float f[8]; float ss = 0.f;
      unpack8(*(const uint4*)(Q + o), f);
#pragma unroll
      for (int e = 0; e < 8; ++e) ss += f[e] * f[e];
      ss = red16(ss);
      float r = rsqrtf(ss * (1.f / 128.f) + 1e-6f);
#pragma unroll
      for (int e = 0; e < 8; ++e) f[e] *= r * qg[e];
      *(uint4*)(Q + o) = pack8(f);
      unpack8(*(const uint4*)(Kx + o), f);
      ss = 0.f;
#pragma unroll
      for (int e = 0; e < 8; ++e) ss += f[e] * f[e];
      ss = red16(ss);
      r = rsqrtf(ss * (1.f / 128.f) + 1e-6f);
#pragma unroll
      for (int e = 0; e < 8; ++e) { f[e] *= r * kg[e]; ks[e] += f[e]; }
      *(uint4*)(Kx + o) = pack8(f);
    }
    __syncthreads();
#pragma unroll
    for (int e = 0; e < 8; ++e) sK[rg * 128 + ln * 8 + e] = ks[e];
    __syncthreads();
    if (tid < 128) {
      float s = 0.f;
#pragma unroll
      for (int j = 0; j < 16; ++j) s += sK[j * 128 + tid];
      kmean[((size_t)(b * 8 + h) * 64 + blk) * 128 + tid] = s * (1.f / 256.f);
    }
  }
}
DI void phase_moba_gate(const Params& p, int bid, int nb, char* smem) {
  float* sKm = (float*)smem;
  const int tid = tidx();
  const bf16_t* Q = slab(p, 2);
  const float* kmean = (const float*)(p.ws + O_KMEAN);
  int* sel = (int*)(p.ws + O_SEL); int* cnt = (int*)(p.ws + O_CNT);
  for (int task = bid; task < 1024; task += nb) {
    const int blk = task & 63, h = (task >> 6) & 7, b = task >> 9;
    __syncthreads();
    for (int i = tid; i < blk * 128; i += 256) sKm[i] = kmean[((size_t)(b * 8 + h) * 64) * 128 + i];
    __syncthreads();
    const size_t t = (size_t)b * S_ + blk * 256 + tid;
    float q[128];
#pragma unroll
    for (int j = 0; j < 16; ++j) unpack8(*(const uint4*)(Q + t * 1024 + h * 128 + j * 8), q + j * 8);
    float v0 = -3e38f, v1 = -3e38f, v2 = -3e38f; int i0 = -1, i1 = -1, i2 = -1;
    for (int j = 0; j < blk; ++j) {
      float d = 0.f;
#pragma unroll
      for (int e = 0; e < 128; ++e) d += q[e] * sKm[j * 128 + e];
      if (d > v0) { v2 = v1; i2 = i1; v1 = v0; i1 = i0; v0 = d; i0 = j; }
      else if (d > v1) { v2 = v1; i2 = i1; v1 = d; i1 = j; }
      else if (d > v2) { v2 = d; i2 = j; }
    }
    int* so = sel + (t * 8 + h) * 3;
    so[0] = i0; so[1] = i1; so[2] = i2;
    const int base = (b * 8 + h) * 64;
    if (i0 >= 0) atomicAdd(cnt + 0 * 1024 + base + i0, 1);
    if (i1 >= 0) atomicAdd(cnt + 1 * 1024 + base + i1, 1);
    if (i2 >= 0) atomicAdd(cnt + 2 * 1024 + base + i2, 1);
  }
}
DI void phase_moba_fill(const Params& p, int bid, int nb, char* smem) {
  int* sBase = (int*)smem;
  const int tid = tidx();
  const int* sel = (const int*)(p.ws + O_SEL); const int* cnt = (const int*)(p.ws + O_CNT);
  int* fill = (int*)(p.ws + O_FILL); int* lists = (int*)(p.ws + O_LISTS);
  for (int task = bid; task < 1024; task += nb) {
    const int blk = task & 63, h = (task >> 6) & 7, b = task >> 9;
    const int base = (b * 8 + h) * 64;
    __syncthreads();
    if (tid < 3) { int a = 0; for (int j = 0; j < 64; ++j) { sBase[tid * 64 + j] = a; a += cnt[tid * 1024 + base + j]; } }
    __syncthreads();
    const int ts = blk * 256 + tid;
    const size_t t = (size_t)b * S_ + ts;
    for (int s = 0; s < 3; ++s) {
      const int j = sel[(t * 8 + h) * 3 + s];
      if (j >= 0) {
        const int pos = sBase[s * 64 + j] + atomicAdd(fill + s * 1024 + base + j, 1);
        lists[(size_t)s * (T_ * 8) + (size_t)(b * 8 + h) * S_ + pos] = ts;
      }
    }
  }
}
DI int t5_bucket(int d) {
  if (d < 16) return d;
  const int large = 16 + (int)(__logf((float)d * (1.f / 16.f)) / 4.1588830833596715f * 16.f);
  return large < 31 ? large : 31;
}
struct MobaLds { bf16_t* sK; bf16_t* sVT; float* sBias; };
DI void moba_block(const Params& p, const MobaLds& L, int b, int h, int tsq  , int kb  ,
                   int ntiles, bool causal, bool init) {
  const int tid = tidx(), lane = tid & 63, hh = lane >> 5, l31 = lane & 31;
  const bf16_t* Q = slab(p, 2); const bf16_t* Kx = slab(p, 4); const bf16_t* V = slab(p, 5);
  bf16_t* ACC = slab(p, 6);
  float* MM = (float*)(p.ws + O_MM); float* ML = (float*)(p.ws + O_ML);
  const bool valid = tsq >= 0;
  const size_t tq = (size_t)b * S_ + (valid ? tsq : 0);
  bf16x8 qf[8];
#pragma unroll
  for (int kk = 0; kk < 8; ++kk) {
    uint4 u = {0, 0, 0, 0};
    if (valid) u = *(const uint4*)(Q + tq * 1024 + h * 128 + kk * 16 + hh * 8);
    qf[kk] = __builtin_bit_cast(bf16x8, u);
  }
  float m = -1e30f, lsum = 0.f;
  f32x16 o[4];
#pragma unroll
  for (int dt = 0; dt < 4; ++dt)
#pragma unroll
    for (int i = 0; i < 16; ++i) o[dt][i] = 0.f;
  if (!init && valid) {
    m = MM[tq * 8 + h]; lsum = ML[tq * 8 + h];
#pragma unroll
    for (int dt = 0; dt < 4; ++dt)
#pragma unroll
      for (int g4 = 0; g4 < 4; ++g4) {
        const uint2 u = *(const uint2*)(ACC + tq * 1024 + h * 128 + dt * 32 + g4 * 8 + hh * 4);
        o[dt][g4 * 4 + 0] = lo16(u.x) * lsum; o[dt][g4 * 4 + 1] = hi16(u.x) * lsum;
        o[dt][g4 * 4 + 2] = lo16(u.y) * lsum; o[dt][g4 * 4 + 3] = hi16(u.y) * lsum;
      }
  }
  int wmaxq = valid ? tsq : -1;
  for (int of = 32; of > 0; of >>= 1) wmaxq = max(wmaxq, __shfl_xor(wmaxq, of));
  const float bias31 = L.sBias[1023];
  const float scale = 0.08838834764831845f;
  const size_t k0 = (size_t)b * S_ + (size_t)kb * 256;
  for (int kt = 0; kt < ntiles; ++kt) {
    __syncthreads();
#pragma unroll
    for (int j = 0; j < 4; ++j) {
      const int ci = tid + 256 * j, kr = ci >> 4, d8 = (ci & 15) * 8;
      const size_t go = (k0 + kt * 64 + kr) * 1024 + h * 128 + d8;
      *(uint4*)(L.sK + kr * 136 + d8) = *(const uint4*)(Kx + go);
      const uint4 u = *(const uint4*)(V + go);
#pragma unroll
      for (int e = 0; e < 8; ++e) L.sVT[(d8 + e) * 72 + kr] = get16(u, e);
    }
    __syncthreads();
    const int kpos0 = kb * 256 + kt * 64;
    if (causal && kpos0 > wmaxq) continue;
    f32x16 st[2];
#pragma unroll
    for (int t2 = 0; t2 < 2; ++t2)
#pragma unroll
      for (int i = 0; i < 16; ++i) st[t2][i] = 0.f;
#pragma unroll
    for (int kk = 0; kk < 8; ++kk)
#pragma unroll
      for (int t2 = 0; t2 < 2; ++t2) {
        const bf16x8 af = *(const bf16x8*)(L.sK + (t2 * 32 + l31) * 136 + kk * 16 + hh * 8);
        st[t2] = MFMA32(af, qf[kk], st[t2]);
      }
    float mloc = -1e30f;
#pragma unroll
    for (int t2 = 0; t2 < 2; ++t2)
#pragma unroll
      for (int i = 0; i < 16; ++i) {
        const int kp = kpos0 + t2 * 32 + crow(i, hh);
        const int dist = tsq - kp;
        float s;
        if (causal && dist < 0) s = -1e30f;
        else {
          const int dd = dist < 0 ? 0 : dist;
          s = st[t2][i] * scale + (dd < 1024 ? L.sBias[dd] : bias31);
        }
        st[t2][i] = s;
        mloc = fmaxf(mloc, s);
      }
    mloc = fmaxf(mloc, __shfl_xor(mloc, 32));
    const float mnew = fmaxf(m, mloc);
    const float alpha = __expf(m - mnew);
    float ls = 0.f;
#pragma unroll
    for (int t2 = 0; t2 < 2; ++t2)
#pragma unroll
      for (int i = 0; i < 16; ++i) {
        const float pv = st[t2][i] <= -1e29f ? 0.f : __expf(st[t2][i] - mnew);
        st[t2][i] = pv; ls += pv;
      }
    ls += __shfl_xor(ls, 32);
    lsum = lsum * alpha + ls;
    m = mnew;
#pragma unroll
    for (int dt = 0; dt < 4; ++dt)
#pragma unroll
      for (int i = 0; i < 16; ++i) o[dt][i] *= alpha;
#pragma unroll
    for (int t2 = 0; t2 < 2; ++t2)
#pragma unroll
      for (int s2 = 0; s2 < 2; ++s2) {
        uint4 pu;
        pu.x = pack2(st[t2][8 * s2 + 0], st[t2][8 * s2 + 1]); pu.y = pack2(st[t2][8 * s2 + 2], st[t2][8 * s2 + 3]);
        pu.z = pack2(st[t2][8 * s2 + 4], st[t2][8 * s2 + 5]); pu.w = pack2(st[t2][8 * s2 + 6], st[t2][8 * s2 + 7]);
        const bf16x8 pf = __builtin_bit_cast(bf16x8, pu);
#pragma unroll
        for (int dt = 0; dt < 4; ++dt) {
          const bf16_t* vp = L.sVT + (dt * 32 + l31) * 72 + t2 * 32 + s2 * 16 + hh * 4;
          uint4 vu; const uint2 a0 = *(const uint2*)vp, a1 = *(const uint2*)(vp + 8);
          vu.x = a0.x; vu.y = a0.y; vu.z = a1.x; vu.w = a1.y;
          o[dt] = MFMA32(__builtin_bit_cast(bf16x8, vu), pf, o[dt]);
        }
      }
  }
  if (valid) {
    const float inv = 1.f / lsum;
    if (hh == 0) { MM[tq * 8 + h] = m; ML[tq * 8 + h] = lsum; }
#pragma unroll
    for (int dt = 0; dt < 4; ++dt)
#pragma unroll
      for (int g4 = 0; g4 < 4; ++g4) {
        uint2 u; u.x = pack2(o[dt][g4 * 4] * inv, o[dt][g4 * 4 + 1] * inv); u.y = pack2(o[dt][g4 * 4 + 2] * inv, o[dt][g4 * 4 + 3] * inv);
        *(uint2*)(ACC + tq * 1024 + h * 128 + dt * 32 + g4 * 8 + hh * 4) = u;
      }
  }
}
DI void moba_bias_table(const Params& p, float* sBias, int h) {
  for (int d = tidx(); d < 1024; d += 256) sBias[d] = p.in[I_RELB][t5_bucket(d) * 8 + h];
}
DI void phase_moba_own(const Params& p, int bid, int nb, char* smem) {
  MobaLds L; L.sK = (bf16_t*)smem; L.sVT = L.sK + 64 * 136; L.sBias = (float*)(L.sVT + 128 * 72);
  const int tid = tidx(), lane = tid & 63, wave = tid >> 6;
  for (int task = bid; task < 2048; task += nb) {
    const int qt = task & 1, blk = (task >> 1) & 63, h = (task >> 7) & 7, b = task >> 10;
    __syncthreads();
    moba_bias_table(p, L.sBias, h);
    __syncthreads();
    const int tsq = blk * 256 + qt * 128 + wave * 32 + (lane & 31);
    moba_block(p, L, b, h, tsq, blk, 2 * (qt + 1), true, true);
  }
}
DI void phase_moba_past(const Params& p, int s, int bid, int nb, char* smem) {
  MobaLds L; L.sK = (bf16_t*)smem; L.sVT = L.sK + 64 * 136; L.sBias = (float*)(L.sVT + 128 * 72);
  int* sTb = (int*)(L.sBias + 1024);
  const int tid = tidx(), lane = tid & 63, wave = tid >> 6;
  const int* cnt = (const int*)(p.ws + O_CNT) + s * 1024;
  const int* lists = (const int*)(p.ws + O_LISTS) + (size_t)s * (T_ * 8);
  __syncthreads();
  if (tid < 16) { int a = 0; for (int j = 0; j < 64; ++j) { sTb[tid * 64 + j] = a; a += (cnt[tid * 64 + j] + 127) >> 7; } sTb[1040 + tid] = a; }
  __syncthreads();
  if (tid == 0) { int a = 0; for (int i = 0; i < 16; ++i) { const int c = sTb[1040 + i]; sTb[1040 + i] = a; a += c; } sTb[1056] = a; }
  __syncthreads();
  const int total = sTb[1056];
  for (int task = bid; task < total; task += nb) {
    int gi = 0;
    for (int i = 1; i < 16; ++i) if (sTb[1040 + i] <= task) gi = i;
    const int loc = task - sTb[1040 + gi];
    int j = 0;
    for (int i = 1; i < 64; ++i) if (sTb[gi * 64 + i] <= loc) j = i;
    while (j > 0 && ((cnt[gi * 64 + j] + 127) >> 7) == 0) --j;
    const int tile = loc - sTb[gi * 64 + j];
    const int b = gi >> 3, h = gi & 7;
    __syncthreads();
    moba_bias_table(p, L.sBias, h);
    __syncthreads();
    int lbase = 0;
    for (int i = 0; i < j; ++i) lbase += cnt[gi * 64 + i];
    const int n = cnt[gi * 64 + j];
    const int qi = tile * 128 + wave * 32 + (lane & 31);
    const int tsq = qi < n ? lists[(size_t)gi * S_ + lbase + qi] : -1;
    moba_block(p, L, b, h, tsq, j, 4, false, false);
  }
}

DI void phase_merge(const Params& p, int l, int bid, int nb, char* smem) {
  bf16_t* sA = (bf16_t*)smem; bf16_t* sB = sA + 128 * LDT;
  bf16_t* stash = sB + 128 * LDT;
  const int tid = tidx();
  const bf16_t* h = slab(p, 0);
  const bf16_t* wg = (const bf16_t*)(p.ws + O_WGATE); const bf16_t* pt = (const bf16_t*)(p.ws + O_PT);
  const float* bg = p.in[I_BGATE] + l * 3072;
  bf16_t* mg = slab(p, 2);
  for (int t = bid; t < 512 * 8; t += nb) {
    int tm, tn; tile_remap(t, 512, 8, tm, tn);
    f32x16 accm[1][2]; acc_zero<1>(accm);
    for (int br = 0; br < 3; ++br) {
      if ((SKIP_BR >> br) & 1) continue;
      const bf16_t* yb = slab(p, br == 0 ? 1 : (br == 1 ? 6 : 3));
      f32x16 acc[1][2]; acc_zero<1>(acc);
      gemm_core<1>(h + (size_t)tm * 64 * 1024, 1024, wg + (size_t)(br * 1024 + tn * 128) * 1024, 1024, 1024, sA, sB, acc);
      {
        const float* bgp = bg + br * 1024 + tn * 128;
        ACC_FOREACH(1, acc, { stash[((mi * 2 + ni) * 16 + i) * 256 + tid] = f2bf(sigmoidf_(v + bgp[c])); })
      }
      acc_zero<1>(acc);
      gemm_core<1>(yb + (size_t)tm * 64 * 1024, 1024, pt + (size_t)(br * 1024 + tn * 128) * 1024, 1024, 1024, sA, sB, acc);
      ACC_FOREACH(1, acc, { accm[mi][ni][i] += bf2f(stash[((mi * 2 + ni) * 16 + i) * 256 + tid]) * v; })
    }
    bf16_t* d = mg + (size_t)tm * 64 * 1024 + tn * 128;
    ACC_FOREACH(1, accm, { d[(size_t)r * 1024 + c] = f2bf(v); })
  }
}
DI void phase_wout(const Params& p, int l, int bid, int nb, char* smem) {
  bf16_t* sA = (bf16_t*)smem; bf16_t* sB = sA + 128 * LDT;
  const bf16_t* mg = slab(p, 2); const bf16_t* wo = (const bf16_t*)(p.ws + O_WOUT);
  const float* xin = l == 0 ? p.in[I_X] : p.out;
  for (int t = bid; t < 256 * 8; t += nb) {
    int tm, tn; tile_remap(t, 256, 8, tm, tn);
    f32x16 acc[2][2]; acc_zero<2>(acc);
    gemm_core<2>(mg + (size_t)tm * 128 * 1024, 1024, wo + (size_t)tn * 128 * 1024, 1024, 1024, sA, sB, acc);
    const size_t o0 = (size_t)tm * 128 * 1024 + tn * 128;
    ACC_FOREACH(2, acc, { const size_t o = o0 + (size_t)r * 1024 + c; p.out[o] = xin[o] + v; })
  }
}

DI void phase_peer_prep(const Params& p, int l, int bid, int nb) {
  rmsnorm_phase(p.out, p.in[I_N2G] + l * 1024, slab(p, 0), bid, nb);
  conv_fp8(p.in[I_U] + (size_t)l * 16777216, (unsigned char*)slab(p, 1), 16777216, 64.f, bid, nb);
  conv_fp8(p.in[I_V] + (size_t)l * 16777216, (unsigned char*)slab(p, 1) + 16777216, 16777216, 16.f, bid, nb);
}
DI void phase_peer_q(const Params& p, int bid, int nb, char* smem) {
  bf16_t* sA = (bf16_t*)smem; bf16_t* sB = sA + 128 * LDT;
  const bf16_t* h2 = slab(p, 0); const bf16_t* wq = (const bf16_t*)(p.ws + O_WQ);
  bf16_t* q = slab(p, 2);
  for (int t = bid; t < 256 * 16; t += nb) {
    int tm, tn; tile_remap(t, 256, 16, tm, tn);
    f32x16 acc[2][2]; acc_zero<2>(acc);
    gemm_core<2>(h2 + (size_t)tm * 128 * 1024, 1024, wq + (size_t)tn * 128 * 1024, 1024, 1024, sA, sB, acc);
    bf16_t* d = q + (size_t)tm * 128 * 2048 + tn * 128;
    ACC_FOREACH(2, acc, { d[(size_t)r * 2048 + c] = f2bf(v); })
  }
}
DI unsigned fkey(float f) { unsigned u = __float_as_uint(f); return (u & 0x80000000u) ? ~u : (u | 0x80000000u); }
DI void phase_peer_topk(const Params& p, int bid, int nb, char* smem, int rep) {
  bf16_t* sQ = (bf16_t*)smem;
  float* sS = (float*)smem;
  float* wsc = (float*)(smem + 66560);
  const int tid = tidx(), lane = tid & 63, wave = tid >> 6, wm = wave >> 1, wn = wave & 1, hh = lane >> 5, l31 = lane & 31;
  const bf16_t* q = slab(p, 2);
  const bf16_t* kb = (const bf16_t*)(p.ws + (wn == 0 ? O_K1 : O_K2));
  int* idx_out = (int*)slab(p, 4); float* gate_out = (float*)slab(p, 5);
  float* tv = wsc + wave * 384;
  const unsigned long long ltmask = (1ull << lane) - 1ull;
  for (int task = bid; task < 4096; task += nb) {
    const int hd = task & 7, tt = task >> 3;
    const size_t t0 = (size_t)tt * 64;
    __syncthreads();
#pragma unroll
    for (int j = 0; j < 8; ++j) {
      const int ci = tid + 256 * j, r = ci >> 5, c8 = (ci & 31) * 8;
      *(uint4*)(sQ + r * 264 + c8) = *(const uint4*)(q + (t0 + r) * 2048 + hd * 256 + c8);
    }
    __syncthreads();
    f32x16 acc[4];
#pragma unroll
    for (int ni = 0; ni < 4; ++ni)
#pragma unroll
      for (int i = 0; i < 16; ++i) acc[ni][i] = 0.f;
#pragma unroll
    for (int kk = 0; kk < 8; ++kk) {
      const bf16x8 af = *(const bf16x8*)(sQ + (wm * 32 + l31) * 264 + wn * 128 + kk * 16 + hh * 8);
#pragma unroll
      for (int ni = 0; ni < 4; ++ni) {
        const bf16x8 bf = *(const bf16x8*)(kb + (size_t)(ni * 32 + l31) * 128 + kk * 16 + hh * 8);
        acc[ni] = MFMA32(af, bf, acc[ni]);
      }
    }
    __syncthreads();
#pragma unroll
    for (int ni = 0; ni < 4; ++ni)
#pragma unroll
      for (int i = 0; i < 16; ++i) sS[(wm * 32 + crow(i, hh)) * 260 + wn * 128 + ni * 32 + l31] = acc[ni][i];
    __syncthreads();
#define WAVE_SYNC() do { __builtin_amdgcn_fence(__ATOMIC_RELEASE, "wavefront"); __builtin_amdgcn_wave_barrier(); __builtin_amdgcn_fence(__ATOMIC_ACQUIRE, "wavefront"); } while (0)
    for (int tk = 0; tk < 16; tk += 4) {
      float av[4][4]; unsigned ak[4][4]; unsigned thrA[4], thrB[4];
#pragma unroll
      for (int u = 0; u < 4; ++u) {
        const int r = wave * 16 + tk + u;
#pragma unroll
        for (int q = 0; q < 4; ++q) { av[u][q] = sS[r * 260 + q * 64 + lane]; ak[u][q] = fkey(av[u][q]); }
        thrA[u] = 0; thrB[u] = 0;
      }
      for (int bit = 31; bit >= 0; --bit) {
#pragma unroll
        for (int u = 0; u < 4; ++u) {
          const unsigned ca = thrA[u] | (1u << bit), cb = thrB[u] | (1u << bit);
          const int na = __popcll(__ballot(ak[u][0] >= ca)) + __popcll(__ballot(ak[u][1] >= ca));
          const int nb2 = __popcll(__ballot(ak[u][2] >= cb)) + __popcll(__ballot(ak[u][3] >= cb));
          thrA[u] = na >= 16 ? ca : thrA[u];
          thrB[u] = nb2 >= 16 ? cb : thrB[u];
        }
      }
#pragma unroll
      for (int u = 0; u < 4; ++u) {
        float* tvu = tv + u * 96; int* tiu = (int*)(tvu + 32);
        const unsigned long long q0 = __ballot(ak[u][0] >= thrA[u]), q1 = __ballot(ak[u][1] >= thrA[u]);
        const int p0 = __popcll(q0 & ltmask), p1 = __popcll(q0) + __popcll(q1 & ltmask);
        if (ak[u][0] >= thrA[u] && p0 < 16) { tvu[p0] = av[u][0]; tiu[p0] = lane; }
        if (ak[u][1] >= thrA[u] && p1 < 16) { tvu[p1] = av[u][1]; tiu[p1] = lane + 64; }
        const unsigned long long w0 = __ballot(ak[u][2] >= thrB[u]), w1 = __ballot(ak[u][3] >= thrB[u]);
        const int r0 = __popcll(w0 & ltmask), r1 = __popcll(w0) + __popcll(w1 & ltmask);
        if (ak[u][2] >= thrB[u] && r0 < 16) { tvu[16 + r0] = av[u][2]; tiu[16 + r0] = lane; }
        if (ak[u][3] >= thrB[u] && r1 < 16) { tvu[16 + r1] = av[u][3]; tiu[16 + r1] = lane + 64; }
      }
      WAVE_SYNC();
      float cv[4][4]; unsigned ck[4][4]; unsigned thr[4];
#pragma unroll
      for (int u = 0; u < 4; ++u) {
        const float* tvu = tv + u * 96;
#pragma unroll
        for (int q4 = 0; q4 < 4; ++q4) { const int c = lane + 64 * q4; cv[u][q4] = tvu[c >> 4] + tvu[16 + (c & 15)]; ck[u][q4] = fkey(cv[u][q4]); }
        thr[u] = 0;
      }
      for (int bit = 31; bit >= 0; --bit) {
#pragma unroll
        for (int u = 0; u < 4; ++u) {
          const unsigned cand = thr[u] | (1u << bit);
          const int c = __popcll(__ballot(ck[u][0] >= cand)) + __popcll(__ballot(ck[u][1] >= cand)) + __popcll(__ballot(ck[u][2] >= cand)) + __popcll(__ballot(ck[u][3] >= cand));
          thr[u] = c >= 16 ? cand : thr[u];
        }
      }
#pragma unroll
      for (int u = 0; u < 4; ++u) {
        float* tvu = tv + u * 96; const int* tiu = (const int*)(tvu + 32); float* fvu = tvu + 64; int* fiu = (int*)(tvu + 80);
        int basep = 0;
#pragma unroll
        for (int q4 = 0; q4 < 4; ++q4) {
          const unsigned long long bb = __ballot(ck[u][q4] >= thr[u]);
          const int pos = basep + __popcll(bb & ltmask);
          if (ck[u][q4] >= thr[u] && pos < 16) { const int c = lane + 64 * q4; fvu[pos] = cv[u][q4]; fiu[pos] = tiu[c >> 4] * 128 + tiu[16 + (c & 15)]; }
          basep += __popcll(bb);
        }
      }
      WAVE_SYNC();
      {
        const int u = lane >> 4, e16 = lane & 15;
        const float* fvu = tv + u * 96 + 64; const int* fiu = (const int*)(tv + u * 96 + 80);
        float mx = -3e38f;
#pragma unroll
        for (int e = 0; e < 16; ++e) mx = fmaxf(mx, fvu[e]);
        float sm = 0.f;
#pragma unroll
        for (int e = 0; e < 16; ++e) sm += __expf(fvu[e] - mx);
        const size_t o = ((t0 + wave * 16 + tk + u) * 8 + hd) * 16 + e16;
        idx_out[o] = fiu[e16];
        gate_out[o] = __expf(fvu[e16] - mx) / sm;
      }
      WAVE_SYNC();
    }
  }
}
DI void fp8x16_to_f32(const u32x4& v, float* f) {
#pragma unroll
  for (int j = 0; j < 4; ++j) {
    const f32x2 lo = __builtin_amdgcn_cvt_pk_f32_fp8((int)v[j], false), hi = __builtin_amdgcn_cvt_pk_f32_fp8((int)v[j], true);
    f[4 * j] = lo.x; f[4 * j + 1] = lo.y; f[4 * j + 2] = hi.x; f[4 * j + 3] = hi.y;
  }
}
DI void phase_peer_gather(const Params& p, int bid, int nb, char* smem) {
  const int tid = tidx(), lane = tid & 63, wave = tid >> 6;
  const bf16_t* h2 = slab(p, 0);
  const unsigned char* ub = (const unsigned char*)slab(p, 1); const unsigned char* vb = ub + 16777216;
  const int* idx = (const int*)slab(p, 4); const float* gate = (const float*)slab(p, 5);
  for (int t = bid * 4 + wave; t < T_; t += nb * 4) {
    float h[16];
    unpack8(*(const uint4*)(h2 + (size_t)t * 1024 + lane * 16), h);
    unpack8(*(const uint4*)(h2 + (size_t)t * 1024 + lane * 16 + 8), h + 8);
    const int ia = idx[(size_t)t * 128 + lane], ib = idx[(size_t)t * 128 + 64 + lane];
    float c_lo = 0.f, c_hi = 0.f;
#pragma unroll 1
    for (int g = 0; g < 8; ++g) {
      float part[16];
#pragma unroll
      for (int hf = 0; hf < 2; ++hf) {
        u32x4 rows[8];
#pragma unroll
        for (int j = 0; j < 8; ++j) {
          const int e = g * 16 + hf * 8 + j;
          const int id = __builtin_amdgcn_readlane(g < 4 ? ia : ib, e & 63);
          rows[j] = *(const u32x4*)(ub + (size_t)id * 1024 + lane * 16);
        }
#pragma unroll
        for (int j = 0; j < 8; ++j) {
          float f[16]; fp8x16_to_f32(rows[j], f);
          float a = 0.f;
#pragma unroll
          for (int i = 0; i < 16; ++i) a += h[i] * f[i];
          part[hf * 8 + j] = a;
        }
      }
#pragma unroll
      for (int n = 8, m = 32; n >= 1; n >>= 1, m >>= 1) {
        const bool up = (lane & m) != 0;
#pragma unroll
        for (int i = 0; i < n; ++i) {
          const float keep = up ? part[i + n] : part[i];
          const float send = up ? part[i] : part[i + n];
          part[i] = keep + __shfl_xor(send, m);
        }
      }
      float a = part[0];
      a += __shfl_xor(a, 2);
      a += __shfl_xor(a, 1);
      a *= (1.f / 64.f);
      const float ge = 0.5f * a * (1.f + erff(a * 0.7071067811865476f));
      const float cj = __shfl(ge, 4 * (lane & 15));
      const float cv = cj * gate[(size_t)t * 128 + g * 16 + (lane & 15)];
      const bool mine = (lane >> 4) == (g & 3);
      if (g < 4) c_lo = mine ? cv : c_lo; else c_hi = mine ? cv : c_hi;
    }
    float o[16];
#pragma unroll
    for (int i = 0; i < 16; ++i) o[i] = 0.f;
#pragma unroll 1
    for (int g = 0; g < 16; ++g) {
      u32x4 rows[8];
#pragma unroll
      for (int j = 0; j < 8; ++j) {
        const int e = g * 8 + j;
        const int id = __builtin_amdgcn_readlane(g < 8 ? ia : ib, e & 63);
        rows[j] = *(const u32x4*)(vb + (size_t)id * 1024 + lane * 16);
      }
#pragma unroll
      for (int j = 0; j < 8; ++j) {
        const int e = g * 8 + j;
        const float c = __builtin_bit_cast(float, __builtin_amdgcn_readlane(__builtin_bit_cast(int, g < 8 ? c_lo : c_hi), e & 63));
        float f[16]; fp8x16_to_f32(rows[j], f);
#pragma unroll
        for (int i = 0; i < 16; ++i) o[i] += c * f[i];
      }
    }
    float4* xo = (float4*)(p.out + (size_t)t * 1024 + lane * 16);
#pragma unroll
    for (int q = 0; q < 4; ++q) {
      float4 a = xo[q];
      a.x += o[4 * q] * (1.f / 16.f); a.y += o[4 * q + 1] * (1.f / 16.f); a.z += o[4 * q + 2] * (1.f / 16.f); a.w += o[4 * q + 3] * (1.f / 16.f);
      xo[q] = a;
    }
  }
}

constexpr int NPH = 26;
DI void run_phase(const Params& p, int lrep, int ph, int bid, int nb, char* smem) {
  const int l = lrep & 15, rep = lrep >> 4;
#ifdef ONLY_PH
  ph = ONLY_PH;
#endif
  switch (ph) {
    case 0: phase_prep(p, l, bid, nb, smem); break;
    case 1: {
      Route rt; rt.seg0 = 6; rt.packed = 4 | (5 << 4) | (6 << 8);
      gemm_in_phase(p, l, rt, 26, 48, 26, 0, bid, nb, smem);
    } break;
    case 2: phase_lora_prep(p, l, bid, nb); break;
    case 3: phase_lora_wa(p, l, bid, nb, smem); break;
    case 4: phase_rwkv_scan(p, l, bid, nb, smem); break;
    case 5: phase_rwkv_ln(p, l, bid, nb); break;
    case 6: phase_rwkv_g(p, l, bid, nb, smem); break;
    case 7: {
      Route rt; rt.seg0 = 0; rt.packed = 1 | (2 << 4) | (4 << 8);
      gemm_in_phase(p, l, rt, 25, 0, 24, 74, bid, nb, smem);
    } break;
    case 8: phase_ssd_conv(p, l, bid, nb); break;
    case 9: phase_ssd_states(p, l, bid, nb, smem); break;
    case 10: phase_ssd_scan(p, bid, nb); break;
    case 11: phase_ssd_out(p, l, bid, nb, smem); break;
    case 12: {
      Route rt; rt.seg0 = 3; rt.packed = 2 | (4 << 4) | (5 << 8);
      gemm_in_phase(p, l, rt, 24, 24, 24, 0, bid, nb, smem);
    } break;
    case 13: phase_moba_norm(p, l, bid, nb, smem); break;
    case 14: phase_moba_gate(p, bid, nb, smem); break;
    case 15: phase_moba_fill(p, bid, nb, smem); break;
    case 16: phase_moba_own(p, bid, nb, smem); break;
    case 17: phase_moba_past(p, 0, bid, nb, smem); break;
    case 18: phase_moba_past(p, 1, bid, nb, smem); break;
    case 19: phase_moba_past(p, 2, bid, nb, smem); break;
    case 20: phase_merge(p, l, bid, nb, smem); break;
    case 21: phase_wout(p, l, bid, nb, smem); break;
    case 22: phase_peer_prep(p, l, bid, nb); break;
    case 23: phase_peer_q(p, bid, nb, smem); break;
    case 24: phase_peer_topk(p, bid, nb, smem, rep); break;
    case 25: phase_peer_gather(p, bid, nb, smem); break;
  }
}

#if !MULTI
#define XB_TMO      128
#define XB_XCNT(j)  (256  + 64 * (j))
#define XB_XSUB(j)  (1280 + 64 * (j))
#define XB_XGEN(j)  (2304 + 64 * (j))
#define XB_TOP      3328
#define XB_TOPGEN   3392
#define XCD_BAR_WORDS 3456
#define XB_SPIN_CAP (1u << 22)
#define LAS __attribute__((address_space(3)))
DI unsigned xb_ld(unsigned* p)              { return __hip_atomic_load(p, __ATOMIC_RELAXED, __HIP_MEMORY_SCOPE_AGENT); }
DI unsigned xb_add(unsigned* p, unsigned v) { return __hip_atomic_fetch_add(p, v, __ATOMIC_RELAXED, __HIP_MEMORY_SCOPE_AGENT); }
DI unsigned xb_xcc_id() { return (unsigned)__builtin_amdgcn_s_getreg((3 << 11) | 20) & 0xFu; }
#define XB_SPIN(cond, bar) do { unsigned _sp = 0; while (cond) { __builtin_amdgcn_s_sleep(1); \
    if ((++_sp & 255u) == 0u) { if (xb_ld(&(bar)[XB_TMO])) break; if (_sp > XB_SPIN_CAP) { atomicAdd(&(bar)[XB_TMO], 1u); break; } } } } while (0)
struct XcdBarrier { unsigned* bar; unsigned x; volatile LAS unsigned* st; };
DI XcdBarrier xcd_barrier_post(unsigned* bar, volatile LAS unsigned* st) {
  XcdBarrier b; b.bar = bar; b.x = xb_xcc_id(); b.st = st;
  if (__builtin_amdgcn_workitem_id_x() == 0) (void)xb_add(&bar[XB_XCNT(b.x)], 1u);
  return b;
}
DI void xcd_barrier_complete(unsigned* bar, unsigned x, unsigned& nloc, unsigned& nx) {
  const unsigned G = gridDim.x * gridDim.y * gridDim.z;
  unsigned sum, cnt, mine, sp = 0u;
  for (;;) {
    sum = 0u; cnt = 0u; mine = 0u;
#pragma unroll
    for (unsigned j = 0; j < 16; ++j) { const unsigned c = xb_ld(&bar[XB_XCNT(j)]); sum += c; cnt += (c > 0u) ? 1u : 0u; mine = (j == x) ? c : mine; }
    if (sum == G) break;
    __builtin_amdgcn_s_sleep(1);
    if ((++sp & 255u) == 0u) { if (xb_ld(&bar[XB_TMO])) break; if (sp > XB_SPIN_CAP) { atomicAdd(&bar[XB_TMO], 1u); break; } }
  }
  nloc = mine > 0u ? mine : 1u; nx = cnt > 0u ? cnt : 1u;
}
DI void xcd_barrier(const XcdBarrier& b) {
  asm volatile("s_waitcnt vmcnt(0)" ::: "memory");
  __syncthreads();
  if (__builtin_amdgcn_workitem_id_x() == 0) {
    unsigned* bar = b.bar;
    __builtin_amdgcn_s_waitcnt(0);
    unsigned nloc = b.st[0], nx = b.st[1];
    if (nloc == 0u) { xcd_barrier_complete(bar, b.x, nloc, nx); b.st[0] = nloc; b.st[1] = nx; }
    const unsigned old = xb_add(&bar[XB_XSUB(b.x)], 1u);
    const unsigned gen = old / nloc;
    if (old + 1u == (gen + 1u) * nloc) {
      __builtin_amdgcn_fence(__ATOMIC_RELEASE, "agent");
      asm volatile("s_waitcnt vmcnt(0)" ::: "memory");
      const unsigned og = xb_add(&bar[XB_TOP], 1u);
      const unsigned tg = og / nx;
      if (og + 1u == (tg + 1u) * nx) xb_add(&bar[XB_TOPGEN], 1u);
      else XB_SPIN(xb_ld(&bar[XB_TOPGEN]) == tg, bar);
      __builtin_amdgcn_fence(__ATOMIC_ACQUIRE, "agent");
      xb_add(&bar[XB_XGEN(b.x)], 1u);
      asm volatile("s_waitcnt vmcnt(0)" ::: "memory");
    } else {
      XB_SPIN(xb_ld(&bar[XB_XGEN(b.x)]) == gen, bar);
      __builtin_amdgcn_fence(__ATOMIC_ACQUIRE, "agent");
      asm volatile("s_waitcnt vmcnt(0)" ::: "memory");
    }
  }
  __syncthreads();
}
__global__ void __launch_bounds__(256, 2) mega(Params p) {
  __shared__ __attribute__((aligned(16))) char smem[LDS_BYTES];
  __shared__ uint4 xb_words;
  cg::grid_group grid = cg::this_grid();
  if (__builtin_amdgcn_workitem_id_x() == 0) xb_words = make_uint4(0u, 0u, 0u, 0u);
  __syncthreads();
  XcdBarrier xb = xcd_barrier_post((unsigned*)(p.ws + O_BAR), (volatile LAS unsigned*)&xb_words);
  for (int it = 0; it < 2 * NPH; ++it) {
    int itv = it; asm volatile("" : "+v"(itv));
    const int its = __builtin_amdgcn_readfirstlane(itv);
    const int l = its / NPH, ph = its % NPH;
    int bv = blockIdx.x, nv = gridDim.x; asm volatile("" : "+v"(bv), "+v"(nv));
    const int nrep = ((REPMASK >> ph) & 1) ? 2 : 1;
    for (int r = 0; r < nrep; ++r) {
      run_phase(p, l + 16 * r, ph, __builtin_amdgcn_readfirstlane(bv), __builtin_amdgcn_readfirstlane(nv), smem);
      if (it == 0 && r == 0) grid.sync();
      else xcd_barrier(xb);
    }
  }
}
#else
__global__ void __launch_bounds__(256, 2) phase_kernel(Params p, int l, int ph) {
  __shared__ __attribute__((aligned(16))) char smem[LDS_BYTES];
  run_phase(p, l, ph, blockIdx.x, gridDim.x, smem);
}
#endif


#if DBG
DI int dbg_tok(int i) { return i == 0 ? 3 : (i == 1 ? 130 : (i == 2 ? 300 : 16384 + 511)); }
__global__ void __launch_bounds__(256) dbgA_kernel(Params p) {
  const int tid = tidx();
  for (size_t i = (size_t)blockIdx.x * 256 + tid; i < (size_t)T_ * 1024; i += (size_t)gridDim.x * 256) p.out[i] = p.in[I_X][i];
  if (blockIdx.x < 4) {
    const int t = dbg_tok(blockIdx.x);
    bf16_t* d = (bf16_t*)(p.ws + O_LISTS);
    for (int c = tid; c < 1024; c += 256) d[blockIdx.x * 1024 + c] = slab(p, 1)[(size_t)t * 1024 + c];
  }
}
__global__ void __launch_bounds__(256) dbgB_kernel(Params p, int l) {
  __shared__ float sred[256];
  const int tid = tidx();
  const int ti = blockIdx.x >> 2, g = blockIdx.x & 3;
  const int t = dbg_tok(ti), b = t >> 14, ts = t & (S_ - 1);
  const bf16_t* xs = slab(p, 5) + (size_t)b * S_ * 1024; const bf16_t* bc = slab(p, 6) + (size_t)b * S_ * 1024;
  const float* dt = (const float*)(p.ws + O_DT) + (size_t)b * S_ * 16;
  const bf16_t* zsave = (const bf16_t*)(p.ws + O_LISTS);
  const int ch = g * 256 + tid, head = ch >> 6;
  const float a = -__expf(p.in[I_ALOG][l * 16 + head]);
  float y = 0.f;
  for (int n = 0; n < (SSD_PROBE == 1 ? 0 : 128); ++n) {
    float h = 0.f;
    for (int s = 0; s <= ts; ++s) {
      const float d = dt[(size_t)s * 16 + head];
      h = h * __expf(d * a) + d * bf2f(bc[(size_t)s * 1024 + g * 128 + n]) * bf2f(xs[(size_t)s * 1024 + ch]);
    }
    y += bf2f(bc[(size_t)ts * 1024 + 512 + g * 128 + n]) * h;
  }
  y += p.in[I_DSKIP][l * 16 + head] * bf2f(xs[(size_t)ts * 1024 + ch]);
  y *= siluf_(bf2f(zsave[ti * 1024 + ch]));
  sred[tid] = y * y;
  __syncthreads();
  for (int o = 128; o > 0; o >>= 1) { if (tid < o) sred[tid] += sred[tid + o]; __syncthreads(); }
  const float rs = rsqrtf(sred[0] * (1.f / 256.f) + 1e-6f);
  __syncthreads();
  const float ref = DBG == 2 ? y : y * rs * p.in[I_SSDNG][l * 1024 + ch];
  const float mine = bf2f(slab(p, 1)[(size_t)t * 1024 + ch]);
  sred[tid] = fabsf(mine - ref);
  __syncthreads();
  for (int o = 128; o > 0; o >>= 1) { if (tid < o) sred[tid] = fmaxf(sred[tid], sred[tid + o]); __syncthreads(); }
  if (tid == 0) p.out[blockIdx.x] = 1000.f * sred[0] + 100.f;
}
#endif

#if DBG
__global__ void __launch_bounds__(256) dbgS_kernel(Params p, int l) {
  for (size_t i = (size_t)blockIdx.x * 256 + tidx(); i < (size_t)T_ * 1024; i += (size_t)gridDim.x * 256) {
    const int ch = (int)(i & 1023), head = ch >> 6;
    const float xv = bf2f(slab(p, 5)[i]);
    const float zv = bf2f(slab(p, 1)[i]);
    slab(p, 1)[i] = f2bf(xv * p.in[I_DSKIP][l * 16 + head] * siluf_(zv));
  }
}
#endif

extern "C" void kernel_launch(void* const* d_in, const int* in_sizes, int n_in, void* d_out, int out_size, void* d_ws, size_t ws_size,
                              hipStream_t stream) {
  Params p{};
  for (int i = 0; i < 35; ++i) p.in[i] = (const float*)d_in[i];
  p.out = (float*)d_out;
  p.ws = (char*)d_ws;
  if (ws_size < WS_END) { fprintf(stderr, "workspace too small\n"); return; }
#if MULTI
#if DBG
  for (int ph = 0; ph < 11; ++ph) hipLaunchKernelGGL(phase_kernel, dim3(512), dim3(256), 0, stream, p, 0, ph);
  hipLaunchKernelGGL(dbgA_kernel, dim3(512), dim3(256), 0, stream, p);
  hipLaunchKernelGGL(dbgS_kernel, dim3(512), dim3(256), 0, stream, p, 0);
  hipLaunchKernelGGL(dbgB_kernel, dim3(16), dim3(256), 0, stream, p, 0);
#else
  for (int l = 0; l < NLAYERS; ++l)
    for (int ph = 0; ph < (SKIP_PEER ? 22 : NPH); ++ph) hipLaunchKernelGGL(phase_kernel, dim3(512), dim3(256), 0, stream, p, l, ph);
#endif
#else
  static int grid_blocks = 0;
  if (!grid_blocks) {
    int dev = 0, cus = 0, per_cu = 0;
    (void)hipGetDevice(&dev);
    (void)hipDeviceGetAttribute(&cus, hipDeviceAttributeMultiprocessorCount, dev);
    (void)hipOccupancyMaxActiveBlocksPerMultiprocessor(&per_cu, mega, 256, 0);
    if (per_cu > 2) per_cu = 2;
    grid_blocks = cus * per_cu;
  }
  (void)hipMemsetAsync(p.ws + O_BAR, 0, 16384, stream);
  void* args[] = {&p};
  hipError_t e = hipLaunchCooperativeKernel((void*)mega, dim3(grid_blocks), dim3(256), args, 0, stream);
  if (e != hipSuccess) fprintf(stderr, "coop launch failed: %s (grid %d)\n", hipGetErrorString(e), grid_blocks);
#endif
}
```

```cpp
#include <hip/hip_runtime.h>
#include <hip/hip_cooperative_groups.h>
#include <cstdio>
#include <cstdint>
namespace cg = cooperative_groups;
#define DI __device__ __forceinline__
#ifndef MULTI
#define MULTI 0
#endif
#ifndef SKIP_BR
#define SKIP_BR 0
#endif
#ifndef SKIP_PEER
#define SKIP_PEER 0
#ifndef DBG
#define DBG 0
#endif
#ifndef SSD_PROBE
#define SSD_PROBE 0
#endif
#endif
#ifndef REPMASK
#define REPMASK 0
#endif
#ifndef NLAYERS
#define NLAYERS 2
#endif

typedef unsigned short bf16_t;
typedef __attribute__((ext_vector_type(8))) short bf16x8;
typedef __attribute__((ext_vector_type(16))) float f32x16;
typedef __attribute__((ext_vector_type(4))) float f32x4;
typedef __attribute__((ext_vector_type(4))) unsigned u32x4;
typedef __attribute__((ext_vector_type(2))) float f32x2;
#define MFMA32(a, b, c) __builtin_amdgcn_mfma_f32_32x32x16_bf16((a), (b), (c), 0, 0, 0)
#define MFMA16(a, b, c) __builtin_amdgcn_mfma_f32_16x16x32_bf16((a), (b), (c), 0, 0, 0)

constexpr int T_ = 32768, S_ = 16384;
constexpr size_t SLAB = 67108864;
constexpr int LDS_BYTES = 73728;

struct Params { const float* in[35]; float* out; char* ws; };

enum { I_X = 0, I_RELB, I_N1G, I_WIN, I_CONVW, I_CONVB, I_DTB, I_ALOG, I_DSKIP, I_SSDNG, I_QNG, I_KNG, I_MU, I_W0, I_WW2, I_A0,
       I_WA2, I_WG2, I_KK, I_KA, I_RK, I_LNG, I_LNB, I_PSSD, I_PMOBA, I_PRWKV, I_WGATE, I_BGATE, I_WOUT, I_N2G, I_WQ, I_K1, I_K2, I_U, I_V };

constexpr size_t OFF_W = 7 * SLAB;
constexpr size_t O_WIN = OFF_W;
constexpr size_t O_WGATE = O_WIN + 19660800;
constexpr size_t O_PT = O_WGATE + 6291456;
constexpr size_t O_WOUT = O_PT + 6291456;
constexpr size_t O_WQ = O_WOUT + 2097152;
constexpr size_t O_WW2 = O_WQ + 4194304;
constexpr size_t O_WA2 = O_WW2 + 131072;
constexpr size_t O_WG2 = O_WA2 + 131072;
constexpr size_t O_K1 = O_WG2 + 262144;
constexpr size_t O_K2 = O_K1 + 32768;
constexpr size_t OFF_X = O_K2 + 32768;
constexpr size_t O_DT = OFF_X;
constexpr size_t O_LACT = O_DT + 2097152;
constexpr size_t O_RB = O_LACT + 16777216;
constexpr size_t O_CDEC = O_RB + 2097152;
constexpr size_t O_KMEAN = O_CDEC + 16384;
constexpr size_t O_MM = O_KMEAN + 524288;
constexpr size_t O_ML = O_MM + 1048576;
constexpr size_t O_SEL = O_ML + 1048576;
constexpr size_t O_CNT = O_SEL + 3145728;
constexpr size_t O_FILL = O_CNT + 12288;
constexpr size_t O_LISTS = O_FILL + 12288;
constexpr size_t O_BAR = O_LISTS + 3145728;
constexpr size_t WS_END = O_BAR + 16384;

DI bf16_t* slab(const Params& p, int i) { return (bf16_t*)(p.ws + (size_t)i * SLAB); }

DI bf16_t f2bf(float x) { unsigned u = __float_as_uint(x); u += 0x7fffu + ((u >> 16) & 1u); return (bf16_t)(u >> 16); }
DI float bf2f(bf16_t b) { return __uint_as_float(((unsigned)b) << 16); }
DI unsigned pack2(float a, float b) { return (unsigned)f2bf(a) | ((unsigned)f2bf(b) << 16); }
DI float lo16(unsigned u) { return __uint_as_float(u << 16); }
DI float hi16(unsigned u) { return __uint_as_float(u & 0xffff0000u); }
DI bf16_t get16(const uint4& v, int e) { const unsigned w = (e >> 1) == 0 ? v.x : ((e >> 1) == 1 ? v.y : ((e >> 1) == 2 ? v.z : v.w)); return (bf16_t)((e & 1) ? (w >> 16) : (w & 0xffffu)); }
DI void unpack8(const uint4& v, float* f) {
  f[0] = lo16(v.x); f[1] = hi16(v.x); f[2] = lo16(v.y); f[3] = hi16(v.y);
  f[4] = lo16(v.z); f[5] = hi16(v.z); f[6] = lo16(v.w); f[7] = hi16(v.w);
}
DI uint4 pack8(const float* f) { uint4 v; v.x = pack2(f[0], f[1]); v.y = pack2(f[2], f[3]); v.z = pack2(f[4], f[5]); v.w = pack2(f[6], f[7]); return v; }
DI float sigmoidf_(float x) { return 1.f / (1.f + __expf(-x)); }
DI float softplusf_(float x) { return fmaxf(x, 0.f) + log1pf(__expf(-fabsf(x))); }
DI float siluf_(float x) { return x / (1.f + __expf(-x)); }
DI float wave_sum(float v) { for (int o = 32; o > 0; o >>= 1) v += __shfl_xor(v, o); return v; }
template <int CTRL> DI float dpp_add(float x) {
  int y = __builtin_amdgcn_update_dpp(0, __float_as_int(x), CTRL, 0xf, 0xf, true);
  return x + __int_as_float(y);
}
DI float red8(float x) { x = dpp_add<0xB1>(x); x = dpp_add<0x4E>(x); x = dpp_add<0x141>(x); return x; }
DI float red16(float x) { x = red8(x); x = dpp_add<0x140>(x); return x; }
DI int tidx() { int t = __builtin_amdgcn_workitem_id_x(); asm volatile("" : "+v"(t)); return t; }
DI int crow(int i, int h) { return (i & 3) + 8 * (i >> 2) + 4 * h; }

constexpr int LDT = 72;
template <int MI>
DI void gemm_core(const bf16_t* __restrict__ A, int lda, const bf16_t* __restrict__ Bt, int ldb, int K,
                  bf16_t* sA, bf16_t* sB, f32x16 (&acc)[MI][2]) {
  const int tid = tidx(), lane = tid & 63, wave = tid >> 6, wm = wave >> 1, wn = wave & 1;
  u32x4 ra[2 * MI], rb[4];
#pragma unroll
  for (int j = 0; j < 2 * MI; ++j) { const int c = tid + 256 * j; ra[j] = *(const u32x4*)(A + (size_t)(c >> 3) * lda + (c & 7) * 8); }
#pragma unroll
  for (int j = 0; j < 4; ++j) { const int c = tid + 256 * j; rb[j] = *(const u32x4*)(Bt + (size_t)(c >> 3) * ldb + (c & 7) * 8); }
  for (int k0 = 0; k0 < K; k0 += 64) {
#pragma unroll
    for (int j = 0; j < 2 * MI; ++j) { const int c = tid + 256 * j; *(u32x4*)(sA + (c >> 3) * LDT + (c & 7) * 8) = ra[j]; }
#pragma unroll
    for (int j = 0; j < 4; ++j) { const int c = tid + 256 * j; *(u32x4*)(sB + (c >> 3) * LDT + (c & 7) * 8) = rb[j]; }
    __syncthreads();
    const int kn = (k0 + 64 < K) ? k0 + 64 : k0;
#pragma unroll
    for (int j = 0; j < 2 * MI; ++j) { const int c = tid + 256 * j; ra[j] = *(const u32x4*)(A + (size_t)(c >> 3) * lda + kn + (c & 7) * 8); }
#pragma unroll
    for (int j = 0; j < 4; ++j) { const int c = tid + 256 * j; rb[j] = *(const u32x4*)(Bt + (size_t)(c >> 3) * ldb + kn + (c & 7) * 8); }
#pragma unroll
    for (int kk = 0; kk < 4; ++kk) {
      bf16x8 af[MI], bfr[2];
#pragma unroll
      for (int mi = 0; mi < MI; ++mi) af[mi] = *(const bf16x8*)(sA + (wm * 32 * MI + mi * 32 + (lane & 31)) * LDT + kk * 16 + (lane >> 5) * 8);
#pragma unroll
      for (int ni = 0; ni < 2; ++ni) bfr[ni] = *(const bf16x8*)(sB + (wn * 64 + ni * 32 + (lane & 31)) * LDT + kk * 16 + (lane >> 5) * 8);
#pragma unroll
      for (int mi = 0; mi < MI; ++mi)
#pragma unroll
        for (int ni = 0; ni < 2; ++ni) acc[mi][ni] = MFMA32(af[mi], bfr[ni], acc[mi][ni]);
    }
    __syncthreads();
  }
}
template <int MI>
DI void gemm_core_deep(const bf16_t* __restrict__ A, int lda, const bf16_t* __restrict__ Bt, int ldb, int K,
                       bf16_t* sA0, bf16_t* sB0, f32x16 (&acc)[MI][2]) {
  const int tid = tidx(), lane = tid & 63, wave = tid >> 6, wm = wave >> 1, wn = wave & 1;
  constexpr int STAGE = 2 * 128 * LDT;
  u32x4 xa[2 * MI], xb[4], ya[2 * MI], yb[4];
#define G_LOAD(ra, rb, kofs) { \
    _Pragma("unroll") for (int j = 0; j < 2 * MI; ++j) { const int c = tid + 256 * j; ra[j] = *(const u32x4*)(A + (size_t)(c >> 3) * lda + (kofs) + (c & 7) * 8); } \
    _Pragma("unroll") for (int j = 0; j < 4; ++j) { const int c = tid + 256 * j; rb[j] = *(const u32x4*)(Bt + (size_t)(c >> 3) * ldb + (kofs) + (c & 7) * 8); } }
#define S_STORE(ra, rb, stg) { \
    _Pragma("unroll") for (int j = 0; j < 2 * MI; ++j) { const int c = tid + 256 * j; *(u32x4*)(sA0 + (stg) * STAGE + (c >> 3) * LDT + (c & 7) * 8) = ra[j]; } \
    _Pragma("unroll") for (int j = 0; j < 4; ++j) { const int c = tid + 256 * j; *(u32x4*)(sB0 + (stg) * STAGE + (c >> 3) * LDT + (c & 7) * 8) = rb[j]; } }
#define T_COMPUTE(stg) { \
    _Pragma("unroll") for (int kk = 0; kk < 4; ++kk) { \
      bf16x8 af[MI], bfr[2]; \
      _Pragma("unroll") for (int mi = 0; mi < MI; ++mi) af[mi] = *(const bf16x8*)(sA0 + (stg) * STAGE + (wm * 32 * MI + mi * 32 + (lane & 31)) * LDT + kk * 16 + (lane >> 5) * 8); \
      _Pragma("unroll") for (int ni = 0; ni < 2; ++ni) bfr[ni] = *(const bf16x8*)(sB0 + (stg) * STAGE + (wn * 64 + ni * 32 + (lane & 31)) * LDT + kk * 16 + (lane >> 5) * 8); \
      _Pragma("unroll") for (int mi = 0; mi < MI; ++mi) \
      _Pragma("unroll") for (int ni = 0; ni < 2; ++ni) acc[mi][ni] = MFMA32(af[mi], bfr[ni], acc[mi][ni]); } }
  G_LOAD(xa, xb, 0);
  S_STORE(xa, xb, 0);
  __syncthreads();
  G_LOAD(xa, xb, 64);
  G_LOAD(ya, yb, 128);
  for (int k0 = 0; k0 < K; k0 += 128) {
    T_COMPUTE(0);
    S_STORE(xa, xb, 1);
    { const int kn = (k0 + 192 < K) ? k0 + 192 : K - 64; G_LOAD(xa, xb, kn); }
    __syncthreads();
    T_COMPUTE(1);
    S_STORE(ya, yb, 0);
    { const int kn = (k0 + 256 < K) ? k0 + 256 : K - 64; G_LOAD(ya, yb, kn); }
    __syncthreads();
  }
#undef G_LOAD
#undef S_STORE
#undef T_COMPUTE
}
template <int MI> DI void acc_zero(f32x16 (&acc)[MI][2]) {
#pragma unroll
  for (int mi = 0; mi < MI; ++mi)
#pragma unroll
    for (int ni = 0; ni < 2; ++ni)
#pragma unroll
      for (int i = 0; i < 16; ++i) acc[mi][ni][i] = 0.f;
}
DI void tile_remap(int t, int ntm, int nt, int& tm, int& tn) {
  const int x = t & 7, q = t >> 3, per = ntm >> 3;
  const int grp = q / (8 * nt), rem = q - grp * 8 * nt;
  tn = rem >> 3;
  tm = x * per + grp * 8 + (rem & 7);
}
#define ACC_FOREACH(MI, acc, BODY)                                                        \
  {                                                                                       \
    int lane_ = tidx() & 63; asm volatile("" : "+v"(lane_));                        \
    const int wave_ = tidx() >> 6, wm_ = wave_ >> 1, wn_ = wave_ & 1;                \
    _Pragma("unroll") for (int mi = 0; mi < MI; ++mi)                                     \
    _Pragma("unroll") for (int ni = 0; ni < 2; ++ni)                                      \
    _Pragma("unroll") for (int i = 0; i < 16; ++i) {                                      \
      const int r = wm_ * 32 * MI + mi * 32 + crow(i, lane_ >> 5);                        \
      const int c = wn_ * 64 + ni * 32 + (lane_ & 31);                                    \
      const float v = acc[mi][ni][i];                                                       \
      BODY                                                                                \
    }                                                                                     \
  }

DI void tconv_job(const float* __restrict__ src, int ld, int K, int c0, int ncols, bf16_t* __restrict__ dst, int bid, int nb, float* sT) {
  const int ntn = (ncols + 63) >> 6, ntk = K >> 6, tid = tidx();
  for (int t = bid; t < ntn * ntk; t += nb) {
    const int tk = t % ntk, tn = t / ntk;
    const int kr = tid >> 4, nx = (tid & 15) * 4;
#pragma unroll
    for (int j = 0; j < 4; ++j) {
      const int k = kr + 16 * j;
      const float* s = src + (size_t)(tk * 64 + k) * ld + c0 + tn * 64 + nx;
      float4 v;
      if (tn * 64 + nx + 3 < ncols) v = *(const float4*)s;
      else { v.x = (tn * 64 + nx < ncols) ? s[0] : 0.f; v.y = (tn * 64 + nx + 1 < ncols) ? s[1] : 0.f; v.z = (tn * 64 + nx + 2 < ncols) ? s[2] : 0.f; v.w = 0.f; }
      sT[k * 65 + nx] = v.x; sT[k * 65 + nx + 1] = v.y; sT[k * 65 + nx + 2] = v.z; sT[k * 65 + nx + 3] = v.w;
    }
    __syncthreads();
    const int n = tid >> 2, kq = tid & 3;
    if (tn * 64 + n < ncols) {
      float f[16];
#pragma unroll
      for (int j = 0; j < 16; ++j) f[j] = sT[(kq * 16 + j) * 65 + n];
      uint4* d = (uint4*)(dst + (size_t)(tn * 64 + n) * K + tk * 64 + kq * 16);
      d[0] = pack8(f); d[1] = pack8(f + 8);
    }
    __syncthreads();
  }
}
DI void conv_plain(const float* __restrict__ src, bf16_t* __restrict__ dst, size_t n, int bid, int nb) {
  size_t i = ((size_t)bid * 256 + tidx()), st = (size_t)nb * 256;
  for (; i < n / 8; i += st) {
    float4 a = ((const float4*)src)[2 * i], b = ((const float4*)src)[2 * i + 1];
    uint4 o; o.x = pack2(a.x, a.y); o.y = pack2(a.z, a.w); o.z = pack2(b.x, b.y); o.w = pack2(b.z, b.w);
    ((uint4*)dst)[i] = o;
  }
}
DI void conv_fp8(const float* __restrict__ src, unsigned char* __restrict__ dst, size_t n, float scale, int bid, int nb) {
  size_t i = ((size_t)bid * 256 + tidx()), st = (size_t)nb * 256;
  for (; i < n / 16; i += st) {
    const float4* sp = (const float4*)src + 4 * i;
    u32x4 o;
#pragma unroll
    for (int j = 0; j < 4; ++j) {
      const float4 a = sp[j];
      int w = 0;
      w = __builtin_amdgcn_cvt_pk_fp8_f32(a.x * scale, a.y * scale, w, false);
      w = __builtin_amdgcn_cvt_pk_fp8_f32(a.z * scale, a.w * scale, w, true);
      o[j] = (unsigned)w;
    }
    ((u32x4*)dst)[i] = o;
  }
}
DI void rmsnorm_phase(const float* __restrict__ x, const float* __restrict__ g, bf16_t* __restrict__ h, int bid, int nb) {
  const int wave = tidx() >> 6, lane = tidx() & 63;
  for (int row = bid * 4 + wave; row < T_; row += nb * 4) {
    const float4* xr = (const float4*)(x + (size_t)row * 1024);
    float4 v[4]; float ss = 0.f;
#pragma unroll
    for (int j = 0; j < 4; ++j) { v[j] = xr[lane + 64 * j]; ss += v[j].x * v[j].x + v[j].y * v[j].y + v[j].z * v[j].z + v[j].w * v[j].w; }
    ss = wave_sum(ss);
    const float r = rsqrtf(ss * (1.f / 1024.f) + 1e-6f);
#pragma unroll
    for (int j = 0; j < 4; ++j) {
      float4 g4 = ((const float4*)g)[lane + 64 * j];
      uint2 o; o.x = pack2(v[j].x * r * g4.x, v[j].y * r * g4.y); o.y = pack2(v[j].z * r * g4.z, v[j].w * r * g4.w);
      ((uint2*)(h + (size_t)row * 1024))[lane + 64 * j] = o;
    }
  }
}
DI void phase_prep(const Params& p, int l, int bid, int nb, char* smem) {
  float* sT = (float*)smem;
  char* ws = p.ws;
  const float* win = p.in[I_WIN] + (size_t)l * 1024 * 9488;
  bf16_t* wt_in = (bf16_t*)(ws + O_WIN);
  tconv_job(win, 9488, 1024, 0, 3072, wt_in, bid, nb, sT);
  tconv_job(win, 9488, 1024, 3088, 6400, wt_in + (size_t)3072 * 1024, bid, nb, sT);
  tconv_job(win, 9488, 1024, 3072, 16, wt_in + (size_t)9472 * 1024, bid, nb, sT);
  {
    uint4 z = {0, 0, 0, 0};
    uint4* d = (uint4*)(wt_in + (size_t)9488 * 1024);
    for (int i = bid * 256 + tidx(); i < 112 * 1024 / 8; i += nb * 256) d[i] = z;
  }
  tconv_job(p.in[I_WGATE] + (size_t)l * 1024 * 3072, 3072, 1024, 0, 3072, (bf16_t*)(ws + O_WGATE), bid, nb, sT);
  tconv_job(p.in[I_PSSD] + (size_t)l * 1048576, 1024, 1024, 0, 1024, (bf16_t*)(ws + O_PT), bid, nb, sT);
  tconv_job(p.in[I_PMOBA] + (size_t)l * 1048576, 1024, 1024, 0, 1024, (bf16_t*)(ws + O_PT) + 1048576, bid, nb, sT);
  tconv_job(p.in[I_PRWKV] + (size_t)l * 1048576, 1024, 1024, 0, 1024, (bf16_t*)(ws + O_PT) + 2 * 1048576, bid, nb, sT);
  tconv_job(p.in[I_WOUT] + (size_t)l * 1048576, 1024, 1024, 0, 1024, (bf16_t*)(ws + O_WOUT), bid, nb, sT);
  tconv_job(p.in[I_WQ] + (size_t)l * 1024 * 2048, 2048, 1024, 0, 2048, (bf16_t*)(ws + O_WQ), bid, nb, sT);
  tconv_job(p.in[I_WW2] + (size_t)l * 64 * 1024, 1024, 64, 0, 1024, (bf16_t*)(ws + O_WW2), bid, nb, sT);
  tconv_job(p.in[I_WA2] + (size_t)l * 64 * 1024, 1024, 64, 0, 1024, (bf16_t*)(ws + O_WA2), bid, nb, sT);
  tconv_job(p.in[I_WG2] + (size_t)l * 128 * 1024, 1024, 128, 0, 1024, (bf16_t*)(ws + O_WG2), bid, nb, sT);
  conv_plain(p.in[I_K1] + (size_t)l * 16384, (bf16_t*)(ws + O_K1), 16384, bid, nb);
  conv_plain(p.in[I_K2] + (size_t)l * 16384, (bf16_t*)(ws + O_K2), 16384, bid, nb);
  { int* cz = (int*)(ws + O_CNT); for (int i = bid * 256 + tidx(); i < 2 * 3072; i += nb * 256) cz[i] = 0; }
  const float* xin = l == 0 ? p.in[I_X] : p.out;
  rmsnorm_phase(xin, p.in[I_N1G] + l * 1024, slab(p, 0), bid, nb);
}

struct Route { int packed; int seg0; };
DI void gemm_in_phase(const Params& p, int l, const Route rt, int nt, int t0a, int t0b_from, int t0b, int bid, int nb, char* smem) {
  bf16_t* sA = (bf16_t*)smem; bf16_t* sB = sA + 128 * LDT;
  const bf16_t* h = slab(p, 0);
  const bf16_t* wt = (const bf16_t*)(p.ws + O_WIN);
  bf16_t* lora = slab(p, 3); float* dtp = (float*)(p.ws + O_DT); const float* dtb = p.in[I_DTB] + l * 16;
  for (int t = bid; t < 256 * nt; t += nb) {
    int tm, tl; tile_remap(t, 256, nt, tm, tl);
    const int tn = tl < t0b_from ? t0a + tl : t0b + (tl - t0b_from);
    f32x16 acc[2][2]; acc_zero<2>(acc);
    gemm_core_deep<2>(h + (size_t)tm * 128 * 1024, 1024, wt + (size_t)tn * 128 * 1024, 1024, 1024, sA, sB, acc);
    const int row0 = tm * 128, col0 = tn * 128, seg = col0 >> 10;
    if (seg < 9) {
      bf16_t* d = slab(p, (rt.packed >> (4 * (seg - rt.seg0))) & 15) + (size_t)row0 * 1024 + (col0 & 1023);
      ACC_FOREACH(2, acc, { d[(size_t)r * 1024 + c] = f2bf(v); })
    } else {
      const int cc0 = col0 - 9216;
      ACC_FOREACH(2, acc, {
        const int cc = cc0 + c;
        if (cc < 256) lora[(size_t)(row0 + r) * 256 + cc] = f2bf(v);
        else if (cc < 272) dtp[(size_t)(row0 + r) * 16 + (cc - 256)] = softplusf_(v + dtb[cc - 256]);
      })
    }
  }
}

DI void phase_lora_prep(const Params& p, int l, int bid, int nb) {
  const bf16_t* raw = slab(p, 3);
  bf16_t* act = (bf16_t*)(p.ws + O_LACT);
  const float* mu = p.in[I_MU] + l * 3328 + 3072;
  for (int it = bid * 256 + tidx(); it < T_ * 32; it += nb * 256) {
    const int t = it >> 5, c8 = (it & 31) * 8;
    uint4 cur = *(const uint4*)(raw + (size_t)t * 256 + c8);
    uint4 prv = {0, 0, 0, 0};
    if (t & (S_ - 1)) prv = *(const uint4*)(raw + (size_t)(t - 1) * 256 + c8);
    float x[8], xp[8], o[8];
    unpack8(cur, x); unpack8(prv, xp);
#pragma unroll
    for (int e = 0; e < 8; ++e) {
      const int j = c8 + e;
      const float xs = x[e] + (xp[e] - x[e]) * mu[j];
      o[e] = j < 64 ? tanhf(xs) : (j < 128 ? xs : sigmoidf_(xs));
    }
    *(uint4*)(act + (size_t)t * 256 + c8) = pack8(o);
  }
}
template <class F>
DI void gemm_lora_phase(const Params& p, int aoff, int K, const bf16_t* wt, int bid, int nb, char* smem, F epi) {
  bf16_t* sA = (bf16_t*)smem; bf16_t* sB = sA + 128 * LDT;
  const bf16_t* A = (const bf16_t*)(p.ws + O_LACT) + aoff;
  for (int t = bid; t < 256 * 8; t += nb) {
    const int tm = t >> 3, tn = t & 7;
    f32x16 acc[2][2]; acc_zero<2>(acc);
    gemm_core<2>(A + (size_t)tm * 128 * 256, 256, wt + (size_t)tn * 128 * K, K, K, sA, sB, acc);
    const int row0 = tm * 128, col0 = tn * 128;
    ACC_FOREACH(2, acc, { epi(row0 + r, col0 + c, v); })
  }
}
DI void phase_lora_wa(const Params& p, int l, int bid, int nb, char* smem) {
  const float* w0 = p.in[I_W0] + l * 1024; const float* a0 = p.in[I_A0] + l * 1024;
  bf16_t* ew = slab(p, 1); bf16_t* av = slab(p, 2);
  gemm_lora_phase(p, 0, 64, (const bf16_t*)(p.ws + O_WW2), bid, nb, smem, [&](int r, int c, float v) {
    const float wpre = w0[c] + v;
    const float w = -softplusf_(-wpre) - 0.5f;
    ew[(size_t)r * 1024 + c] = f2bf(__expf(w));
  });
  gemm_lora_phase(p, 64, 64, (const bf16_t*)(p.ws + O_WA2), bid, nb, smem, [&](int r, int c, float v) {
    av[(size_t)r * 1024 + c] = f2bf(sigmoidf_(a0[c] + v));
  });
}
DI void phase_rwkv_scan(const Params& p, int l, int bid, int nb, char* smem) {
  float* fbase = (float*)smem;
  constexpr int BUF = 5376;
  const int tid = tidx(), lane = tid & 63, wave = tid >> 6;
  const bf16_t* R = slab(p, 4); const bf16_t* Kx = slab(p, 5); const bf16_t* V = slab(p, 6);
  const bf16_t* EW = slab(p, 1); const bf16_t* AV = slab(p, 2);
  bf16_t* Y = slab(p, 3);
  float* rbout = (float*)(p.ws + O_RB);
  for (int task = bid; task < 256; task += nb) {
    const int qd = task & 7, head = (task >> 3) & 15, b = task >> 7;
    __syncthreads();
    if (wave >= 2) {
      const int st = (tid & 127) >> 3, c8 = tid & 7, ch0 = head * 64 + c8 * 8;
      float mur[8], muk[8], muv[8], ckk[8], cka[8], crk[8];
#pragma unroll
      for (int e = 0; e < 8; ++e) {
        mur[e] = p.in[I_MU][l * 3328 + ch0 + e]; muk[e] = p.in[I_MU][l * 3328 + 1024 + ch0 + e]; muv[e] = p.in[I_MU][l * 3328 + 2048 + ch0 + e];
        ckk[e] = p.in[I_KK][l * 1024 + ch0 + e]; cka[e] = p.in[I_KA][l * 1024 + ch0 + e]; crk[e] = p.in[I_RK][l * 1024 + ch0 + e];
      }
      uint4 gr, gk, gv, gw, ga, gpr, gpk, gpv;
      auto gload = [&](int c) {
        const int ts = c * 16 + st;
        const size_t o = ((size_t)b * S_ + ts) * 1024 + ch0;
        gr = *(const uint4*)(R + o); gk = *(const uint4*)(Kx + o); gv = *(const uint4*)(V + o);
        gw = *(const uint4*)(EW + o); ga = *(const uint4*)(AV + o);
        if (ts > 0) { gpr = *(const uint4*)(R + o - 1024); gpk = *(const uint4*)(Kx + o - 1024); gpv = *(const uint4*)(V + o - 1024); }
        else { gpr = make_uint4(0, 0, 0, 0); gpk = gpr; gpv = gpr; }
      };
      auto stage = [&](int c) {
        float* bufp = fbase + (c & 1) * BUF;
        float* sa = bufp; float* sw = sa + 1024; float* sb = sw + 1024; float* sk = sb + 1024; float* sr = sk + 1024; float* sv = sr + 1024;
        float r[8], k[8], v[8], w[8], a[8], pr[8], pk[8], pv[8];
        unpack8(gr, r); unpack8(gk, k); unpack8(gv, v); unpack8(gw, w); unpack8(ga, a); unpack8(gpr, pr); unpack8(gpk, pk); unpack8(gpv, pv);
        float kk[8], ss = 0.f, rbs = 0.f;
#pragma unroll
        for (int e = 0; e < 8; ++e) {
          r[e] = r[e] + (pr[e] - r[e]) * mur[e];
          k[e] = k[e] + (pk[e] - k[e]) * muk[e];
          v[e] = v[e] + (pv[e] - v[e]) * muv[e];
          kk[e] = k[e] * ckk[e]; ss += kk[e] * kk[e];
        }
        ss = red8(ss);
        const float inv = rsqrtf(fmaxf(ss, 1e-12f));
        float oa[8], ow[8], ob[8], ok[8];
#pragma unroll
        for (int e = 0; e < 8; ++e) {
          kk[e] *= inv;
          ok[e] = k[e] * (1.f + (a[e] - 1.f) * cka[e]);
          oa[e] = -kk[e]; ob[e] = kk[e] * a[e]; ow[e] = __expf(-w[e]);
          rbs += r[e] * ok[e] * crk[e];
        }
        rbs = red8(rbs);
        float* d;
        d = sa + st * 64 + c8 * 8; *(float4*)d = make_float4(oa[0], oa[1], oa[2], oa[3]); *(float4*)(d + 4) = make_float4(oa[4], oa[5], oa[6], oa[7]);
        d = sw + st * 64 + c8 * 8; *(float4*)d = make_float4(ow[0], ow[1], ow[2], ow[3]); *(float4*)(d + 4) = make_float4(ow[4], ow[5], ow[6], ow[7]);
        d = sb + st * 64 + c8 * 8; *(float4*)d = make_float4(ob[0], ob[1], ob[2], ob[3]); *(float4*)(d + 4) = make_float4(ob[4], ob[5], ob[6], ob[7]);
        d = sk + st * 64 + c8 * 8; *(float4*)d = make_float4(ok[0], ok[1], ok[2], ok[3]); *(float4*)(d + 4) = make_float4(ok[4], ok[5], ok[6], ok[7]);
        d = sr + st * 64 + c8 * 8; *(float4*)d = make_float4(r[0], r[1], r[2], r[3]); *(float4*)(d + 4) = make_float4(r[4], r[5], r[6], r[7]);
        if (c8 == qd) { d = sv + st * 8; *(float4*)d = make_float4(v[0], v[1], v[2], v[3]); *(float4*)(d + 4) = make_float4(v[4], v[5], v[6], v[7]); }
        if (qd == 0 && c8 == 0) rbout[((size_t)b * S_ + c * 16 + st) * 16 + head] = rbs;
      };
      auto ywrite = [&](int c) {
        const int j = tid & 127;
        if (j < 16) {
          const float* sy = fbase + (c & 1) * BUF + 5248;
          float f[8];
#pragma unroll
          for (int e = 0; e < 8; ++e) f[e] = sy[j * 8 + e];
          *(uint4*)(Y + ((size_t)b * S_ + c * 16 + j) * 1024 + head * 64 + qd * 8) = pack8(f);
        }
      };
      gload(0);
      stage(0);
      gload(1);
      __syncthreads();
      for (int c = 0; c < 1024; ++c) {
        if (c + 1 < 1024) stage(c + 1);
        if (c + 2 < 1024) gload(c + 2);
        if (c > 0) ywrite(c - 1);
        __syncthreads();
      }
      ywrite(1023);
    } else {
      const int rowl = wave * 4 + (lane >> 4), pp = lane & 15;
      f32x2 st01 = {0.f, 0.f}, st23 = {0.f, 0.f};
      __syncthreads();
      for (int c = 0; c < 1024; ++c) {
        const float* bufp = fbase + (c & 1) * BUF;
        const float* sa = bufp; const float* sw = sa + 1024; const float* sb = sw + 1024; const float* sk = sb + 1024; const float* sr = sk + 1024;
        const float* sv = sr + 1024; float* sy = (float*)sv + 128;
        float yk0 = 0.f;
        f32x4 a4 = *(const f32x4*)(sa + 4 * pp), w4 = *(const f32x4*)(sw + 4 * pp), b4 = *(const f32x4*)(sb + 4 * pp);
        f32x4 k4 = *(const f32x4*)(sk + 4 * pp), r4 = *(const f32x4*)(sr + 4 * pp);
        float vv = sv[rowl];
#pragma unroll
        for (int s = 0; s < 16; ++s) {
          f32x4 a4n = a4, w4n = w4, b4n = b4, k4n = k4, r4n = r4; float vvn = vv;
          if (s + 1 < 16) {
            a4n = *(const f32x4*)(sa + (s + 1) * 64 + 4 * pp); w4n = *(const f32x4*)(sw + (s + 1) * 64 + 4 * pp);
            b4n = *(const f32x4*)(sb + (s + 1) * 64 + 4 * pp); k4n = *(const f32x4*)(sk + (s + 1) * 64 + 4 * pp);
            r4n = *(const f32x4*)(sr + (s + 1) * 64 + 4 * pp); vvn = sv[(s + 1) * 8 + rowl];
          }
          f32x2 t = st01 * a4.xy + st23 * a4.zw;
          const float d = red16(t.x + t.y);
          st01 = st01 * w4.xy + b4.xy * d + k4.xy * vv;
          st23 = st23 * w4.zw + b4.zw * d + k4.zw * vv;
          f32x2 u = st01 * r4.xy + st23 * r4.zw;
          const float y = red16(u.x + u.y);
          yk0 = (pp == s) ? y : yk0;
          a4 = a4n; w4 = w4n; b4 = b4n; k4 = k4n; r4 = r4n; vv = vvn;
        }
        sy[pp * 8 + rowl] = yk0;
        __syncthreads();
      }
    }
  }
}
DI void phase_rwkv_ln(const Params& p, int l, int bid, int nb) {
  bf16_t* Y = slab(p, 3); const bf16_t* V = slab(p, 6);
  const float* rb = (const float*)(p.ws + O_RB);
  const float* lng = p.in[I_LNG] + l * 1024; const float* lnb = p.in[I_LNB] + l * 1024; const float* muv = p.in[I_MU] + l * 3328 + 2048;
  for (int it = bid * 256 + tidx(); it < T_ * 128; it += nb * 256) {
    const int t = it >> 7, c8 = (it & 127) * 8, head = c8 >> 6;
    float y[8], v[8], pv[8], o[8];
    unpack8(*(const uint4*)(Y + (size_t)t * 1024 + c8), y);
    unpack8(*(const uint4*)(V + (size_t)t * 1024 + c8), v);
    uint4 pz = {0, 0, 0, 0};
    if (t & (S_ - 1)) pz = *(const uint4*)(V + (size_t)(t - 1) * 1024 + c8);
    unpack8(pz, pv);
    float s = 0.f;
#pragma unroll
    for (int e = 0; e < 8; ++e) s += y[e];
    s = red8(s);
    const float mean = s * (1.f / 64.f);
    float q = 0.f;
#pragma unroll
    for (int e = 0; e < 8; ++e) { const float d = y[e] - mean; q += d * d; }
    q = red8(q);
    const float rstd = rsqrtf(q * (1.f / 64.f) + 64e-5f);
    const float rbv = rb[(size_t)t * 16 + head];
#pragma unroll
    for (int e = 0; e < 8; ++e) {
      const float vs = v[e] + (pv[e] - v[e]) * muv[c8 + e];
      o[e] = (y[e] - mean) * rstd * lng[c8 + e] + lnb[c8 + e] + rbv * vs;
    }
    *(uint4*)(Y + (size_t)t * 1024 + c8) = pack8(o);
  }
}
DI void phase_rwkv_g(const Params& p, int l, int bid, int nb, char* smem) {
  bf16_t* Y = slab(p, 3);
  gemm_lora_phase(p, 128, 128, (const bf16_t*)(p.ws + O_WG2), bid, nb, smem, [&](int r, int c, float v) {
    const size_t o = (size_t)r * 1024 + c;
    Y[o] = f2bf(bf2f(Y[o]) * v);
  });
}

DI void phase_ssd_conv(const Params& p, int l, int bid, int nb) {
  const bf16_t* rx = slab(p, 2); const bf16_t* rbc = slab(p, 4);
  bf16_t* xs = slab(p, 5); bf16_t* bc = slab(p, 6);
  const float* cw = p.in[I_CONVW] + l * 4 * 2048; const float* cb = p.in[I_CONVB] + l * 2048;
  for (int it = bid * 256 + tidx(); it < T_ * 256; it += nb * 256) {
    const int t = it >> 8, c8 = (it & 255) * 8;
    const bf16_t* src = c8 < 1024 ? rx : rbc; bf16_t* dst = c8 < 1024 ? xs : bc;
    const int cc = c8 & 1023, ts = t & (S_ - 1);
    float acc[8];
#pragma unroll
    for (int e = 0; e < 8; ++e) acc[e] = cb[c8 + e];
#pragma unroll
    for (int k = 0; k < 4; ++k) {
      if (ts - 3 + k >= 0) {
        float x[8]; unpack8(*(const uint4*)(src + (size_t)(t - 3 + k) * 1024 + cc), x);
#pragma unroll
        for (int e = 0; e < 8; ++e) acc[e] += x[e] * cw[k * 2048 + c8 + e];
      }
    }
#pragma unroll
    for (int e = 0; e < 8; ++e) acc[e] = siluf_(acc[e]);
    *(uint4*)(dst + (size_t)t * 1024 + cc) = pack8(acc);
  }
}
DI float* scan128(float* a, float* b) {
  const int tid = tidx();
  float* src = a; float* dst = b;
  for (int off = 1; off < 128; off <<= 1) {
    if (tid < 128) dst[tid] = src[tid] + (tid >= off ? src[tid - off] : 0.f);
    __syncthreads();
    float* t = src; src = dst; dst = t;
  }
  return src;
}
DI void phase_ssd_states(const Params& p, int l, int bid, int nb, char* smem) {
  bf16_t* sXT = (bf16_t*)smem;
  bf16_t* sBT = sXT + 64 * 136;
  float* fa = (float*)(sBT + 128 * 136);
  float* fb = fa + 128; float* fdt = fb + 128;
  const int tid = tidx(), lane = tid & 63, wave = tid >> 6;
  const bf16_t* xs = slab(p, 5); const bf16_t* bc = slab(p, 6);
  const float* dt = (const float*)(p.ws + O_DT);
  float* cdec = (float*)(p.ws + O_CDEC);
  for (int task = bid; task < 4096; task += nb) {
    const int head = task & 15, c = (task >> 4) & 127, b = task >> 11, g = head >> 2;
    const size_t t0 = (size_t)b * S_ + c * 128;
    const float aneg = -__expf(p.in[I_ALOG][l * 16 + head]);
    __syncthreads();
    if (tid < 128) { const float d = dt[(t0 + tid) * 16 + head]; fdt[tid] = d; fa[tid] = d * aneg; }
    __syncthreads();
    float* acs = scan128(fa, fb);
    const float alast = acs[127];
    if (tid == 0) cdec[(b * 128 + c) * 16 + head] = __expf(alast);
#pragma unroll
    for (int j = 0; j < 4; ++j) {
      const int ci = tid + 256 * j, lr = ci >> 3, p8 = (ci & 7) * 8;
      float x[8]; unpack8(*(const uint4*)(xs + (t0 + lr) * 1024 + head * 64 + p8), x);
      const float sc = fdt[lr] * __expf(alast - acs[lr]);
#pragma unroll
      for (int e = 0; e < 8; ++e) sXT[(p8 + e) * 136 + lr] = f2bf(x[e] * sc);
    }
#pragma unroll
    for (int j = 0; j < 8; ++j) {
      const int ci = tid + 256 * j, lr = ci >> 4, n8 = (ci & 15) * 8;
      const uint4 u = *(const uint4*)(bc + (t0 + lr) * 1024 + g * 128 + n8);
#pragma unroll
      for (int e = 0; e < 8; ++e) sBT[(n8 + e) * 136 + lr] = get16(u, e);
    }
    __syncthreads();
    f32x16 acc[2];
#pragma unroll
    for (int mi = 0; mi < 2; ++mi)
#pragma unroll
      for (int i = 0; i < 16; ++i) acc[mi][i] = 0.f;
#pragma unroll
    for (int kk = 0; kk < 8; ++kk) {
      const bf16x8 bf = *(const bf16x8*)(sBT + (wave * 32 + (lane & 31)) * 136 + kk * 16 + (lane >> 5) * 8);
#pragma unroll
      for (int mi = 0; mi < 2; ++mi) {
        const bf16x8 af = *(const bf16x8*)(sXT + (mi * 32 + (lane & 31)) * 136 + kk * 16 + (lane >> 5) * 8);
        acc[mi] = MFMA32(af, bf, acc[mi]);
      }
    }
    float* st = (float*)slab(p, b == 0 ? 2 : 4) + ((size_t)(c * 16 + head) * 64) * 128;
#pragma unroll
    for (int mi = 0; mi < 2; ++mi)
#pragma unroll
      for (int i = 0; i < 16; ++i) st[(size_t)(mi * 32 + crow(i, lane >> 5)) * 128 + wave * 32 + (lane & 31)] = acc[mi][i];
  }
}
DI void phase_ssd_scan(const Params& p, int bid, int nb) {
  const float* cdec = (const float*)(p.ws + O_CDEC);
  for (int it = bid * 256 + tidx(); it < 2 * 16 * 8192; it += nb * 256) {
    const int b = it >> 17, rem = it & 131071, head = rem >> 13;
    float* st = (float*)slab(p, b == 0 ? 2 : 4) + rem;
    float h = 0.f;
#pragma unroll 8
    for (int c = 0; c < 128; ++c) {
      const float s = st[(size_t)c * 131072];
      st[(size_t)c * 131072] = h;
      h = h * cdec[(b * 128 + c) * 16 + head] + s;
    }
  }
}
DI void phase_ssd_out(const Params& p, int l, int bid, int nb, char* smem) {
  bf16_t* sM = (bf16_t*)smem;
  bf16_t* sXT = sM + 128 * 136;
  float* fa = (float*)(sXT + 64 * 136); float* fb = fa + 128; float* fdt = fb + 128; float* frs = fdt + 128;
  const int tid_ = tidx(), lane = tid_ & 63, wave_ = __builtin_amdgcn_readfirstlane(tid_ >> 6), hh_ = lane >> 5, l31_ = lane & 31;
  const bf16_t* xs = slab(p, 5); const bf16_t* bc = slab(p, 6);
  bf16_t* zy = slab(p, 1);
  const float* dt = (const float*)(p.ws + O_DT);
  const float* ng = p.in[I_SSDNG] + l * 1024;
  for (int task = bid; task < 1024; task += nb) {
    const int g = task & 3, c = (task >> 2) & 127, b = task >> 9;
    const size_t t0 = (size_t)b * S_ + c * 128;
    int tid = tid_; asm volatile("" : "+v"(tid));
    __syncthreads();
#pragma unroll 2
    for (int j = 0; j < 8; ++j) {
      const int ci = tid + 256 * j, lr = ci >> 4, n8 = (ci & 15) * 8;
      *(uint4*)(sM + lr * 136 + n8) = *(const uint4*)(bc + (t0 + lr) * 1024 + g * 128 + n8);
    }
    const int wave = wave_, hh = hh_, l31 = l31_;
    const bf16_t* cptr = bc + (t0 + wave * 32 + l31) * 1024 + 512 + g * 128 + hh * 8;
    __syncthreads();
    f32x16 cb[4];
#pragma unroll
    for (int ni = 0; ni < 4; ++ni)
#pragma unroll
      for (int i = 0; i < 16; ++i) cb[ni][i] = 0.f;
#pragma unroll
    for (int kk = 0; kk < 8; ++kk) {
      const bf16x8 cfk = *(const bf16x8*)(cptr + kk * 16);
#pragma unroll
      for (int ni = 0; ni < 4; ++ni) {
        const bf16x8 bf = *(const bf16x8*)(sM + (ni * 32 + l31) * 136 + kk * 16 + hh * 8);
        cb[ni] = MFMA32(cfk, bf, cb[ni]);
      }
    }
    float ssq[16];
#pragma unroll
    for (int i = 0; i < 16; ++i) ssq[i] = 0.f;
#pragma unroll 1
    for (int e = 0; e < 4; ++e) {
      int l31 = l31_, hh = hh_, wave = wave_;
      asm volatile("" : "+v"(l31), "+v"(hh));
      asm volatile("" : "+s"(wave));
      const int head = g * 4 + e;
      const float aneg = -__expf(p.in[I_ALOG][l * 16 + head]);
      const float dsk = p.in[I_DSKIP][l * 16 + head];
      __syncthreads();
      if (tid < 128) { const float d = dt[(t0 + tid) * 16 + head]; fdt[tid] = d; fa[tid] = d * aneg; }
      __syncthreads();
      float* acs = scan128(fa, fb);
#pragma unroll 2
      for (int j = 0; j < 4; ++j) {
        const int ci = tid + 256 * j, lr = ci >> 3, p8 = (ci & 7) * 8;
        const uint4 u = *(const uint4*)(xs + (t0 + lr) * 1024 + head * 64 + p8);
#pragma unroll
        for (int q = 0; q < 8; ++q) sXT[(p8 + q) * 136 + lr] = get16(u, q);
      }
#pragma unroll
      for (int ni = 0; ni < 4; ++ni)
#pragma unroll
        for (int i = 0; i < 16; ++i) {
          const int lr = wave * 32 + crow(i, hh), sc = ni * 32 + l31;
          const float m = sc <= lr ? cb[ni][i] * __expf(acs[lr] - acs[sc]) * fdt[sc] : 0.f;
          sM[lr * 136 + sc] = f2bf(m);
        }
      __syncthreads();
      const float* hin = (const float*)slab(p, b == 0 ? 2 : 4) + ((size_t)(c * 16 + head) * 64) * 128;
#pragma unroll 1
      for (int ni = 0; ni < 2; ++ni) {
        f32x16 yd;
#pragma unroll
        for (int i = 0; i < 16; ++i) yd[i] = 0.f;
#pragma unroll 2
        for (int kk = 0; kk < 8; ++kk) {
          const bf16x8 cfk = *(const bf16x8*)(cptr + kk * 16);
          const float* hp = hin + (size_t)(ni * 32 + l31) * 128 + kk * 16 + hh * 8;
          const float4 h0 = *(const float4*)hp, h1 = *(const float4*)(hp + 4);
          u32x4 u; u.x = pack2(h0.x, h0.y); u.y = pack2(h0.z, h0.w); u.z = pack2(h1.x, h1.y); u.w = pack2(h1.z, h1.w);
          yd = MFMA32(cfk, __builtin_bit_cast(bf16x8, u), yd);
        }
#pragma unroll
        for (int i = 0; i < 16; ++i) yd[i] *= (SSD_PROBE == 2 ? 0.f : __expf(acs[wave * 32 + crow(i, hh)]));
#pragma unroll
        for (int kk = 0; kk < 8; ++kk) {
          const bf16x8 af = *(const bf16x8*)(sM + (wave * 32 + l31) * 136 + kk * 16 + hh * 8);
          const bf16x8 bf = *(const bf16x8*)(sXT + (ni * 32 + l31) * 136 + kk * 16 + hh * 8);
          yd = MFMA32(af, bf, yd);
        }
#pragma unroll
        for (int i = 0; i < 16; ++i) {
          const int lr = wave * 32 + crow(i, hh), pc = ni * 32 + l31;
          const float xv = bf2f(sXT[pc * 136 + lr]);
          float y = (SSD_PROBE == 1 ? 0.f : yd[i]) + xv * dsk;
          const size_t o = (t0 + lr) * 1024 + head * 64 + pc;
          const float zv = bf2f(zy[o]);
          y *= siluf_(zv);
          ssq[i] += y * y;
          zy[o] = f2bf(y);
        }
      }
    }
#pragma unroll
    for (int i = 0; i < 16; ++i) {
      float s = ssq[i];
      for (int o = 16; o > 0; o >>= 1) s += __shfl_xor(s, o);
      if (l31 == 0) frs[wave * 32 + crow(i, hh)] = rsqrtf(s * (1.f / 256.f) + 1e-6f);
    }
    __syncthreads();
#pragma unroll 1
    for (int j = 0; j < (DBG == 2 ? 0 : 16); ++j) {
      const int ci = tid + 256 * j, lr = ci >> 5, c8 = (ci & 31) * 8;
      bf16_t* ptr = zy + (t0 + lr) * 1024 + g * 256 + c8;
      float f[8]; unpack8(*(const uint4*)ptr, f);
      const float rs = frs[lr];
#pragma unroll
      for (int q = 0; q < 8; ++q) f[q] *= rs * ng[g * 256 + c8 + q];
      *(uint4*)ptr = pack8(f);
    }
  }
}

DI void phase_moba_norm(const Params& p, int l, int bid, int nb, char* smem) {
  float* sK = (float*)smem;
  const int tid = tidx(), rg = tid >> 4, ln = tid & 15;
  bf16_t* Q = slab(p, 2); bf16_t* Kx = slab(p, 4);
  float* kmean = (float*)(p.ws + O_KMEAN);
  float qg[8], kg[8];
#pragma unroll
  for (int e = 0; e < 8; ++e) { qg[e] = p.in[I_QNG][l * 128 + ln * 8 + e]; kg[e] = p.in[I_KNG][l * 128 + ln * 8 + e]; }
  for (int task = bid; task < 1024; task += nb) {
    const int blk = task & 63, h = (task >> 6) & 7, b = task >> 9;
    const size_t t0 = (size_t)b * S_ + blk * 256;
    float ks[8];
#pragma unroll
    for (int e = 0; e < 8; ++e) ks[e] = 0.f;
    for (int j = 0; j < 16; ++j) {
      const size_t o = (t0 + rg + 16 * j) * 1024 + h * 128 + ln * 8;
      float f[8]; float ss = 0.f;
      unpack8(*(const uint4*)(Q + o), f);
#pragma unroll
      for (int e = 0; e < 8; ++e) ss += f[e] * f[e];
      ss = red16(ss);
      float r = rsqrtf(ss * (1.f / 128.f) + 1e-6f);
#pragma unroll
      for (int e = 0; e < 8; ++e) f[e] *= r * qg[e];
      *(uint4*)(Q + o) = pack8(f);
      unpack8(*(const uint4*)(Kx + o), f);
      ss = 0.f;
#pragma unroll
      for (int e = 0; e < 8; ++e) ss += f[e] * f[e];
      ss = red16(ss);
      r = rsqrtf(ss * (1.f / 128.f) + 1e-6f);
#pragma unroll
      for (int e = 0; e < 8; ++e) { f[e] *= r * kg[e]; ks[e] += f[e]; }
      *(uint4*)(Kx + o) = pack8(f);
    }
    __syncthreads();
#pragma unroll
    for (int e = 0; e < 8; ++e) sK[rg * 128 + ln * 8 + e] = ks[e];
    __syncthreads();
    if (tid < 128) {
      float s = 0.f;
#pragma unroll
      for (int j = 0; j < 16; ++j) s += sK[j * 128 + tid];
      kmean[((size_t)(b * 8 + h) * 64 + blk) * 128 + tid] = s * (1.f / 256.f);
    }
  }
}
DI void phase_moba_gate(const Params& p, int bid, int nb, char* smem) {
  float* sKm = (float*)smem;
  const int tid = tidx();
  const bf16_t* Q = slab(p, 2);
  const float* kmean = (const float*)(p.ws + O_KMEAN);
  int* sel = (int*)(p.ws + O_SEL); int* cnt = (int*)(p.ws + O_CNT);
  for (int task = bid; task < 1024; task += nb) {
    const int blk = task & 63, h = (task >> 6) & 7, b = task >> 9;
    __syncthreads();
    for (int i = tid; i < blk * 128; i += 256) sKm[i] = kmean[((size_t)(b * 8 + h) * 64) * 128 + i];
    __syncthreads();
    const size_t t = (size_t)b * S_ + blk * 256 + tid;
    float q[128];
#pragma unroll
    for (int j = 0; j < 16; ++j) unpack8(*(const uint4*)(Q + t * 1024 + h * 128 + j * 8), q + j * 8);
    float v0 = -3e38f, v1 = -3e38f, v2 = -3e38f; int i0 = -1, i1 = -1, i2 = -1;
    for (int j = 0; j < blk; ++j) {
      float d = 0.f;
#pragma unroll
      for (int e = 0; e < 128; ++e) d += q[e] * sKm[j * 128 + e];
      if (d > v0) { v2 = v1; i2 = i1; v1 = v0; i1 = i0; v0 = d; i0 = j; }
      else if (d > v1) { v2 = v1; i2 = i1; v1 = d; i1 = j; }
      else if (d > v2) { v2 = d; i2 = j; }
    }
    int* so = sel + (t * 8 + h) * 3;
    so[0] = i0; so[1] = i1; so[2] = i2;
    const int base = (b * 8 + h) * 64;
    if (i0 >= 0) atomicAdd(cnt + 0 * 1024 + base + i0, 1);
    if (i1 >= 0) atomicAdd(cnt + 1 * 1024 + base + i1, 1);
    if (i2 >= 0) atomicAdd(cnt + 2 * 1024 + base + i2, 1);
  }
}
DI void phase_moba_fill(const Params& p, int bid, int nb, char* smem) {
  int* sBase = (int*)smem;
  const int tid = tidx();
  const int* sel = (const int*)(p.ws + O_SEL); const int* cnt = (const int*)(p.ws + O_CNT);
  int* fill = (int*)(p.ws + O_FILL); int* lists = (int*)(p.ws + O_LISTS);
  for (int task = bid; task < 1024; task += nb) {
    const int blk = task & 63, h = (task >> 6) & 7, b = task >> 9;
    const int base = (b * 8 + h) * 64;
    __syncthreads();
    if (tid < 3) { int a = 0; for (int j = 0; j < 64; ++j) { sBase[tid * 64 + j] = a; a += cnt[tid * 1024 + base + j]; } }
    __syncthreads();
    const int ts = blk * 256 + tid;
    const size_t t = (size_t)b * S_ + ts;
    for (int s = 0; s < 3; ++s) {
      const int j = sel[(t * 8 + h) * 3 + s];
      if (j >= 0) {
        const int pos = sBase[s * 64 + j] + atomicAdd(fill + s * 1024 + base + j, 1);
        lists[(size_t)s * (T_ * 8) + (size_t)(b * 8 + h) * S_ + pos] = ts;
      }
    }
  }
}
DI int t5_bucket(int d) {
  if (d < 16) return d;
  const int large = 16 + (int)(__logf((float)d * (1.f / 16.f)) / 4.1588830833596715f * 16.f);
  return large < 31 ? large : 31;
}
struct MobaLds { bf16_t* sK; bf16_t* sVT; float* sBias; };
DI void moba_block(const Params& p, const MobaLds& L, int b, int h, int tsq  , int kb  ,
                   int ntiles, bool causal, bool init) {
  const int tid = tidx(), lane = tid & 63, hh = lane >> 5, l31 = lane & 31;
  const bf16_t* Q = slab(p, 2); const bf16_t* Kx = slab(p, 4); const bf16_t* V = slab(p, 5);
  bf16_t* ACC = slab(p, 6);
  float* MM = (float*)(p.ws + O_MM); float* ML = (float*)(p.ws + O_ML);
  const bool valid = tsq >= 0;
  const size_t tq = (size_t)b * S_ + (valid ? tsq : 0);
  bf16x8 qf[8];
#pragma unroll
  for (int kk = 0; kk < 8; ++kk) {
    uint4 u = {0, 0, 0, 0};
    if (valid) u = *(const uint4*)(Q + tq * 1024 + h * 128 + kk * 16 + hh * 8);
    qf[kk] = __builtin_bit_cast(bf16x8, u);
  }
  float m = -1e30f, lsum = 0.f;
  f32x16 o[4];
#pragma unroll
  for (int dt = 0; dt < 4; ++dt)
#pragma unroll
    for (int i = 0; i < 16; ++i) o[dt][i] = 0.f;
  if (!init && valid) {
    m = MM[tq * 8 + h]; lsum = ML[tq * 8 + h];
#pragma unroll
    for (int dt = 0; dt < 4; ++dt)
#pragma unroll
      for (int g4 = 0; g4 < 4; ++g4) {
        const uint2 u = *(const uint2*)(ACC + tq * 1024 + h * 128 + dt * 32 + g4 * 8 + hh * 4);
        o[dt][g4 * 4 + 0] = lo16(u.x) * lsum; o[dt][g4 * 4 + 1] = hi16(u.x) * lsum;
        o[dt][g4 * 4 + 2] = lo16(u.y) * lsum; o[dt][g4 * 4 + 3] = hi16(u.y) * lsum;
      }
  }
  int wmaxq = valid ? tsq : -1;
  for (int of = 32; of > 0; of >>= 1) wmaxq = max(wmaxq, __shfl_xor(wmaxq, of));
  const float bias31 = L.sBias[1023];
  const float scale = 0.08838834764831845f;
  const size_t k0 = (size_t)b * S_ + (size_t)kb * 256;
  for (int kt = 0; kt < ntiles; ++kt) {
    __syncthreads();
#pragma unroll
    for (int j = 0; j < 4; ++j) {
      const int ci = tid + 256 * j, kr = ci >> 4, d8 = (ci & 15) * 8;
      const size_t go = (k0 + kt * 64 + kr) * 1024 + h * 128 + d8;
      *(uint4*)(L.sK + kr * 136 + d8) = *(const uint4*)(Kx + go);
      const uint4 u = *(const uint4*)(V + go);
#pragma unroll
      for (int e = 0; e < 8; ++e) L.sVT[(d8 + e) * 72 + kr] = get16(u, e);
    }
    __syncthreads();
    const int kpos0 = kb * 256 + kt * 64;
    if (causal && kpos0 > wmaxq) continue;
    f32x16 st[2];
#pragma unroll
    for (int t2 = 0; t2 < 2; ++t2)
#pragma unroll
      for (int i = 0; i < 16; ++i) st[t2][i] = 0.f;
#pragma unroll
    for (int kk = 0; kk < 8; ++kk)
#pragma unroll
      for (int t2 = 0; t2 < 2; ++t2) {
        const bf16x8 af = *(const bf16x8*)(L.sK + (t2 * 32 + l31) * 136 + kk * 16 + hh * 8);
        st[t2] = MFMA32(af, qf[kk], st[t2]);
      }
    float mloc = -1e30f;
#pragma unroll
    for (int t2 = 0; t2 < 2; ++t2)
#pragma unroll
      for (int i = 0; i < 16; ++i) {
        const int kp = kpos0 + t2 * 32 + crow(i, hh);
        const int dist = tsq - kp;
        float s;
        if (causal && dist < 0) s = -1e30f;
        else {
          const int dd = dist < 0 ? 0 : dist;
          s = st[t2][i] * scale + (dd < 1024 ? L.sBias[dd] : bias31);
        }
        st[t2][i] = s;
        mloc = fmaxf(mloc, s);
      }
    mloc = fmaxf(mloc, __shfl_xor(mloc, 32));
    const float mnew = fmaxf(m, mloc);
    const float alpha = __expf(m - mnew);
    float ls = 0.f;
#pragma unroll
    for (int t2 = 0; t2 < 2; ++t2)
#pragma unroll
      for (int i = 0; i < 16; ++i) {
        const float pv = st[t2][i] <= -1e29f ? 0.f : __expf(st[t2][i] - mnew);
        st[t2][i] = pv; ls += pv;
      }
    ls += __shfl_xor(ls, 32);
    lsum = lsum * alpha + ls;
    m = mnew;
#pragma unroll
    for (int dt = 0; dt < 4; ++dt)
#pragma unroll
      for (int i = 0; i < 16; ++i) o[dt][i] *= alpha;
#pragma unroll
    for (int t2 = 0; t2 < 2; ++t2)
#pragma unroll
      for (int s2 = 0; s2 < 2; ++s2) {
        uint4 pu;
        pu.x = pack2(st[t2][8 * s2 + 0], st[t2][8 * s2 + 1]); pu.y = pack2(st[t2][8 * s2 + 2], st[t2][8 * s2 + 3]);
        pu.z = pack2(st[t2][8 * s2 + 4], st[t2][8 * s2 + 5]); pu.w = pack2(st[t2][8 * s2 + 6], st[t2][8 * s2 + 7]);
        const bf16x8 pf = __builtin_bit_cast(bf16x8, pu);
#pragma unroll
        for (int dt = 0; dt < 4; ++dt) {
          const bf16_t* vp = L.sVT + (dt * 32 + l31) * 72 + t2 * 32 + s2 * 16 + hh * 4;
          uint4 vu; const uint2 a0 = *(const uint2*)vp, a1 = *(const uint2*)(vp + 8);
          vu.x = a0.x; vu.y = a0.y; vu.z = a1.x; vu.w = a1.y;
          o[dt] = MFMA32(__builtin_bit_cast(bf16x8, vu), pf, o[dt]);
        }
      }
  }
  if (valid) {
    const float inv = 1.f / lsum;
    if (hh == 0) { MM[tq * 8 + h] = m; ML[tq * 8 + h] = lsum; }
#pragma unroll
    for (int dt = 0; dt < 4; ++dt)
#pragma unroll
      for (int g4 = 0; g4 < 4; ++g4) {
        uint2 u; u.x = pack2(o[dt][g4 * 4] * inv, o[dt][g4 * 4 + 1] * inv); u.y = pack2(o[dt][g4 * 4 + 2] * inv, o[dt][g4 * 4 + 3] * inv);
        *(uint2*)(ACC + tq * 1024 + h * 128 + dt * 32 + g4 * 8 + hh * 4) = u;
      }
  }
}
DI void moba_bias_table(const Params& p, float* sBias, int h) {
  for (int d = tidx(); d < 1024; d += 256) sBias[d] = p.in[I_RELB][t5_bucket(d) * 8 + h];
}
DI void phase_moba_own(const Params& p, int bid, int nb, char* smem) {
  MobaLds L; L.sK = (bf16_t*)smem; L.sVT = L.sK + 64 * 136; L.sBias = (float*)(L.sVT + 128 * 72);
  const int tid = tidx(), lane = tid & 63, wave = tid >> 6;
  for (int task = bid; task < 2048; task += nb) {
    const int qt = task & 1, blk = (task >> 1) & 63, h = (task >> 7) & 7, b = task >> 10;
    __syncthreads();
    moba_bias_table(p, L.sBias, h);
    __syncthreads();
    const int tsq = blk * 256 + qt * 128 + wave * 32 + (lane & 31);
    moba_block(p, L, b, h, tsq, blk, 2 * (qt + 1), true, true);
  }
}
DI void phase_moba_past(const Params& p, int s, int bid, int nb, char* smem) {
  MobaLds L; L.sK = (bf16_t*)smem; L.sVT = L.sK + 64 * 136; L.sBias = (float*)(L.sVT + 128 * 72);
  int* sTb = (int*)(L.sBias + 1024);
  const int tid = tidx(), lane = tid & 63, wave = tid >> 6;
  const int* cnt = (const int*)(p.ws + O_CNT) + s * 1024;
  const int* lists = (const int*)(p.ws + O_LISTS) + (size_t)s * (T_ * 8);
  __syncthreads();
  if (tid < 16) { int a = 0; for (int j = 0; j < 64; ++j) { sTb[tid * 64 + j] = a; a += (cnt[tid * 64 + j] + 127) >> 7; } sTb[1040 + tid] = a; }
  __syncthreads();
  if (tid == 0) { int a = 0; for (int i = 0; i < 16; ++i) { const int c = sTb[1040 + i]; sTb[1040 + i] = a; a += c; } sTb[1056] = a; }
  __syncthreads();
  const int total = sTb[1056];
  for (int task = bid; task < total; task += nb) {
    int gi = 0;
    for (int i = 1; i < 16; ++i) if (sTb[1040 + i] <= task) gi = i;
    const int loc = task - sTb[1040 + gi];
    int j = 0;
    for (int i = 1; i < 64; ++i) if (sTb[gi * 64 + i] <= loc) j = i;
    while (j > 0 && ((cnt[gi * 64 + j] + 127) >> 7) == 0) --j;
    const int tile = loc - sTb[gi * 64 + j];
    const int b = gi >> 3, h = gi & 7;
    __syncthreads();
    moba_bias_table(p, L.sBias, h);
    __syncthreads();
    int lbase = 0;
    for (int i = 0; i < j; ++i) lbase += cnt[gi * 64 + i];
    const int n = cnt[gi * 64 + j];
    const int qi = tile * 128 + wave * 32 + (lane & 31);
    const int tsq = qi < n ? lists[(size_t)gi * S_ + lbase + qi] : -1;
    moba_block(p, L, b, h, tsq, j, 4, false, false);
  }
}

DI void phase_merge(const Params& p, int l, int bid, int nb, char* smem) {
  bf16_t* sA = (bf16_t*)smem; bf16_t* sB = sA + 128 * LDT;
  bf16_t* stash = sB + 128 * LDT;
  const int tid = tidx();
  const bf16_t* h = slab(p, 0);
  const bf16_t* wg = (const bf16_t*)(p.ws + O_WGATE); const bf16_t* pt = (const bf16_t*)(p.ws + O_PT);
  const float* bg = p.in[I_BGATE] + l * 3072;
  bf16_t* mg = slab(p, 2);
  for (int t = bid; t < 512 * 8; t += nb) {
    int tm, tn; tile_remap(t, 512, 8, tm, tn);
    f32x16 accm[1][2]; acc_zero<1>(accm);
    for (int br = 0; br < 3; ++br) {
      if ((SKIP_BR >> br) & 1) continue;
      const bf16_t* yb = slab(p, br == 0 ? 1 : (br == 1 ? 6 : 3));
      f32x16 acc[1][2]; acc_zero<1>(acc);
      gemm_core<1>(h + (size_t)tm * 64 * 1024, 1024, wg + (size_t)(br * 1024 + tn * 128) * 1024, 1024, 1024, sA, sB, acc);
      {
        const float* bgp = bg + br * 1024 + tn * 128;
        ACC_FOREACH(1, acc, { stash[((mi * 2 + ni) * 16 + i) * 256 + tid] = f2bf(sigmoidf_(v + bgp[c])); })
      }
      acc_zero<1>(acc);
      gemm_core<1>(yb + (size_t)tm * 64 * 1024, 1024, pt + (size_t)(br * 1024 + tn * 128) * 1024, 1024, 1024, sA, sB, acc);
      ACC_FOREACH(1, acc, { accm[mi][ni][i] += bf2f(stash[((mi * 2 + ni) * 16 + i) * 256 + tid]) * v; })
    }
    bf16_t* d = mg + (size_t)tm * 64 * 1024 + tn * 128;
    ACC_FOREACH(1, accm, { d[(size_t)r * 1024 + c] = f2bf(v); })
  }
}
DI void phase_wout(const Params& p, int l, int bid, int nb, char* smem) {
  bf16_t* sA = (bf16_t*)smem; bf16_t* sB = sA + 128 * LDT;
  const bf16_t* mg = slab(p, 2); const bf16_t* wo = (const bf16_t*)(p.ws + O_WOUT);
  const float* xin = l == 0 ? p.in[I_X] : p.out;
  for (int t = bid; t < 256 * 8; t += nb) {
    int tm, tn; tile_remap(t, 256, 8, tm, tn);
    f32x16 acc[2][2]; acc_zero<2>(acc);
    gemm_core_deep<2>(mg + (size_t)tm * 128 * 1024, 1024, wo + (size_t)tn * 128 * 1024, 1024, 1024, sA, sB, acc);
    const size_t o0 = (size_t)tm * 128 * 1024 + tn * 128;
    ACC_FOREACH(2, acc, { const size_t o = o0 + (size_t)r * 1024 + c; p.out[o] = xin[o] + v; })
  }
}

DI void phase_peer_prep(const Params& p, int l, int bid, int nb) {
  rmsnorm_phase(p.out, p.in[I_N2G] + l * 1024, slab(p, 0), bid, nb);
  conv_fp8(p.in[I_U] + (size_t)l * 16777216, (unsigned char*)slab(p, 1), 16777216, 64.f, bid, nb);
  conv_fp8(p.in[I_V] + (size_t)l * 16777216, (unsigned char*)slab(p, 1) + 16777216, 16777216, 16.f, bid, nb);
}
DI void phase_peer_q(const Params& p, int bid, int nb, char* smem) {
  bf16_t* sA = (bf16_t*)smem; bf16_t* sB = sA + 128 * LDT;
  const bf16_t* h2 = slab(p, 0); const bf16_t* wq = (const bf16_t*)(p.ws + O_WQ);
  bf16_t* q = slab(p, 2);
  for (int t = bid; t < 256 * 16; t += nb) {
    int tm, tn; tile_remap(t, 256, 16, tm, tn);
    f32x16 acc[2][2]; acc_zero<2>(acc);
    gemm_core_deep<2>(h2 + (size_t)tm * 128 * 1024, 1024, wq + (size_t)tn * 128 * 1024, 1024, 1024, sA, sB, acc);
    bf16_t* d = q + (size_t)tm * 128 * 2048 + tn * 128;
    ACC_FOREACH(2, acc, { d[(size_t)r * 2048 + c] = f2bf(v); })
  }
}
DI unsigned fkey(float f) { unsigned u = __float_as_uint(f); return (u & 0x80000000u) ? ~u : (u | 0x80000000u); }
DI void phase_peer_topk(const Params& p, int bid, int nb, char* smem, int rep) {
  bf16_t* sQ = (bf16_t*)smem;
  float* sS = (float*)smem;
  float* wsc = (float*)(smem + 66560);
  const int tid = tidx(), lane = tid & 63, wave = tid >> 6, wm = wave >> 1, wn = wave & 1, hh = lane >> 5, l31 = lane & 31;
  const bf16_t* q = slab(p, 2);
  const bf16_t* kb = (const bf16_t*)(p.ws + (wn == 0 ? O_K1 : O_K2));
  int* idx_out = (int*)slab(p, 4); float* gate_out = (float*)slab(p, 5);
  float* tv = wsc + wave * 384;
  const unsigned long long ltmask = (1ull << lane) - 1ull;
  for (int task = bid; task < 4096; task += nb) {
    const int hd = task & 7, tt = task >> 3;
    const size_t t0 = (size_t)tt * 64;
    __syncthreads();
#pragma unroll
    for (int j = 0; j < 8; ++j) {
      const int ci = tid + 256 * j, r = ci >> 5, c8 = (ci & 31) * 8;
      *(uint4*)(sQ + r * 264 + c8) = *(const uint4*)(q + (t0 + r) * 2048 + hd * 256 + c8);
    }
    __syncthreads();
    f32x16 acc[4];
#pragma unroll
    for (int ni = 0; ni < 4; ++ni)
#pragma unroll
      for (int i = 0; i < 16; ++i) acc[ni][i] = 0.f;
#pragma unroll
    for (int kk = 0; kk < 8; ++kk) {
      const bf16x8 af = *(const bf16x8*)(sQ + (wm * 32 + l31) * 264 + wn * 128 + kk * 16 + hh * 8);
#pragma unroll
      for (int ni = 0; ni < 4; ++ni) {
        const bf16x8 bf = *(const bf16x8*)(kb + (size_t)(ni * 32 + l31) * 128 + kk * 16 + hh * 8);
        acc[ni] = MFMA32(af, bf, acc[ni]);
      }
    }
    __syncthreads();
#pragma unroll
    for (int ni = 0; ni < 4; ++ni)
#pragma unroll
      for (int i = 0; i < 16; ++i) sS[(wm * 32 + crow(i, hh)) * 260 + wn * 128 + ni * 32 + l31] = acc[ni][i];
    __syncthreads();
#define WAVE_SYNC() do { __builtin_amdgcn_fence(__ATOMIC_RELEASE, "wavefront"); __builtin_amdgcn_wave_barrier(); __builtin_amdgcn_fence(__ATOMIC_ACQUIRE, "wavefront"); } while (0)
    for (int tk = 0; tk < 16; tk += 4) {
      float av[4][4]; unsigned ak[4][4]; unsigned thrA[4], thrB[4];
#pragma unroll
      for (int u = 0; u < 4; ++u) {
        const int r = wave * 16 + tk + u;
#pragma unroll
        for (int q = 0; q < 4; ++q) { av[u][q] = sS[r * 260 + q * 64 + lane]; ak[u][q] = fkey(av[u][q]); }
        thrA[u] = 0; thrB[u] = 0;
      }
      for (int bit = 31; bit >= 0; --bit) {
#pragma unroll
        for (int u = 0; u < 4; ++u) {
          const unsigned ca = thrA[u] | (1u << bit), cb = thrB[u] | (1u << bit);
          const int na = __popcll(__ballot(ak[u][0] >= ca)) + __popcll(__ballot(ak[u][1] >= ca));
          const int nb2 = __popcll(__ballot(ak[u][2] >= cb)) + __popcll(__ballot(ak[u][3] >= cb));
          thrA[u] = na >= 16 ? ca : thrA[u];
          thrB[u] = nb2 >= 16 ? cb : thrB[u];
        }
      }
#pragma unroll
      for (int u = 0; u < 4; ++u) {
        float* tvu = tv + u * 96; int* tiu = (int*)(tvu + 32);
        const unsigned long long q0 = __ballot(ak[u][0] >= thrA[u]), q1 = __ballot(ak[u][1] >= thrA[u]);
        const int p0 = __popcll(q0 & ltmask), p1 = __popcll(q0) + __popcll(q1 & ltmask);
        if (ak[u][0] >= thrA[u] && p0 < 16) { tvu[p0] = av[u][0]; tiu[p0] = lane; }
        if (ak[u][1] >= thrA[u] && p1 < 16) { tvu[p1] = av[u][1]; tiu[p1] = lane + 64; }
        const unsigned long long w0 = __ballot(ak[u][2] >= thrB[u]), w1 = __ballot(ak[u][3] >= thrB[u]);
        const int r0 = __popcll(w0 & ltmask), r1 = __popcll(w0) + __popcll(w1 & ltmask);
        if (ak[u][2] >= thrB[u] && r0 < 16) { tvu[16 + r0] = av[u][2]; tiu[16 + r0] = lane; }
        if (ak[u][3] >= thrB[u] && r1 < 16) { tvu[16 + r1] = av[u][3]; tiu[16 + r1] = lane + 64; }
      }
      WAVE_SYNC();
      float cv[4][4]; unsigned ck[4][4]; unsigned thr[4];
#pragma unroll
      for (int u = 0; u < 4; ++u) {
        const float* tvu = tv + u * 96;
#pragma unroll
        for (int q4 = 0; q4 < 4; ++q4) { const int c = lane + 64 * q4; cv[u][q4] = tvu[c >> 4] + tvu[16 + (c & 15)]; ck[u][q4] = fkey(cv[u][q4]); }
        thr[u] = 0;
      }
      for (int bit = 31; bit >= 0; --bit) {
#pragma unroll
        for (int u = 0; u < 4; ++u) {
          const unsigned cand = thr[u] | (1u << bit);
          const int c = __popcll(__ballot(ck[u][0] >= cand)) + __popcll(__ballot(ck[u][1] >= cand)) + __popcll(__ballot(ck[u][2] >= cand)) + __popcll(__ballot(ck[u][3] >= cand));
          thr[u] = c >= 16 ? cand : thr[u];
        }
      }
#pragma unroll
      for (int u = 0; u < 4; ++u) {
        float* tvu = tv + u * 96; const int* tiu = (const int*)(tvu + 32); float* fvu = tvu + 64; int* fiu = (int*)(tvu + 80);
        int basep = 0;
#pragma unroll
        for (int q4 = 0; q4 < 4; ++q4) {
          const unsigned long long bb = __ballot(ck[u][q4] >= thr[u]);
          const int pos = basep + __popcll(bb & ltmask);
          if (ck[u][q4] >= thr[u] && pos < 16) { const int c = lane + 64 * q4; fvu[pos] = cv[u][q4]; fiu[pos] = tiu[c >> 4] * 128 + tiu[16 + (c & 15)]; }
          basep += __popcll(bb);
        }
      }
      WAVE_SYNC();
      {
        const int u = lane >> 4, e16 = lane & 15;
        const float* fvu = tv + u * 96 + 64; const int* fiu = (const int*)(tv + u * 96 + 80);
        float mx = -3e38f;
#pragma unroll
        for (int e = 0; e < 16; ++e) mx = fmaxf(mx, fvu[e]);
        float sm = 0.f;
#pragma unroll
        for (int e = 0; e < 16; ++e) sm += __expf(fvu[e] - mx);
        const size_t o = ((t0 + wave * 16 + tk + u) * 8 + hd) * 16 + e16;
        idx_out[o] = fiu[e16];
        gate_out[o] = __expf(fvu[e16] - mx) / sm;
      }
      WAVE_SYNC();
    }
  }
}
DI void fp8x16_to_f32(const u32x4& v, float* f) {
#pragma unroll
  for (int j = 0; j < 4; ++j) {
    const f32x2 lo = __builtin_amdgcn_cvt_pk_f32_fp8((int)v[j], false), hi = __builtin_amdgcn_cvt_pk_f32_fp8((int)v[j], true);
    f[4 * j] = lo.x; f[4 * j + 1] = lo.y; f[4 * j + 2] = hi.x; f[4 * j + 3] = hi.y;
  }
}
DI void phase_peer_gather(const Params& p, int bid, int nb, char* smem) {
  const int tid = tidx(), lane = tid & 63, wave = tid >> 6;
  const bf16_t* h2 = slab(p, 0);
  const unsigned char* ub = (const unsigned char*)slab(p, 1); const unsigned char* vb = ub + 16777216;
  const int* idx = (const int*)slab(p, 4); const float* gate = (const float*)slab(p, 5);
  for (int t = bid * 4 + wave; t < T_; t += nb * 4) {
    float h[16];
    unpack8(*(const uint4*)(h2 + (size_t)t * 1024 + lane * 16), h);
    unpack8(*(const uint4*)(h2 + (size_t)t * 1024 + lane * 16 + 8), h + 8);
    const int ia = idx[(size_t)t * 128 + lane], ib = idx[(size_t)t * 128 + 64 + lane];
    float c_lo = 0.f, c_hi = 0.f;
#pragma unroll 1
    for (int g = 0; g < 8; ++g) {
      float part[16];
#pragma unroll
      for (int hf = 0; hf < 2; ++hf) {
        u32x4 rows[8];
#pragma unroll
        for (int j = 0; j < 8; ++j) {
          const int e = g * 16 + hf * 8 + j;
          const int id = __builtin_amdgcn_readlane(g < 4 ? ia : ib, e & 63);
          rows[j] = *(const u32x4*)(ub + (size_t)id * 1024 + lane * 16);
        }
#pragma unroll
        for (int j = 0; j < 8; ++j) {
          float f[16]; fp8x16_to_f32(rows[j], f);
          float a = 0.f;
#pragma unroll
          for (int i = 0; i < 16; ++i) a += h[i] * f[i];
          part[hf * 8 + j] = a;
        }
      }
#pragma unroll
      for (int n = 8, m = 32; n >= 1; n >>= 1, m >>= 1) {
        const bool up = (lane & m) != 0;
#pragma unroll
        for (int i = 0; i < n; ++i) {
          const float keep = up ? part[i + n] : part[i];
          const float send = up ? part[i] : part[i + n];
          part[i] = keep + __shfl_xor(send, m);
        }
      }
      float a = part[0];
      a += __shfl_xor(a, 2);
      a += __shfl_xor(a, 1);
      a *= (1.f / 64.f);
      const float ge = 0.5f * a * (1.f + erff(a * 0.7071067811865476f));
      const float cj = __shfl(ge, 4 * (lane & 15));
      const float cv = cj * gate[(size_t)t * 128 + g * 16 + (lane & 15)];
      const bool mine = (lane >> 4) == (g & 3);
      if (g < 4) c_lo = mine ? cv : c_lo; else c_hi = mine ? cv : c_hi;
    }
    float o[16];
#pragma unroll
    for (int i = 0; i < 16; ++i) o[i] = 0.f;
#pragma unroll 1
    for (int g = 0; g < 16; ++g) {
      u32x4 rows[8];
#pragma unroll
      for (int j = 0; j < 8; ++j) {
        const int e = g * 8 + j;
        const int id = __builtin_amdgcn_readlane(g < 8 ? ia : ib, e & 63);
        rows[j] = *(const u32x4*)(vb + (size_t)id * 1024 + lane * 16);
      }
#pragma unroll
      for (int j = 0; j < 8; ++j) {
        const int e = g * 8 + j;
        const float c = __builtin_bit_cast(float, __builtin_amdgcn_readlane(__builtin_bit_cast(int, g < 8 ? c_lo : c_hi), e & 63));
        float f[16]; fp8x16_to_f32(rows[j], f);
#pragma unroll
        for (int i = 0; i < 16; ++i) o[i] += c * f[i];
      }
    }
    float4* xo = (float4*)(p.out + (size_t)t * 1024 + lane * 16);
#pragma unroll
    for (int q = 0; q < 4; ++q) {
      float4 a = xo[q];
      a.x += o[4 * q] * (1.f / 16.f); a.y += o[4 * q + 1] * (1.f / 16.f); a.z += o[4 * q + 2] * (1.f / 16.f); a.w += o[4 * q + 3] * (1.f / 16.f);
      xo[q] = a;
    }
  }
}

constexpr int NPH = 26;
DI void run_phase(const Params& p, int lrep, int ph, int bid, int nb, char* smem) {
  const int l = lrep & 15, rep = lrep >> 4;
#ifdef ONLY_PH
  ph = ONLY_PH;
#endif
  switch (ph) {
    case 0: phase_prep(p, l, bid, nb, smem); break;
    case 1: {
      Route rt; rt.seg0 = 6; rt.packed = 4 | (5 << 4) | (6 << 8);
      gemm_in_phase(p, l, rt, 26, 48, 26, 0, bid, nb, smem);
    } break;
    case 2: phase_lora_prep(p, l, bid, nb); break;
    case 3: phase_lora_wa(p, l, bid, nb, smem); break;
    case 4: phase_rwkv_scan(p, l, bid, nb, smem); break;
    case 5: phase_rwkv_ln(p, l, bid, nb); break;
    case 6: phase_rwkv_g(p, l, bid, nb, smem); break;
    case 7: {
      Route rt; rt.seg0 = 0; rt.packed = 1 | (2 << 4) | (4 << 8);
      gemm_in_phase(p, l, rt, 25, 0, 24, 74, bid, nb, smem);
    } break;
    case 8: phase_ssd_conv(p, l, bid, nb); break;
    case 9: phase_ssd_states(p, l, bid, nb, smem); break;
    case 10: phase_ssd_scan(p, bid, nb); break;
    case 11: phase_ssd_out(p, l, bid, nb, smem); break;
    case 12: {
      Route rt; rt.seg0 = 3; rt.packed = 2 | (4 << 4) | (5 << 8);
      gemm_in_phase(p, l, rt, 24, 24, 24, 0, bid, nb, smem);
    } break;
    case 13: phase_moba_norm(p, l, bid, nb, smem); break;
    case 14: phase_moba_gate(p, bid, nb, smem); break;
    case 15: phase_moba_fill(p, bid, nb, smem); break;
    case 16: phase_moba_own(p, bid, nb, smem); break;
    case 17: phase_moba_past(p, 0, bid, nb, smem); break;
    case 18: phase_moba_past(p, 1, bid, nb, smem); break;
    case 19: phase_moba_past(p, 2, bid, nb, smem); break;
    case 20: phase_merge(p, l, bid, nb, smem); break;
    case 21: phase_wout(p, l, bid, nb, smem); break;
    case 22: phase_peer_prep(p, l, bid, nb); break;
    case 23: phase_peer_q(p, bid, nb, smem); break;
    case 24: phase_peer_topk(p, bid, nb, smem, rep); break;
    case 25: phase_peer_gather(p, bid, nb, smem); break;
  }
}

#if !MULTI
#define XB_TMO      128
#define XB_XCNT(j)  (256  + 64 * (j))
#define XB_XSUB(j)  (1280 + 64 * (j))
#define XB_XGEN(j)  (2304 + 64 * (j))
#define XB_TOP      3328
#define XB_TOPGEN   3392
#define XCD_BAR_WORDS 3456
#define XB_SPIN_CAP (1u << 22)
#define LAS __attribute__((address_space(3)))
DI unsigned xb_ld(unsigned* p)              { return __hip_atomic_load(p, __ATOMIC_RELAXED, __HIP_MEMORY_SCOPE_AGENT); }
DI unsigned xb_add(unsigned* p, unsigned v) { return __hip_atomic_fetch_add(p, v, __ATOMIC_RELAXED, __HIP_MEMORY_SCOPE_AGENT); }
DI unsigned xb_xcc_id() { return (unsigned)__builtin_amdgcn_s_getreg((3 << 11) | 20) & 0xFu; }
#define XB_SPIN(cond, bar) do { unsigned _sp = 0; while (cond) { __builtin_amdgcn_s_sleep(1); \
    if ((++_sp & 255u) == 0u) { if (xb_ld(&(bar)[XB_TMO])) break; if (_sp > XB_SPIN_CAP) { atomicAdd(&(bar)[XB_TMO], 1u); break; } } } } while (0)
struct XcdBarrier { unsigned* bar; unsigned x; volatile LAS unsigned* st; };
DI XcdBarrier xcd_barrier_post(unsigned* bar, volatile LAS unsigned* st) {
  XcdBarrier b; b.bar = bar; b.x = xb_xcc_id(); b.st = st;
  if (__builtin_amdgcn_workitem_id_x() == 0) (void)xb_add(&bar[XB_XCNT(b.x)], 1u);
  return b;
}
DI void xcd_barrier_complete(unsigned* bar, unsigned x, unsigned& nloc, unsigned& nx) {
  const unsigned G = gridDim.x * gridDim.y * gridDim.z;
  unsigned sum, cnt, mine, sp = 0u;
  for (;;) {
    sum = 0u; cnt = 0u; mine = 0u;
#pragma unroll
    for (unsigned j = 0; j < 16; ++j) { const unsigned c = xb_ld(&bar[XB_XCNT(j)]); sum += c; cnt += (c > 0u) ? 1u : 0u; mine = (j == x) ? c : mine; }
    if (sum == G) break;
    __builtin_amdgcn_s_sleep(1);
    if ((++sp & 255u) == 0u) { if (xb_ld(&bar[XB_TMO])) break; if (sp > XB_SPIN_CAP) { atomicAdd(&bar[XB_TMO], 1u); break; } }
  }
  nloc = mine > 0u ? mine : 1u; nx = cnt > 0u ? cnt : 1u;
}
DI void xcd_barrier(const XcdBarrier& b) {
  asm volatile("s_waitcnt vmcnt(0)" ::: "memory");
  __syncthreads();
  if (__builtin_amdgcn_workitem_id_x() == 0) {
    unsigned* bar = b.bar;
    __builtin_amdgcn_s_waitcnt(0);
    unsigned nloc = b.st[0], nx = b.st[1];
    if (nloc == 0u) { xcd_barrier_complete(bar, b.x, nloc, nx); b.st[0] = nloc; b.st[1] = nx; }
    const unsigned old = xb_add(&bar[XB_XSUB(b.x)], 1u);
    const unsigned gen = old / nloc;
    if (old + 1u == (gen + 1u) * nloc) {
      __builtin_amdgcn_fence(__ATOMIC_RELEASE, "agent");
      asm volatile("s_waitcnt vmcnt(0)" ::: "memory");
      const unsigned og = xb_add(&bar[XB_TOP], 1u);
      const unsigned tg = og / nx;
      if (og + 1u == (tg + 1u) * nx) xb_add(&bar[XB_TOPGEN], 1u);
      else XB_SPIN(xb_ld(&bar[XB_TOPGEN]) == tg, bar);
      __builtin_amdgcn_fence(__ATOMIC_ACQUIRE, "agent");
      xb_add(&bar[XB_XGEN(b.x)], 1u);
      asm volatile("s_waitcnt vmcnt(0)" ::: "memory");
    } else {
      XB_SPIN(xb_ld(&bar[XB_XGEN(b.x)]) == gen, bar);
      __builtin_amdgcn_fence(__ATOMIC_ACQUIRE, "agent");
      asm volatile("s_waitcnt vmcnt(0)" ::: "memory");
    }
  }
  __syncthreads();
}
__global__ void __launch_bounds__(256, 2) mega(Params p) {
  __shared__ __attribute__((aligned(16))) char smem[LDS_BYTES];
  __shared__ uint4 xb_words;
  cg::grid_group grid = cg::this_grid();
  if (__builtin_amdgcn_workitem_id_x() == 0) xb_words = make_uint4(0u, 0u, 0u, 0u);
  __syncthreads();
  XcdBarrier xb = xcd_barrier_post((unsigned*)(p.ws + O_BAR), (volatile LAS unsigned*)&xb_words);
  for (int it = 0; it < 2 * NPH; ++it) {
    int itv = it; asm volatile("" : "+v"(itv));
    const int its = __builtin_amdgcn_readfirstlane(itv);
    const int l = its / NPH, ph = its % NPH;
    int bv = blockIdx.x, nv = gridDim.x; asm volatile("" : "+v"(bv), "+v"(nv));
    const int nrep = ((REPMASK >> ph) & 1) ? 2 : 1;
    for (int r = 0; r < nrep; ++r) {
      run_phase(p, l + 16 * r, ph, __builtin_amdgcn_readfirstlane(bv), __builtin_amdgcn_readfirstlane(nv), smem);
      if (it == 0 && r == 0) grid.sync();
      else xcd_barrier(xb);
    }
  }
}
#else
__global__ void __launch_bounds__(256, 2) phase_kernel(Params p, int l, int ph) {
  __shared__ __attribute__((aligned(16))) char smem[LDS_BYTES];
  run_phase(p, l, ph, blockIdx.x, gridDim.x, smem);
}
#endif


#if DBG
DI int dbg_tok(int i) { return i == 0 ? 3 : (i == 1 ? 130 : (i == 2 ? 300 : 16384 + 511)); }
__global__ void __launch_bounds__(256) dbgA_kernel(Params p) {
  const int tid = tidx();
  for (size_t i = (size_t)blockIdx.x * 256 + tid; i < (size_t)T_ * 1024; i += (size_t)gridDim.x * 256) p.out[i] = p.in[I_X][i];
  if (blockIdx.x < 4) {
    const int t = dbg_tok(blockIdx.x);
    bf16_t* d = (bf16_t*)(p.ws + O_LISTS);
    for (int c = tid; c < 1024; c += 256) d[blockIdx.x * 1024 + c] = slab(p, 1)[(size_t)t * 1024 + c];
  }
}
__global__ void __launch_bounds__(256) dbgB_kernel(Params p, int l) {
  __shared__ float sred[256];
  const int tid = tidx();
  const int ti = blockIdx.x >> 2, g = blockIdx.x & 3;
  const int t = dbg_tok(ti), b = t >> 14, ts = t & (S_ - 1);
  const bf16_t* xs = slab(p, 5) + (size_t)b * S_ * 1024; const bf16_t* bc = slab(p, 6) + (size_t)b * S_ * 1024;
  const float* dt = (const float*)(p.ws + O_DT) + (size_t)b * S_ * 16;
  const bf16_t* zsave = (const bf16_t*)(p.ws + O_LISTS);
  const int ch = g * 256 + tid, head = ch >> 6;
  const float a = -__expf(p.in[I_ALOG][l * 16 + head]);
  float y = 0.f;
  for (int n = 0; n < (SSD_PROBE == 1 ? 0 : 128); ++n) {
    float h = 0.f;
    for (int s = 0; s <= ts; ++s) {
      const float d = dt[(size_t)s * 16 + head];
      h = h * __expf(d * a) + d * bf2f(bc[(size_t)s * 1024 + g * 128 + n]) * bf2f(xs[(size_t)s * 1024 + ch]);
    }
    y += bf2f(bc[(size_t)ts * 1024 + 512 + g * 128 + n]) * h;
  }
  y += p.in[I_DSKIP][l * 16 + head] * bf2f(xs[(size_t)ts * 1024 + ch]);
  y *= siluf_(bf2f(zsave[ti * 1024 + ch]));
  sred[tid] = y * y;
  __syncthreads();
  for (int o = 128; o > 0; o >>= 1) { if (tid < o) sred[tid] += sred[tid + o]; __syncthreads(); }
  const float rs = rsqrtf(sred[0] * (1.f / 256.f) + 1e-6f);
  __syncthreads();
  const float ref = DBG == 2 ? y : y * rs * p.in[I_SSDNG][l * 1024 + ch];
  const float mine = bf2f(slab(p, 1)[(size_t)t * 1024 + ch]);
  sred[tid] = fabsf(mine - ref);
  __syncthreads();
  for (int o = 128; o > 0; o >>= 1) { if (tid < o) sred[tid] = fmaxf(sred[tid], sred[tid + o]); __syncthreads(); }
  if (tid == 0) p.out[blockIdx.x] = 1000.f * sred[0] + 100.f;
}
#endif

#if DBG
__global__ void __launch_bounds__(256) dbgS_kernel(Params p, int l) {
  for (size_t i = (size_t)blockIdx.x * 256 + tidx(); i < (size_t)T_ * 1024; i += (size_t)gridDim.x * 256) {
    const int ch = (int)(i & 1023), head = ch >> 6;
    const float xv = bf2f(slab(p, 5)[i]);
    const float zv = bf2f(slab(p, 1)[i]);
    slab(p, 1)[i] = f2bf(xv * p.in[I_DSKIP][l * 16 + head] * siluf_(zv));
  }
}
#endif

extern "C" void kernel_launch(void* const* d_in, const int* in_sizes, int n_in, void* d_out, int out_size, void* d_ws, size_t ws_size,
                              hipStream_t stream) {
  Params p{};
  for (int i = 0; i < 35; ++i) p.in[i] = (const float*)d_in[i];
  p.out = (float*)d_out;
  p.ws = (char*)d_ws;
  if (ws_size < WS_END) { fprintf(stderr, "workspace too small\n"); return; }
#if MULTI
#if DBG
  for (int ph = 0; ph < 11; ++ph) hipLaunchKernelGGL(phase_kernel, dim3(512), dim3(256), 0, stream, p, 0, ph);
  hipLaunchKernelGGL(dbgA_kernel, dim3(512), dim3(256), 0, stream, p);
  hipLaunchKernelGGL(dbgS_kernel, dim3(512), dim3(256), 0, stream, p, 0);
  hipLaunchKernelGGL(dbgB_kernel, dim3(16), dim3(256), 0, stream, p, 0);
#else
  for (int l = 0; l < NLAYERS; ++l)
    for (int ph = 0; ph < (SKIP_PEER ? 22 : NPH); ++ph) hipLaunchKernelGGL(phase_kernel, dim3(512), dim3(256), 0, stream, p, l, ph);
#endif
#else
  static int grid_blocks = 0;
  if (!grid_blocks) {
    int dev = 0, cus = 0, per_cu = 0;
    (void)hipGetDevice(&dev);
    (void)hipDeviceGetAttribute(&cus, hipDeviceAttributeMultiprocessorCount, dev);
    (void)hipOccupancyMaxActiveBlocksPerMultiprocessor(&per_cu, mega, 256, 0);
    if (per_cu > 2) per_cu = 2;
    grid_blocks = cus * per_cu;
  }
  (void)hipMemsetAsync(p.ws + O_BAR, 0, 16384, stream);
  void* args[] = {&p};
  hipError_t e = hipLaunchCooperativeKernel((void*)mega, dim3(grid_blocks), dim3(256), args, 0, stream);
  if (e != hipSuccess) fprintf(stderr, "coop launch failed: %s (grid %d)\n", hipGetErrorString(e), grid_blocks);
#endif
}
```

```cpp
#include <hip/hip_runtime.h>
#include <hip/hip_cooperative_groups.h>
#include <cstdio>
#include <cstdint>
namespace cg = cooperative_groups;
#define DI __device__ __forceinline__
#ifndef MULTI
#define MULTI 0
#endif
#ifndef SKIP_BR
#define SKIP_BR 0
#endif
#ifndef SKIP_PEER
#define SKIP_PEER 0
#ifndef DBG
#define DBG 0
#endif
#ifndef SSD_PROBE
#define SSD_PROBE 0
#endif
#endif
#ifndef REPMASK
#define REPMASK 0
#endif
#ifndef NLAYERS
#define NLAYERS 2
#endif

typedef unsigned short bf16_t;
typedef __attribute__((ext_vector_type(8))) short bf16x8;
typedef __attribute__((ext_vector_type(16))) float f32x16;
typedef __attribute__((ext_vector_type(4))) float f32x4;
typedef __attribute__((ext_vector_type(4))) unsigned u32x4;
typedef __attribute__((ext_vector_type(2))) float f32x2;
#define MFMA32(a, b, c) __builtin_amdgcn_mfma_f32_32x32x16_bf16((a), (b), (c), 0, 0, 0)
#define MFMA16(a, b, c) __builtin_amdgcn_mfma_f32_16x16x32_bf16((a), (b), (c), 0, 0, 0)

constexpr int T_ = 32768, S_ = 16384;
constexpr size_t SLAB = 67108864;
constexpr int LDS_BYTES = 73728;

struct Params { const float* in[35]; float* out; char* ws; };

enum { I_X = 0, I_RELB, I_N1G, I_WIN, I_CONVW, I_CONVB, I_DTB, I_ALOG, I_DSKIP, I_SSDNG, I_QNG, I_KNG, I_MU, I_W0, I_WW2, I_A0,
       I_WA2, I_WG2, I_KK, I_KA, I_RK, I_LNG, I_LNB, I_PSSD, I_PMOBA, I_PRWKV, I_WGATE, I_BGATE, I_WOUT, I_N2G, I_WQ, I_K1, I_K2, I_U, I_V };

constexpr size_t OFF_W = 7 * SLAB;
constexpr size_t O_WIN = OFF_W;
constexpr size_t O_WGATE = O_WIN + 19660800;
constexpr size_t O_PT = O_WGATE + 6291456;
constexpr size_t O_WOUT = O_PT + 6291456;
constexpr size_t O_WQ = O_WOUT + 2097152;
constexpr size_t O_WW2 = O_WQ + 4194304;
constexpr size_t O_WA2 = O_WW2 + 131072;
constexpr size_t O_WG2 = O_WA2 + 131072;
constexpr size_t O_K1 = O_WG2 + 262144;
constexpr size_t O_K2 = O_K1 + 32768;
constexpr size_t OFF_X = O_K2 + 32768;
constexpr size_t O_DT = OFF_X;
constexpr size_t O_LACT = O_DT + 2097152;
constexpr size_t O_RB = O_LACT + 16777216;
constexpr size_t O_CDEC = O_RB + 2097152;
constexpr size_t O_KMEAN = O_CDEC + 16384;
constexpr size_t O_MM = O_KMEAN + 524288;
constexpr size_t O_ML = O_MM + 1048576;
constexpr size_t O_SEL = O_ML + 1048576;
constexpr size_t O_CNT = O_SEL + 3145728;
constexpr size_t O_FILL = O_CNT + 12288;
constexpr size_t O_LISTS = O_FILL + 12288;
constexpr size_t O_BAR = O_LISTS + 3145728;
constexpr size_t WS_END = O_BAR + 16384;

DI bf16_t* slab(const Params& p, int i) { return (bf16_t*)(p.ws + (size_t)i * SLAB); }

DI bf16_t f2bf(float x) { unsigned u = __float_as_uint(x); u += 0x7fffu + ((u >> 16) & 1u); return (bf16_t)(u >> 16); }
DI float bf2f(bf16_t b) { return __uint_as_float(((unsigned)b) << 16); }
DI unsigned pack2(float a, float b) { return (unsigned)f2bf(a) | ((unsigned)f2bf(b) << 16); }
DI float lo16(unsigned u) { return __uint_as_float(u << 16); }
DI float hi16(unsigned u) { return __uint_as_float(u & 0xffff0000u); }
DI bf16_t get16(const uint4& v, int e) { const unsigned w = (e >> 1) == 0 ? v.x : ((e >> 1) == 1 ? v.y : ((e >> 1) == 2 ? v.z : v.w)); return (bf16_t)((e & 1) ? (w >> 16) : (w & 0xffffu)); }
DI void unpack8(const uint4& v, float* f) {
  f[0] = lo16(v.x); f[1] = hi16(v.x); f[2] = lo16(v.y); f[3] = hi16(v.y);
  f[4] = lo16(v.z); f[5] = hi16(v.z); f[6] = lo16(v.w); f[7] = hi16(v.w);
}
DI uint4 pack8(const float* f) { uint4 v; v.x = pack2(f[0], f[1]); v.y = pack2(f[2], f[3]); v.z = pack2(f[4], f[5]); v.w = pack2(f[6], f[7]); return v; }
DI float sigmoidf_(float x) { return 1.f / (1.f + __expf(-x)); }
DI float softplusf_(float x) { return fmaxf(x, 0.f) + log1pf(__expf(-fabsf(x))); }
DI float siluf_(float x) { return x / (1.f + __expf(-x)); }
DI float wave_sum(float v) { for (int o = 32; o > 0; o >>= 1) v += __shfl_xor(v, o); return v; }
template <int CTRL> DI float dpp_add(float x) {
  int y = __builtin_amdgcn_update_dpp(0, __float_as_int(x), CTRL, 0xf, 0xf, true);
  return x + __int_as_float(y);
}
DI float red8(float x) { x = dpp_add<0xB1>(x); x = dpp_add<0x4E>(x); x = dpp_add<0x141>(x); return x; }
DI float red16(float x) { x = red8(x); x = dpp_add<0x140>(x); return x; }
DI int tidx() { int t = __builtin_amdgcn_workitem_id_x(); asm volatile("" : "+v"(t)); return t; }
DI int crow(int i, int h) { return (i & 3) + 8 * (i >> 2) + 4 * h; }

constexpr int LDT = 72;
template <int MI>
DI void gemm_core(const bf16_t* __restrict__ A, int lda, const bf16_t* __restrict__ Bt, int ldb, int K,
                  bf16_t* sA, bf16_t* sB, f32x16 (&acc)[MI][2]) {
  const int tid = tidx(), lane = tid & 63, wave = tid >> 6, wm = wave >> 1, wn = wave & 1;
  u32x4 ra[2 * MI], rb[4];
#pragma unroll
  for (int j = 0; j < 2 * MI; ++j) { const int c = tid + 256 * j; ra[j] = *(const u32x4*)(A + (size_t)(c >> 3) * lda + (c & 7) * 8); }
#pragma unroll
  for (int j = 0; j < 4; ++j) { const int c = tid + 256 * j; rb[j] = *(const u32x4*)(Bt + (size_t)(c >> 3) * ldb + (c & 7) * 8); }
  for (int k0 = 0; k0 < K; k0 += 64) {
#pragma unroll
    for (int j = 0; j < 2 * MI; ++j) { const int c = tid + 256 * j; *(u32x4*)(sA + (c >> 3) * LDT + (c & 7) * 8) = ra[j]; }
#pragma unroll
    for (int j = 0; j < 4; ++j) { const int c = tid + 256 * j; *(u32x4*)(sB + (c >> 3) * LDT + (c & 7) * 8) = rb[j]; }
    __syncthreads();
    const int kn = (k0 + 64 < K) ? k0 + 64 : k0;
#pragma unroll
    for (int j = 0; j < 2 * MI; ++j) { const int c = tid + 256 * j; ra[j] = *(const u32x4*)(A + (size_t)(c >> 3) * lda + kn + (c & 7) * 8); }
#pragma unroll
    for (int j = 0; j < 4; ++j) { const int c = tid + 256 * j; rb[j] = *(const u32x4*)(Bt + (size_t)(c >> 3) * ldb + kn + (c & 7) * 8); }
#pragma unroll
    for (int kk = 0; kk < 4; ++kk) {
      bf16x8 af[MI], bfr[2];
#pragma unroll
      for (int mi = 0; mi < MI; ++mi) af[mi] = *(const bf16x8*)(sA + (wm * 32 * MI + mi * 32 + (lane & 31)) * LDT + kk * 16 + (lane >> 5) * 8);
#pragma unroll
      for (int ni = 0; ni < 2; ++ni) bfr[ni] = *(const bf16x8*)(sB + (wn * 64 + ni * 32 + (lane & 31)) * LDT + kk * 16 + (lane >> 5) * 8);
#pragma unroll
      for (int mi = 0; mi < MI; ++mi)
#pragma unroll
        for (int ni = 0; ni < 2; ++ni) acc[mi][ni] = MFMA32(af[mi], bfr[ni], acc[mi][ni]);
    }
    __syncthreads();
  }
}
template <int MI>
DI void gemm_core_deep(const bf16_t* __restrict__ A, int lda, const bf16_t* __restrict__ Bt, int ldb, int K,
                       bf16_t* sA0, bf16_t* sB0, f32x16 (&acc)[MI][2]) {
  const int tid = tidx(), lane = tid & 63, wave = tid >> 6, wm = wave >> 1, wn = wave & 1;
  constexpr int STAGE = 2 * 128 * LDT;
  u32x4 xa[2 * MI], xb[4], ya[2 * MI], yb[4];
#define G_LOAD(ra, rb, kofs) { \
    _Pragma("unroll") for (int j = 0; j < 2 * MI; ++j) { const int c = tid + 256 * j; ra[j] = *(const u32x4*)(A + (size_t)(c >> 3) * lda + (kofs) + (c & 7) * 8); } \
    _Pragma("unroll") for (int j = 0; j < 4; ++j) { const int c = tid + 256 * j; rb[j] = *(const u32x4*)(Bt + (size_t)(c >> 3) * ldb + (kofs) + (c & 7) * 8); } }
#define S_STORE(ra, rb, stg) { \
    _Pragma("unroll") for (int j = 0; j < 2 * MI; ++j) { const int c = tid + 256 * j; *(u32x4*)(sA0 + (stg) * STAGE + (c >> 3) * LDT + (c & 7) * 8) = ra[j]; } \
    _Pragma("unroll") for (int j = 0; j < 4; ++j) { const int c = tid + 256 * j; *(u32x4*)(sB0 + (stg) * STAGE + (c >> 3) * LDT + (c & 7) * 8) = rb[j]; } }
#define T_COMPUTE(stg) { \
    _Pragma("unroll") for (int kk = 0; kk < 4; ++kk) { \
      bf16x8 af[MI], bfr[2]; \
      _Pragma("unroll") for (int mi = 0; mi < MI; ++mi) af[mi] = *(const bf16x8*)(sA0 + (stg) * STAGE + (wm * 32 * MI + mi * 32 + (lane & 31)) * LDT + kk * 16 + (lane >> 5) * 8); \
      _Pragma("unroll") for (int ni = 0; ni < 2; ++ni) bfr[ni] = *(const bf16x8*)(sB0 + (stg) * STAGE + (wn * 64 + ni * 32 + (lane & 31)) * LDT + kk * 16 + (lane >> 5) * 8); \
      _Pragma("unroll") for (int mi = 0; mi < MI; ++mi) \
      _Pragma("unroll") for (int ni = 0; ni < 2; ++ni) acc[mi][ni] = MFMA32(af[mi], bfr[ni], acc[mi][ni]); } }
  G_LOAD(xa, xb, 0);
  S_STORE(xa, xb, 0);
  __syncthreads();
  G_LOAD(xa, xb, 64);
  G_LOAD(ya, yb, 128);
  for (int k0 = 0; k0 < K; k0 += 128) {
    T_COMPUTE(0);
    S_STORE(xa, xb, 1);
    { const int kn = (k0 + 192 < K) ? k0 + 192 : K - 64; G_LOAD(xa, xb, kn); }
    __syncthreads();
    T_COMPUTE(1);
    S_STORE(ya, yb, 0);
    { const int kn = (k0 + 256 < K) ? k0 + 256 : K - 64; G_LOAD(ya, yb, kn); }
    __syncthreads();
  }
#undef G_LOAD
#undef S_STORE
#undef T_COMPUTE
}
template <int MI> DI void acc_zero(f32x16 (&acc)[MI][2]) {
#pragma unroll
  for (int mi = 0; mi < MI; ++mi)
#pragma unroll
    for (int ni = 0; ni < 2; ++ni)
#pragma unroll
      for (int i = 0; i < 16; ++i) acc[mi][ni][i] = 0.f;
}
DI void tile_remap(int t, int ntm, int nt, int& tm, int& tn) {
  const int x = t & 7, q = t >> 3, per = ntm >> 3;
  const int grp = q / (8 * nt), rem = q - grp * 8 * nt;
  tn = rem >> 3;
  tm = x * per + grp * 8 + (rem & 7);
}
#define ACC_FOREACH(MI, acc, BODY)                                                        \
  {                                                                                       \
    int lane_ = tidx() & 63; asm volatile("" : "+v"(lane_));                        \
    const int wave_ = tidx() >> 6, wm_ = wave_ >> 1, wn_ = wave_ & 1;                \
    _Pragma("unroll") for (int mi = 0; mi < MI; ++mi)                                     \
    _Pragma("unroll") for (int ni = 0; ni < 2; ++ni)                                      \
    _Pragma("unroll") for (int i = 0; i < 16; ++i) {                                      \
      const int r = wm_ * 32 * MI + mi * 32 + crow(i, lane_ >> 5);                        \
      const int c = wn_ * 64 + ni * 32 + (lane_ & 31);                                    \
      const float v = acc[mi][ni][i];                                                       \
      BODY                                                                                \
    }                                                                                     \
  }

DI void tconv_job(const float* __restrict__ src, int ld, int K, int c0, int ncols, bf16_t* __restrict__ dst, int bid, int nb, float* sT) {
  const int ntn = (ncols + 63) >> 6, ntk = K >> 6, tid = tidx();
  for (int t = bid; t < ntn * ntk; t += nb) {
    const int tk = t % ntk, tn = t / ntk;
    const int kr = tid >> 4, nx = (tid & 15) * 4;
#pragma unroll
    for (int j = 0; j < 4; ++j) {
      const int k = kr + 16 * j;
      const float* s = src + (size_t)(tk * 64 + k) * ld + c0 + tn * 64 + nx;
      float4 v;
      if (tn * 64 + nx + 3 < ncols) v = *(const float4*)s;
      else { v.x = (tn * 64 + nx < ncols) ? s[0] : 0.f; v.y = (tn * 64 + nx + 1 < ncols) ? s[1] : 0.f; v.z = (tn * 64 + nx + 2 < ncols) ? s[2] : 0.f; v.w = 0.f; }
      sT[k * 65 + nx] = v.x; sT[k * 65 + nx + 1] = v.y; sT[k * 65 + nx + 2] = v.z; sT[k * 65 + nx + 3] = v.w;
    }
    __syncthreads();
    const int n = tid >> 2, kq = tid & 3;
    if (tn * 64 + n < ncols) {
      float f[16];
#pragma unroll
      for (int j = 0; j < 16; ++j) f[j] = sT[(kq * 16 + j) * 65 + n];
      uint4* d = (uint4*)(dst + (size_t)(tn * 64 + n) * K + tk * 64 + kq * 16);
      d[0] = pack8(f); d[1] = pack8(f + 8);
    }
    __syncthreads();
  }
}
DI void conv_plain(const float* __restrict__ src, bf16_t* __restrict__ dst, size_t n, int bid, int nb) {
  size_t i = ((size_t)bid * 256 + tidx()), st = (size_t)nb * 256;
  for (; i < n / 8; i += st) {
    float4 a = ((const float4*)src)[2 * i], b = ((const float4*)src)[2 * i + 1];
    uint4 o; o.x = pack2(a.x, a.y); o.y = pack2(a.z, a.w); o.z = pack2(b.x, b.y); o.w = pack2(b.z, b.w);
    ((uint4*)dst)[i] = o;
  }
}
DI void conv_fp8(const float* __restrict__ src, unsigned char* __restrict__ dst, size_t n, float scale, int bid, int nb) {
  size_t i = ((size_t)bid * 256 + tidx()), st = (size_t)nb * 256;
  for (; i < n / 16; i += st) {
    const float4* sp = (const float4*)src + 4 * i;
    u32x4 o;
#pragma unroll
    for (int j = 0; j < 4; ++j) {
      const float4 a = sp[j];
      int w = 0;
      w = __builtin_amdgcn_cvt_pk_fp8_f32(a.x * scale, a.y * scale, w, false);
      w = __builtin_amdgcn_cvt_pk_fp8_f32(a.z * scale, a.w * scale, w, true);
      o[j] = (unsigned)w;
    }
    ((u32x4*)dst)[i] = o;
  }
}
DI void rmsnorm_phase(const float* __restrict__ x, const float* __restrict__ g, bf16_t* __restrict__ h, int bid, int nb) {
  const int wave = tidx() >> 6, lane = tidx() & 63;
  for (int row = bid * 4 + wave; row < T_; row += nb * 4) {
    const float4* xr = (const float4*)(x + (size_t)row * 1024);
    float4 v[4]; float ss = 0.f;
#pragma unroll
    for (int j = 0; j < 4; ++j) { v[j] = xr[lane + 64 * j]; ss += v[j].x * v[j].x + v[j].y * v[j].y + v[j].z * v[j].z + v[j].w * v[j].w; }
    ss = wave_sum(ss);
    const float r = rsqrtf(ss * (1.f / 1024.f) + 1e-6f);
#pragma unroll
    for (int j = 0; j < 4; ++j) {
      float4 g4 = ((const float4*)g)[lane + 64 * j];
      uint2 o; o.x = pack2(v[j].x * r * g4.x, v[j].y * r * g4.y); o.y = pack2(v[j].z * r * g4.z, v[j].w * r * g4.w);
      ((uint2*)(h + (size_t)row * 1024))[lane + 64 * j] = o;
    }
  }
}
DI void phase_prep(const Params& p, int l, int bid, int nb, char* smem) {
  float* sT = (float*)smem;
  char* ws = p.ws;
  const float* win = p.in[I_WIN] + (size_t)l * 1024 * 9488;
  bf16_t* wt_in = (bf16_t*)(ws + O_WIN);
  tconv_job(win, 9488, 1024, 0, 3072, wt_in, bid, nb, sT);
  tconv_job(win, 9488, 1024, 3088, 6400, wt_in + (size_t)3072 * 1024, bid, nb, sT);
  tconv_job(win, 9488, 1024, 3072, 16, wt_in + (size_t)9472 * 1024, bid, nb, sT);
  {
    uint4 z = {0, 0, 0, 0};
    uint4* d = (uint4*)(wt_in + (size_t)9488 * 1024);
    for (int i = bid * 256 + tidx(); i < 112 * 1024 / 8; i += nb * 256) d[i] = z;
  }
  tconv_job(p.in[I_WGATE] + (size_t)l * 1024 * 3072, 3072, 1024, 0, 3072, (bf16_t*)(ws + O_WGATE), bid, nb, sT);
  tconv_job(p.in[I_PSSD] + (size_t)l * 1048576, 1024, 1024, 0, 1024, (bf16_t*)(ws + O_PT), bid, nb, sT);
  tconv_job(p.in[I_PMOBA] + (size_t)l * 1048576, 1024, 1024, 0, 1024, (bf16_t*)(ws + O_PT) + 1048576, bid, nb, sT);
  tconv_job(p.in[I_PRWKV] + (size_t)l * 1048576, 1024, 1024, 0, 1024, (bf16_t*)(ws + O_PT) + 2 * 1048576, bid, nb, sT);
  tconv_job(p.in[I_WOUT] + (size_t)l * 1048576, 1024, 1024, 0, 1024, (bf16_t*)(ws + O_WOUT), bid, nb, sT);
  tconv_job(p.in[I_WQ] + (size_t)l * 1024 * 2048, 2048, 1024, 0, 2048, (bf16_t*)(ws + O_WQ), bid, nb, sT);
  tconv_job(p.in[I_WW2] + (size_t)l * 64 * 1024, 1024, 64, 0, 1024, (bf16_t*)(ws + O_WW2), bid, nb, sT);
  tconv_job(p.in[I_WA2] + (size_t)l * 64 * 1024, 1024, 64, 0, 1024, (bf16_t*)(ws + O_WA2), bid, nb, sT);
  tconv_job(p.in[I_WG2] + (size_t)l * 128 * 1024, 1024, 128, 0, 1024, (bf16_t*)(ws + O_WG2), bid, nb, sT);
  conv_plain(p.in[I_K1] + (size_t)l * 16384, (bf16_t*)(ws + O_K1), 16384, bid, nb);
  conv_plain(p.in[I_K2] + (size_t)l * 16384, (bf16_t*)(ws + O_K2), 16384, bid, nb);
  { int* cz = (int*)(ws + O_CNT); for (int i = bid * 256 + tidx(); i < 2 * 3072; i += nb * 256) cz[i] = 0; }
  const float* xin = l == 0 ? p.in[I_X] : p.out;
  rmsnorm_phase(xin, p.in[I_N1G] + l * 1024, slab(p, 0), bid, nb);
}

struct Route { int packed; int seg0; };
DI void gemm_in_phase(const Params& p, int l, const Route rt, int nt, int t0a, int t0b_from, int t0b, int bid, int nb, char* smem) {
  bf16_t* sA = (bf16_t*)smem; bf16_t* sB = sA + 128 * LDT;
  const bf16_t* h = slab(p, 0);
  const bf16_t* wt = (const bf16_t*)(p.ws + O_WIN);
  bf16_t* lora = slab(p, 3); float* dtp = (float*)(p.ws + O_DT); const float* dtb = p.in[I_DTB] + l * 16;
  for (int t = bid; t < 256 * nt; t += nb) {
    int tm, tl; tile_remap(t, 256, nt, tm, tl);
    const int tn = tl < t0b_from ? t0a + tl : t0b + (tl - t0b_from);
    f32x16 acc[2][2]; acc_zero<2>(acc);
    gemm_core_deep<2>(h + (size_t)tm * 128 * 1024, 1024, wt + (size_t)tn * 128 * 1024, 1024, 1024, sA, sB, acc);
    const int row0 = tm * 128, col0 = tn * 128, seg = col0 >> 10;
    if (seg < 9) {
      bf16_t* d = slab(p, (rt.packed >> (4 * (seg - rt.seg0))) & 15) + (size_t)row0 * 1024 + (col0 & 1023);
      ACC_FOREACH(2, acc, { d[(size_t)r * 1024 + c] = f2bf(v); })
    } else {
      const int cc0 = col0 - 9216;
      ACC_FOREACH(2, acc, {
        const int cc = cc0 + c;
        if (cc < 256) lora[(size_t)(row0 + r) * 256 + cc] = f2bf(v);
        else if (cc < 272) dtp[(size_t)(row0 + r) * 16 + (cc - 256)] = softplusf_(v + dtb[cc - 256]);
      })
    }
  }
}

DI void phase_lora_prep(const Params& p, int l, int bid, int nb) {
  const bf16_t* raw = slab(p, 3);
  bf16_t* act = (bf16_t*)(p.ws + O_LACT);
  const float* mu = p.in[I_MU] + l * 3328 + 3072;
  for (int it = bid * 256 + tidx(); it < T_ * 32; it += nb * 256) {
    const int t = it >> 5, c8 = (it & 31) * 8;
    uint4 cur = *(const uint4*)(raw + (size_t)t * 256 + c8);
    uint4 prv = {0, 0, 0, 0};
    if (t & (S_ - 1)) prv = *(const uint4*)(raw + (size_t)(t - 1) * 256 + c8);
    float x[8], xp[8], o[8];
    unpack8(cur, x); unpack8(prv, xp);
#pragma unroll
    for (int e = 0; e < 8; ++e) {
      const int j = c8 + e;
      const float xs = x[e] + (xp[e] - x[e]) * mu[j];
      o[e] = j < 64 ? tanhf(xs) : (j < 128 ? xs : sigmoidf_(xs));
    }
    *(uint4*)(act + (size_t)t * 256 + c8) = pack8(o);
  }
}
template <class F>
DI void gemm_lora_phase(const Params& p, int aoff, int K, const bf16_t* wt, int bid, int nb, char* smem, F epi) {
  bf16_t* sA = (bf16_t*)smem; bf16_t* sB = sA + 128 * LDT;
  const bf16_t* A = (const bf16_t*)(p.ws + O_LACT) + aoff;
  for (int t = bid; t < 256 * 8; t += nb) {
    const int tm = t >> 3, tn = t & 7;
    f32x16 acc[2][2]; acc_zero<2>(acc);
    gemm_core<2>(A + (size_t)tm * 128 * 256, 256, wt + (size_t)tn * 128 * K, K, K, sA, sB, acc);
    const int row0 = tm * 128, col0 = tn * 128;
    ACC_FOREACH(2, acc, { epi(row0 + r, col0 + c, v); })
  }
}
DI void phase_lora_wa(const Params& p, int l, int bid, int nb, char* smem) {
  const float* w0 = p.in[I_W0] + l * 1024; const float* a0 = p.in[I_A0] + l * 1024;
  bf16_t* ew = slab(p, 1); bf16_t* av = slab(p, 2);
  gemm_lora_phase(p, 0, 64, (const bf16_t*)(p.ws + O_WW2), bid, nb, smem, [&](int r, int c, float v) {
    const float wpre = w0[c] + v;
    const float w = -softplusf_(-wpre) - 0.5f;
    ew[(size_t)r * 1024 + c] = f2bf(__expf(w));
  });
  gemm_lora_phase(p, 64, 64, (const bf16_t*)(p.ws + O_WA2), bid, nb, smem, [&](int r, int c, float v) {
    av[(size_t)r * 1024 + c] = f2bf(sigmoidf_(a0[c] + v));
  });
}
DI void phase_rwkv_scan(const Params& p, int l, int bid, int nb, char* smem) {
  float* fbase = (float*)smem;
  constexpr int BUF = 5376;
  const int tid = tidx(), lane = tid & 63, wave = tid >> 6;
  const bf16_t* R = slab(p, 4); const bf16_t* Kx = slab(p, 5); const bf16_t* V = slab(p, 6);
  const bf16_t* EW = slab(p, 1); const bf16_t* AV = slab(p, 2);
  bf16_t* Y = slab(p, 3);
  float* rbout = (float*)(p.ws + O_RB);
  for (int task = bid; task < 256; task += nb) {
    const int qd = task & 7, head = (task >> 3) & 15, b = task >> 7;
    __syncthreads();
    if (wave >= 2) {
      const int st = (tid & 127) >> 3, c8 = tid & 7, ch0 = head * 64 + c8 * 8;
      float mur[8], muk[8], muv[8], ckk[8], cka[8], crk[8];
#pragma unroll
      for (int e = 0; e < 8; ++e) {
        mur[e] = p.in[I_MU][l * 3328 + ch0 + e]; muk[e] = p.in[I_MU][l * 3328 + 1024 + ch0 + e]; muv[e] = p.in[I_MU][l * 3328 + 2048 + ch0 + e];
        ckk[e] = p.in[I_KK][l * 1024 + ch0 + e]; cka[e] = p.in[I_KA][l * 1024 + ch0 + e]; crk[e] = p.in[I_RK][l * 1024 + ch0 + e];
      }
      uint4 gr, gk, gv, gw, ga, gpr, gpk, gpv;
      auto gload = [&](int c) {
        const int ts = c * 16 + st;
        const size_t o = ((size_t)b * S_ + ts) * 1024 + ch0;
        gr = *(const uint4*)(R + o); gk = *(const uint4*)(Kx + o); gv = *(const uint4*)(V + o);
        gw = *(const uint4*)(EW + o); ga = *(const uint4*)(AV + o);
        if (ts > 0) { gpr = *(const uint4*)(R + o - 1024); gpk = *(const uint4*)(Kx + o - 1024); gpv = *(const uint4*)(V + o - 1024); }
        else { gpr = make_uint4(0, 0, 0, 0); gpk = gpr; gpv = gpr; }
      };
      auto stage = [&](int c) {
        float* bufp = fbase + (c & 1) * BUF;
        float* sa = bufp; float* sw = sa + 1024; float* sb = sw + 1024; float* sk = sb + 1024; float* sr = sk + 1024; float* sv = sr + 1024;
        float r[8], k[8], v[8], w[8], a[8], pr[8], pk[8], pv[8];
        unpack8(gr, r); unpack8(gk, k); unpack8(gv, v); unpack8(gw, w); unpack8(ga, a); unpack8(gpr, pr); unpack8(gpk, pk); unpack8(gpv, pv);
        float kk[8], ss = 0.f, rbs = 0.f;
#pragma unroll
        for (int e = 0; e < 8; ++e) {
          r[e] = r[e] + (pr[e] - r[e]) * mur[e];
          k[e] = k[e] + (pk[e] - k[e]) * muk[e];
          v[e] = v[e] + (pv[e] - v[e]) * muv[e];
          kk[e] = k[e] * ckk[e]; ss += kk[e] * kk[e];
        }
        ss = red8(ss);
        const float inv = rsqrtf(fmaxf(ss, 1e-12f));
        float oa[8], ow[8], ob[8], ok[8];
#pragma unroll
        for (int e = 0; e < 8; ++e) {
          kk[e] *= inv;
          ok[e] = k[e] * (1.f + (a[e] - 1.f) * cka[e]);
          oa[e] = -kk[e]; ob[e] = kk[e] * a[e]; ow[e] = __expf(-w[e]);
          rbs += r[e] * ok[e] * crk[e];
        }
        rbs = red8(rbs);
        float* d;
        d = sa + st * 64 + c8 * 8; *(float4*)d = make_float4(oa[0], oa[1], oa[2], oa[3]); *(float4*)(d + 4) = make_float4(oa[4], oa[5], oa[6], oa[7]);
        d = sw + st * 64 + c8 * 8; *(float4*)d = make_float4(ow[0], ow[1], ow[2], ow[3]); *(float4*)(d + 4) = make_float4(ow[4], ow[5], ow[6], ow[7]);
        d = sb + st * 64 + c8 * 8; *(float4*)d = make_float4(ob[0], ob[1], ob[2], ob[3]); *(float4*)(d + 4) = make_float4(ob[4], ob[5], ob[6], ob[7]);
        d = sk + st * 64 + c8 * 8; *(float4*)d = make_float4(ok[0], ok[1], ok[2], ok[3]); *(float4*)(d + 4) = make_float4(ok[4], ok[5], ok[6], ok[7]);
        d = sr + st * 64 + c8 * 8; *(float4*)d = make_float4(r[0], r[1], r[2], r[3]); *(float4*)(d + 4) = make_float4(r[4], r[5], r[6], r[7]);
        if (c8 == qd) { d = sv + st * 8; *(float4*)d = make_float4(v[0], v[1], v[2], v[3]); *(float4*)(d + 4) = make_float4(v[4], v[5], v[6], v[7]); }
        if (qd == 0 && c8 == 0) rbout[((size_t)b * S_ + c * 16 + st) * 16 + head] = rbs;
      };
      auto ywrite = [&](int c) {
        const int j = tid & 127;
        if (j < 16) {
          const float* sy = fbase + (c & 1) * BUF + 5248;
          float f[8];
#pragma unroll
          for (int e = 0; e < 8; ++e) f[e] = sy[j * 8 + e];
          *(uint4*)(Y + ((size_t)b * S_ + c * 16 + j) * 1024 + head * 64 + qd * 8) = pack8(f);
        }
      };
      gload(0);
      stage(0);
      gload(1);
      __syncthreads();
      for (int c = 0; c < 1024; ++c) {
        if (c + 1 < 1024) stage(c + 1);
        if (c + 2 < 1024) gload(c + 2);
        if (c > 0) ywrite(c - 1);
        __syncthreads();
      }
      ywrite(1023);
    } else {
      const int rowl = wave * 4 + (lane >> 4), pp = lane & 15;
      f32x2 st01 = {0.f, 0.f}, st23 = {0.f, 0.f};
      __syncthreads();
      for (int c = 0; c < 1024; ++c) {
        const float* bufp = fbase + (c & 1) * BUF;
        const float* sa = bufp; const float* sw = sa + 1024; const float* sb = sw + 1024; const float* sk = sb + 1024; const float* sr = sk + 1024;
        const float* sv = sr + 1024; float* sy = (float*)sv + 128;
        float yk0 = 0.f;
        f32x4 a4 = *(const f32x4*)(sa + 4 * pp), w4 = *(const f32x4*)(sw + 4 * pp), b4 = *(const f32x4*)(sb + 4 * pp);
        f32x4 k4 = *(const f32x4*)(sk + 4 * pp), r4 = *(const f32x4*)(sr + 4 * pp);
        float vv = sv[rowl];
#pragma unroll
        for (int s = 0; s < 16; ++s) {
          f32x4 a4n = a4, w4n = w4, b4n = b4, k4n = k4, r4n = r4; float vvn = vv;
          if (s + 1 < 16) {
            a4n = *(const f32x4*)(sa + (s + 1) * 64 + 4 * pp); w4n = *(const f32x4*)(sw + (s + 1) * 64 + 4 * pp);
            b4n = *(const f32x4*)(sb + (s + 1) * 64 + 4 * pp); k4n = *(const f32x4*)(sk + (s + 1) * 64 + 4 * pp);
            r4n = *(const f32x4*)(sr + (s + 1) * 64 + 4 * pp); vvn = sv[(s + 1) * 8 + rowl];
          }
          f32x2 t = st01 * a4.xy + st23 * a4.zw;
          const float d = red16(t.x + t.y);
          st01 = st01 * w4.xy + b4.xy * d + k4.xy * vv;
          st23 = st23 * w4.zw + b4.zw * d + k4.zw * vv;
          f32x2 u = st01 * r4.xy + st23 * r4.zw;
          const float y = red16(u.x + u.y);
          yk0 = (pp == s) ? y : yk0;
          a4 = a4n; w4 = w4n; b4 = b4n; k4 = k4n; r4 = r4n; vv = vvn;
        }
        sy[pp * 8 + rowl] = yk0;
        __syncthreads();
      }
    }
  }
}
DI void phase_rwkv_ln(const Params& p, int l, int bid, int nb) {
  bf16_t* Y = slab(p, 3); const bf16_t* V = slab(p, 6);
  const float* rb = (const float*)(p.ws + O_RB);
  const float* lng = p.in[I_LNG] + l * 1024; const float* lnb = p.in[I_LNB] + l * 1024; const float* muv = p.in[I_MU] + l * 3328 + 2048;
  for (int it = bid * 256 + tidx(); it < T_ * 128; it += nb * 256) {
    const int t = it >> 7, c8 = (it & 127) * 8, head = c8 >> 6;
    float y[8], v[8], pv[8], o[8];
    unpack8(*(const uint4*)(Y + (size_t)t * 1024 + c8), y);
    unpack8(*(const uint4*)(V + (size_t)t * 1024 + c8), v);
    uint4 pz = {0, 0, 0, 0};
    if (t & (S_ - 1)) pz = *(const uint4*)(V + (size_t)(t - 1) * 1024 + c8);
    unpack8(pz, pv);
    float s = 0.f;
#pragma unroll
    for (int e = 0; e < 8; ++e) s += y[e];
    s = red8(s);
    const float mean = s * (1.f / 64.f);
    float q = 0.f;
#pragma unroll
    for (int e = 0; e < 8; ++e) { const float d = y[e] - mean; q += d * d; }
    q = red8(q);
    const float rstd = rsqrtf(q * (1.f / 64.f) + 64e-5f);
    const float rbv = rb[(size_t)t * 16 + head];
#pragma unroll
    for (int e = 0; e < 8; ++e) {
      const float vs = v[e] + (pv[e] - v[e]) * muv[c8 + e];
      o[e] = (y[e] - mean) * rstd * lng[c8 + e] + lnb[c8 + e] + rbv * vs;
    }
    *(uint4*)(Y + (size_t)t * 1024 + c8) = pack8(o);
  }
}
DI void phase_rwkv_g(const Params& p, int l, int bid, int nb, char* smem) {
  bf16_t* Y = slab(p, 3);
  gemm_lora_phase(p, 128, 128, (const bf16_t*)(p.ws + O_WG2), bid, nb, smem, [&](int r, int c, float v) {
    const size_t o = (size_t)r * 1024 + c;
    Y[o] = f2bf(bf2f(Y[o]) * v);
  });
}

DI void phase_ssd_conv(const Params& p, int l, int bid, int nb) {
  const bf16_t* rx = slab(p, 2); const bf16_t* rbc = slab(p, 4);
  bf16_t* xs = slab(p, 5); bf16_t* bc = slab(p, 6);
  const float* cw = p.in[I_CONVW] + l * 4 * 2048; const float* cb = p.in[I_CONVB] + l * 2048;
  for (int it = bid * 256 + tidx(); it < T_ * 256; it += nb * 256) {
    const int t = it >> 8, c8 = (it & 255) * 8;
    const bf16_t* src = c8 < 1024 ? rx : rbc; bf16_t* dst = c8 < 1024 ? xs : bc;
    const int cc = c8 & 1023, ts = t & (S_ - 1);
    float acc[8];
#pragma unroll
    for (int e = 0; e < 8; ++e) acc[e] = cb[c8 + e];
#pragma unroll
    for (int k = 0; k < 4; ++k) {
      if (ts - 3 + k >= 0) {
        float x[8]; unpack8(*(const uint4*)(src + (size_t)(t - 3 + k) * 1024 + cc), x);
#pragma unroll
        for (int e = 0; e < 8; ++e) acc[e] += x[e] * cw[k * 2048 + c8 + e];
      }
    }
#pragma unroll
    for (int e = 0; e < 8; ++e) acc[e] = siluf_(acc[e]);
    *(uint4*)(dst + (size_t)t * 1024 + cc) = pack8(acc);
  }
}
DI float* scan128(float* a, float* b) {
  const int tid = tidx();
  float* src = a; float* dst = b;
  for (int off = 1; off < 128; off <<= 1) {
    if (tid < 128) dst[tid] = src[tid] + (tid >= off ? src[tid - off] : 0.f);
    __syncthreads();
    float* t = src; src = dst; dst = t;
  }
  return src;
}
DI void phase_ssd_states(const Params& p, int l, int bid, int nb, char* smem) {
  bf16_t* sXT = (bf16_t*)smem;
  bf16_t* sBT = sXT + 64 * 136;
  float* fa = (float*)(sBT + 128 * 136);
  float* fb = fa + 128; float* fdt = fb + 128;
  const int tid = tidx(), lane = tid & 63, wave = tid >> 6;
  const bf16_t* xs = slab(p, 5); const bf16_t* bc = slab(p, 6);
  const float* dt = (const float*)(p.ws + O_DT);
  float* cdec = (float*)(p.ws + O_CDEC);
  for (int task = bid; task < 4096; task += nb) {
    const int head = task & 15, c = (task >> 4) & 127, b = task >> 11, g = head >> 2;
    const size_t t0 = (size_t)b * S_ + c * 128;
    const float aneg = -__expf(p.in[I_ALOG][l * 16 + head]);
    __syncthreads();
    if (tid < 128) { const float d = dt[(t0 + tid) * 16 + head]; fdt[tid] = d; fa[tid] = d * aneg; }
    __syncthreads();
    float* acs = scan128(fa, fb);
    const float alast = acs[127];
    if (tid == 0) cdec[(b * 128 + c) * 16 + head] = __expf(alast);
#pragma unroll
    for (int j = 0; j < 4; ++j) {
      const int ci = tid + 256 * j, lr = ci >> 3, p8 = (ci & 7) * 8;
      float x[8]; unpack8(*(const uint4*)(xs + (t0 + lr) * 1024 + head * 64 + p8), x);
      const float sc = fdt[lr] * __expf(alast - acs[lr]);
#pragma unroll
      for (int e = 0; e < 8; ++e) sXT[(p8 + e) * 136 + lr] = f2bf(x[e] * sc);
    }
#pragma unroll
    for (int j = 0; j < 8; ++j) {
      const int ci = tid + 256 * j, lr = ci >> 4, n8 = (ci & 15) * 8;
      const uint4 u = *(const uint4*)(bc + (t0 + lr) * 1024 + g * 128 + n8);
#pragma unroll
      for (int e = 0; e < 8; ++e) sBT[(n8 + e) * 136 + lr] = get16(u, e);
    }
    __syncthreads();
    f32x16 acc[2];
#pragma unroll
    for (int mi = 0; mi < 2; ++mi)
#pragma unroll
      for (int i = 0; i < 16; ++i) acc[mi][i] = 0.f;
#pragma unroll
    for (int kk = 0; kk < 8; ++kk) {
      const bf16x8 bf = *(const bf16x8*)(sBT + (wave * 32 + (lane & 31)) * 136 + kk * 16 + (lane >> 5) * 8);
#pragma unroll
      for (int mi = 0; mi < 2; ++mi) {
        const bf16x8 af = *(const bf16x8*)(sXT + (mi * 32 + (lane & 31)) * 136 + kk * 16 + (lane >> 5) * 8);
        acc[mi] = MFMA32(af, bf, acc[mi]);
      }
    }
    float* st = (float*)slab(p, b == 0 ? 2 : 4) + ((size_t)(c * 16 + head) * 64) * 128;
#pragma unroll
    for (int mi = 0; mi < 2; ++mi)
#pragma unroll
      for (int i = 0; i < 16; ++i) st[(size_t)(mi * 32 + crow(i, lane >> 5)) * 128 + wave * 32 + (lane & 31)] = acc[mi][i];
  }
}
DI void phase_ssd_scan(const Params& p, int bid, int nb) {
  const float* cdec = (const float*)(p.ws + O_CDEC);
  for (int it = bid * 256 + tidx(); it < 2 * 16 * 8192; it += nb * 256) {
    const int b = it >> 17, rem = it & 131071, head = rem >> 13;
    float* st = (float*)slab(p, b == 0 ? 2 : 4) + rem;
    float h = 0.f;
#pragma unroll 8
    for (int c = 0; c < 128; ++c) {
      const float s = st[(size_t)c * 131072];
      st[(size_t)c * 131072] = h;
      h = h * cdec[(b * 128 + c) * 16 + head] + s;
    }
  }
}
DI void phase_ssd_out(const Params& p, int l, int bid, int nb, char* smem) {
  bf16_t* sM = (bf16_t*)smem;
  bf16_t* sXT = sM + 128 * 136;
  float* fa = (float*)(sXT + 64 * 136); float* fb = fa + 128; float* fdt = fb + 128; float* frs = fdt + 128;
  const int tid_ = tidx(), lane = tid_ & 63, wave_ = __builtin_amdgcn_readfirstlane(tid_ >> 6), hh_ = lane >> 5, l31_ = lane & 31;
  const bf16_t* xs = slab(p, 5); const bf16_t* bc = slab(p, 6);
  bf16_t* zy = slab(p, 1);
  const float* dt = (const float*)(p.ws + O_DT);
  const float* ng = p.in[I_SSDNG] + l * 1024;
  for (int task = bid; task < 1024; task += nb) {
    const int g = task & 3, c = (task >> 2) & 127, b = task >> 9;
    const size_t t0 = (size_t)b * S_ + c * 128;
    int tid = tid_; asm volatile("" : "+v"(tid));
    __syncthreads();
#pragma unroll 2
    for (int j = 0; j < 8; ++j) {
      const int ci = tid + 256 * j, lr = ci >> 4, n8 = (ci & 15) * 8;
      *(uint4*)(sM + lr * 136 + n8) = *(const uint4*)(bc + (t0 + lr) * 1024 + g * 128 + n8);
    }
    const int wave = wave_, hh = hh_, l31 = l31_;
    const bf16_t* cptr = bc + (t0 + wave * 32 + l31) * 1024 + 512 + g * 128 + hh * 8;
    __syncthreads();
    f32x16 cb[4];
#pragma unroll
    for (int ni = 0; ni < 4; ++ni)
#pragma unroll
      for (int i = 0; i < 16; ++i) cb[ni][i] = 0.f;
#pragma unroll
    for (int kk = 0; kk < 8; ++kk) {
      const bf16x8 cfk = *(const bf16x8*)(cptr + kk * 16);
#pragma unroll
      for (int ni = 0; ni < 4; ++ni) {
        const bf16x8 bf = *(const bf16x8*)(sM + (ni * 32 + l31) * 136 + kk * 16 + hh * 8);
        cb[ni] = MFMA32(cfk, bf, cb[ni]);
      }
    }
    float ssq[16];
#pragma unroll
    for (int i = 0; i < 16; ++i) ssq[i] = 0.f;
#pragma unroll 1
    for (int e = 0; e < 4; ++e) {
      int l31 = l31_, hh = hh_, wave = wave_;
      asm volatile("" : "+v"(l31), "+v"(hh));
      asm volatile("" : "+s"(wave));
      const int head = g * 4 + e;
      const float aneg = -__expf(p.in[I_ALOG][l * 16 + head]);
      const float dsk = p.in[I_DSKIP][l * 16 + head];
      __syncthreads();
      if (tid < 128) { const float d = dt[(t0 + tid) * 16 + head]; fdt[tid] = d; fa[tid] = d * aneg; }
      __syncthreads();
      float* acs = scan128(fa, fb);
#pragma unroll 2
      for (int j = 0; j < 4; ++j) {
        const int ci = tid + 256 * j, lr = ci >> 3, p8 = (ci & 7) * 8;
        const uint4 u = *(const uint4*)(xs + (t0 + lr) * 1024 + head * 64 + p8);
#pragma unroll
        for (int q = 0; q < 8; ++q) sXT[(p8 + q) * 136 + lr] = get16(u, q);
      }
#pragma unroll
      for (int ni = 0; ni < 4; ++ni)
#pragma unroll
        for (int i = 0; i < 16; ++i) {
          const int lr = wave * 32 + crow(i, hh), sc = ni * 32 + l31;
          const float m = sc <= lr ? cb[ni][i] * __expf(acs[lr] - acs[sc]) * fdt[sc] : 0.f;
          sM[lr * 136 + sc] = f2bf(m);
        }
      __syncthreads();
      const float* hin = (const float*)slab(p, b == 0 ? 2 : 4) + ((size_t)(c * 16 + head) * 64) * 128;
#pragma unroll 1
      for (int ni = 0; ni < 2; ++ni) {
        f32x16 yd;
#pragma unroll
        for (int i = 0; i < 16; ++i) yd[i] = 0.f;
#pragma unroll 2
        for (int kk = 0; kk < 8; ++kk) {
          const bf16x8 cfk = *(const bf16x8*)(cptr + kk * 16);
          const float* hp = hin + (size_t)(ni * 32 + l31) * 128 + kk * 16 + hh * 8;
          const float4 h0 = *(const float4*)hp, h1 = *(const float4*)(hp + 4);
          u32x4 u; u.x = pack2(h0.x, h0.y); u.y = pack2(h0.z, h0.w); u.z = pack2(h1.x, h1.y); u.w = pack2(h1.z, h1.w);
          yd = MFMA32(cfk, __builtin_bit_cast(bf16x8, u), yd);
        }
#pragma unroll
        for (int i = 0; i < 16; ++i) yd[i] *= (SSD_PROBE == 2 ? 0.f : __expf(acs[wave * 32 + crow(i, hh)]));
#pragma unroll
        for (int kk = 0; kk < 8; ++kk) {
          const bf16x8 af = *(const bf16x8*)(sM + (wave * 32 + l31) * 136 + kk * 16 + hh * 8);
          const bf16x8 bf = *(const bf16x8*)(sXT + (ni * 32 + l31) * 136 + kk * 16 + hh * 8);
          yd = MFMA32(af, bf, yd);
        }
#pragma unroll
        for (int i = 0; i < 16; ++i) {
          const int lr = wave * 32 + crow(i, hh), pc = ni * 32 + l31;
          const float xv = bf2f(sXT[pc * 136 + lr]);
          float y = (SSD_PROBE == 1 ? 0.f : yd[i]) + xv * dsk;
          const size_t o = (t0 + lr) * 1024 + head * 64 + pc;
          const float zv = bf2f(zy[o]);
          y *= siluf_(zv);
          ssq[i] += y * y;
          zy[o] = f2bf(y);
        }
      }
    }
#pragma unroll
    for (int i = 0; i < 16; ++i) {
      float s = ssq[i];
      for (int o = 16; o > 0; o >>= 1) s += __shfl_xor(s, o);
      if (l31 == 0) frs[wave * 32 + crow(i, hh)] = rsqrtf(s * (1.f / 256.f) + 1e-6f);
    }
    __syncthreads();
#pragma unroll 1
    for (int j = 0; j < (DBG == 2 ? 0 : 16); ++j) {
      const int ci = tid + 256 * j, lr = ci >> 5, c8 = (ci & 31) * 8;
      bf16_t* ptr = zy + (t0 + lr) * 1024 + g * 256 + c8;
      float f[8]; unpack8(*(const uint4*)ptr, f);
      const float rs = frs[lr];
#pragma unroll
      for (int q = 0; q < 8; ++q) f[q] *= rs * ng[g * 256 + c8 + q];
      *(uint4*)ptr = pack8(f);
    }
  }
}

DI void phase_moba_norm(const Params& p, int l, int bid, int nb, char* smem) {
  float* sK = (float*)smem;
  const int tid = tidx(), rg = tid >> 4, ln = tid & 15;
  bf16_t* Q = slab(p, 2); bf16_t* Kx = slab(p, 4);
  float* kmean = (float*)(p.ws + O_KMEAN);
  float qg[8], kg[8];
#pragma unroll
  for (int e = 0; e < 8; ++e) { qg[e] = p.in[I_QNG][l * 128 + ln * 8 + e]; kg[e] = p.in[I_KNG][l * 128 + ln * 8 + e]; }
  for (int task = bid; task < 1024; task += nb) {
    const int blk = task & 63, h = (task >> 6) & 7, b = task >> 9;
    const size_t t0 = (size_t)b * S_ + blk * 256;
    float ks[8];
#pragma unroll
    for (int e = 0; e < 8; ++e) ks[e] = 0.f;
    for (int j = 0; j < 16; ++j) {
      const size_t o = (t0 + rg + 16 * j) * 1024 + h * 128 + ln * 8;
      float f[8]; float ss = 0.f;
      unpack8(*(const uint4*)(Q + o), f);
#pragma unroll
      for (int e = 0; e < 8; ++e) ss += f[e] * f[e];
      ss = red16(ss);
      float r = rsqrtf(ss * (1.f / 128.f) + 1e-6f);
#pragma unroll
      for (int e = 0; e < 8; ++e) f[e] *= r * qg[e];
      *(uint4*)(Q + o) = pack8(f);
      unpack8(*(const uint4*)(Kx + o), f);
      ss = 0.f;
#pragma unroll
      for (int e = 0; e < 8; ++e) ss += f[e] * f[e];
      ss = red16(ss);
      r = rsqrtf(ss * (1.f / 128.f) + 1e-6f);
#pragma unroll
      for (int e = 0; e < 8; ++e) { f[e] *= r * kg[e]; ks[e] += f[e]; }
      *(uint4*)(Kx + o) = pack8(f);
    }
    __syncthreads();
#pragma unroll
    for (int e = 0; e < 8; ++e) sK[rg * 128 + ln * 8 + e] = ks[e];
    __syncthreads();
    if (tid < 128) {
      float s = 0.f;
#pragma unroll
      for (int j = 0; j < 16; ++j) s += sK[j * 128 + tid];
      kmean[((size_t)(b * 8 + h) * 64 + blk) * 128 + tid] = s * (1.f / 256.f);
    }
  }
}
DI void phase_moba_gate(const Params& p, int bid, int nb, char* smem) {
  float* sKm = (float*)smem;
  const int tid = tidx();
  const bf16_t* Q = slab(p, 2);
  const float* kmean = (const float*)(p.ws + O_KMEAN);
  int* sel = (int*)(p.ws + O_SEL); int* cnt = (int*)(p.ws + O_CNT);
  for (int task = bid; task < 1024; task += nb) {
    const int blk = task & 63, h = (task >> 6) & 7, b = task >> 9;
    __syncthreads();
    for (int i = tid; i < blk * 128; i += 256) sKm[i] = kmean[((size_t)(b * 8 + h) * 64) * 128 + i];
    __syncthreads();
    const size_t t = (size_t)b * S_ + blk * 256 + tid;
    float q[128];
#pragma unroll
    for (int j = 0; j < 16; ++j) unpack8(*(const uint4*)(Q + t * 1024 + h * 128 + j * 8), q + j * 8);
    float v0 = -3e38f, v1 = -3e38f, v2 = -3e38f; int i0 = -1, i1 = -1, i2 = -1;
    for (int j = 0; j < blk; ++j) {
      float d = 0.f;
#pragma unroll
      for (int e = 0; e < 128; ++e) d += q[e] * sKm[j * 128 + e];
      if (d > v0) { v2 = v1; i2 = i1; v1 = v0; i1 = i0; v0 = d; i0 = j; }
      else if (d > v1) { v2 = v1; i2 = i1; v1 = d; i1 = j; }
      else if (d > v2) { v2 = d; i2 = j; }
    }
    int* so = sel + (t * 8 + h) * 3;
    so[0] = i0; so[1] = i1; so[2] = i2;
    const int base = (b * 8 + h) * 64;
    if (i0 >= 0) atomicAdd(cnt + 0 * 1024 + base + i0, 1);
    if (i1 >= 0) atomicAdd(cnt + 1 * 1024 + base + i1, 1);
    if (i2 >= 0) atomicAdd(cnt + 2 * 1024 + base + i2, 1);
  }
}
DI void phase_moba_fill(const Params& p, int bid, int nb, char* smem) {
  int* sBase = (int*)smem;
  const int tid = tidx();
  const int* sel = (const int*)(p.ws + O_SEL); const int* cnt = (const int*)(p.ws + O_CNT);
  int* fill = (int*)(p.ws + O_FILL); int* lists = (int*)(p.ws + O_LISTS);
  for (int task = bid; task < 1024; task += nb) {
    const int blk = task & 63, h = (task >> 6) & 7, b = task >> 9;
    const int base = (b * 8 + h) * 64;
    __syncthreads();
    if (tid < 3) { int a = 0; for (int j = 0; j < 64; ++j) { sBase[tid * 64 + j] = a; a += cnt[tid * 1024 + base + j]; } }
    __syncthreads();
    const int ts = blk * 256 + tid;
    const size_t t = (size_t)b * S_ + ts;
    for (int s = 0; s < 3; ++s) {
      const int j = sel[(t * 8 + h) * 3 + s];
      if (j >= 0) {
        const int pos = sBase[s * 64 + j] + atomicAdd(fill + s * 1024 + base + j, 1);
        lists[(size_t)s * (T_ * 8) + (size_t)(b * 8 + h) * S_ + pos] = ts;
      }
    }
  }
}
DI int t5_bucket(int d) {
  if (d < 16) return d;
  const int large = 16 + (int)(__logf((float)d * (1.f / 16.f)) / 4.1588830833596715f * 16.f);
  return large < 31 ? large : 31;
}
struct MobaLds { bf16_t* sK; bf16_t* sVT; float* sBias; };
DI void moba_block(const Params& p, const MobaLds& L, int b, int h, int tsq  , int kb  ,
                   int ntiles, bool causal, bool init) {
  const int tid = tidx(), lane = tid & 63, hh = lane >> 5, l31 = lane & 31;
  const bf16_t* Q = slab(p, 2); const bf16_t* Kx = slab(p, 4); const bf16_t* V = slab(p, 5);
  bf16_t* ACC = slab(p, 6);
  float* MM = (float*)(p.ws + O_MM); float* ML = (float*)(p.ws + O_ML);
  const bool valid = tsq >= 0;
  const size_t tq = (size_t)b * S_ + (valid ? tsq : 0);
  bf16x8 qf[8];
#pragma unroll
  for (int kk = 0; kk < 8; ++kk) {
    uint4 u = {0, 0, 0, 0};
    if (valid) u = *(const uint4*)(Q + tq * 1024 + h * 128 + kk * 16 + hh * 8);
    qf[kk] = __builtin_bit_cast(bf16x8, u);
  }
  float m = -1e30f, lsum = 0.f;
  f32x16 o[4];
#pragma unroll
  for (int dt = 0; dt < 4; ++dt)
#pragma unroll
    for (int i = 0; i < 16; ++i) o[dt][i] = 0.f;
  if (!init && valid) {
    m = MM[tq * 8 + h]; lsum = ML[tq * 8 + h];
#pragma unroll
    for (int dt = 0; dt < 4; ++dt)
#pragma unroll
      for (int g4 = 0; g4 < 4; ++g4) {
        const uint2 u = *(const uint2*)(ACC + tq * 1024 + h * 128 + dt * 32 + g4 * 8 + hh * 4);
        o[dt][g4 * 4 + 0] = lo16(u.x) * lsum; o[dt][g4 * 4 + 1] = hi16(u.x) * lsum;
        o[dt][g4 * 4 + 2] = lo16(u.y) * lsum; o[dt][g4 * 4 + 3] = hi16(u.y) * lsum;
      }
  }
  int wmaxq = valid ? tsq : -1;
  for (int of = 32; of > 0; of >>= 1) wmaxq = max(wmaxq, __shfl_xor(wmaxq, of));
  const float bias31 = L.sBias[1023];
  const float scale = 0.08838834764831845f;
  const size_t k0 = (size_t)b * S_ + (size_t)kb * 256;
  for (int kt = 0; kt < ntiles; ++kt) {
    __syncthreads();
#pragma unroll
    for (int j = 0; j < 4; ++j) {
      const int ci = tid + 256 * j, kr = ci >> 4, d8 = (ci & 15) * 8;
      const size_t go = (k0 + kt * 64 + kr) * 1024 + h * 128 + d8;
      *(uint4*)(L.sK + kr * 136 + d8) = *(const uint4*)(Kx + go);
      const uint4 u = *(const uint4*)(V + go);
#pragma unroll
      for (int e = 0; e < 8; ++e) L.sVT[(d8 + e) * 72 + kr] = get16(u, e);
    }
    __syncthreads();
    const int kpos0 = kb * 256 + kt * 64;
    if (causal && kpos0 > wmaxq) continue;
    f32x16 st[2];
#pragma unroll
    for (int t2 = 0; t2 < 2; ++t2)
#pragma unroll
      for (int i = 0; i < 16; ++i) st[t2][i] = 0.f;
#pragma unroll
    for (int kk = 0; kk < 8; ++kk)
#pragma unroll
      for (int t2 = 0; t2 < 2; ++t2) {
        const bf16x8 af = *(const bf16x8*)(L.sK + (t2 * 32 + l31) * 136 + kk * 16 + hh * 8);
        st[t2] = MFMA32(af, qf[kk], st[t2]);
      }
    float mloc = -1e30f;
#pragma unroll
    for (int t2 = 0; t2 < 2; ++t2)
#pragma unroll
      for (int i = 0; i < 16; ++i) {
        const int kp = kpos0 + t2 * 32 + crow(i, hh);
        const int dist = tsq - kp;
        float s;
        if (causal && dist < 0) s = -1e30f;
        else {
          const int dd = dist < 0 ? 0 : dist;
          s = st[t2][i] * scale + (dd < 1024 ? L.sBias[dd] : bias31);
        }
        st[t2][i] = s;
        mloc = fmaxf(mloc, s);
      }
    mloc = fmaxf(mloc, __shfl_xor(mloc, 32));
    const float mnew = fmaxf(m, mloc);
    const float alpha = __expf(m - mnew);
    float ls = 0.f;
#pragma unroll
    for (int t2 = 0; t2 < 2; ++t2)
#pragma unroll
      for (int i = 0; i < 16; ++i) {
        const float pv = st[t2][i] <= -1e29f ? 0.f : __expf(st[t2][i] - mnew);
        st[t2][i] = pv; ls += pv;
      }
    ls += __shfl_xor(ls, 32);
    lsum = lsum * alpha + ls;
    m = mnew;
#pragma unroll
    for (int dt = 0; dt < 4; ++dt)
#pragma unroll
      for (int i = 0; i < 16; ++i) o[dt][i] *= alpha;
#pragma unroll
    for (int t2 = 0; t2 < 2; ++t2)
#pragma unroll
      for (int s2 = 0; s2 < 2; ++s2) {
        uint4 pu;
        pu.x = pack2(st[t2][8 * s2 + 0], st[t2][8 * s2 + 1]); pu.y = pack2(st[t2][8 * s2 + 2], st[t2][8 * s2 + 3]);
        pu.z = pack2(st[t2][8 * s2 + 4], st[t2][8 * s2 + 5]); pu.w = pack2(st[t2][8 * s2 + 6], st[t2][8 * s2 + 7]);
        const bf16x8 pf = __builtin_bit_cast(bf16x8, pu);
#pragma unroll
        for (int dt = 0; dt < 4; ++dt) {
          const bf16_t* vp = L.sVT + (dt * 32 + l31) * 72 + t2 * 32 + s2 * 16 + hh * 4;
          uint4 vu; const uint2 a0 = *(const uint2*)vp, a1 = *(const uint2*)(vp + 8);
          vu.x = a0.x; vu.y = a0.y; vu.z = a1.x; vu.w = a1.y;
          o[dt] = MFMA32(__builtin_bit_cast(bf16x8, vu), pf, o[dt]);
        }
      }
  }
  if (valid) {
    const float inv = 1.f / lsum;
    if (hh == 0) { MM[tq * 8 + h] = m; ML[tq * 8 + h] = lsum; }
#pragma unroll
    for (int dt = 0; dt < 4; ++dt)
#pragma unroll
      for (int g4 = 0; g4 < 4; ++g4) {
        uint2 u; u.x = pack2(o[dt][g4 * 4] * inv, o[dt][g4 * 4 + 1] * inv); u.y = pack2(o[dt][g4 * 4 + 2] * inv, o[dt][g4 * 4 + 3] * inv);
        *(uint2*)(ACC + tq * 1024 + h * 128 + dt * 32 + g4 * 8 + hh * 4) = u;
      }
  }
}
DI void moba_bias_table(const Params& p, float* sBias, int h) {
  for (int d = tidx(); d < 1024; d += 256) sBias[d] = p.in[I_RELB][t5_bucket(d) * 8 + h];
}
DI void phase_moba_own(const Params& p, int bid, int nb, char* smem) {
  MobaLds L; L.sK = (bf16_t*)smem; L.sVT = L.sK + 64 * 136; L.sBias = (float*)(L.sVT + 128 * 72);
  const int tid = tidx(), lane = tid & 63, wave = tid >> 6;
  for (int task = bid; task < 2048; task += nb) {
    const int qt = task & 1, blk = (task >> 1) & 63, h = (task >> 7) & 7, b = task >> 10;
    __syncthreads();
    moba_bias_table(p, L.sBias, h);
    __syncthreads();
    const int tsq = blk * 256 + qt * 128 + wave * 32 + (lane & 31);
    moba_block(p, L, b, h, tsq, blk, 2 * (qt + 1), true, true);
  }
}
DI void phase_moba_past(const Params& p, int s, int bid, int nb, char* smem) {
  MobaLds L; L.sK = (bf16_t*)smem; L.sVT = L.sK + 64 * 136; L.sBias = (float*)(L.sVT + 128 * 72);
  int* sTb = (int*)(L.sBias + 1024);
  const int tid = tidx(), lane = tid & 63, wave = tid >> 6;
  const int* cnt = (const int*)(p.ws + O_CNT) + s * 1024;
  const int* lists = (const int*)(p.ws + O_LISTS) + (size_t)s * (T_ * 8);
  __syncthreads();
  if (tid < 16) { int a = 0; for (int j = 0; j < 64; ++j) { sTb[tid * 64 + j] = a; a += (cnt[tid * 64 + j] + 127) >> 7; } sTb[1040 + tid] = a; }
  __syncthreads();
  if (tid == 0) { int a = 0; for (int i = 0; i < 16; ++i) { const int c = sTb[1040 + i]; sTb[1040 + i] = a; a += c; } sTb[1056] = a; }
  __syncthreads();
  const int total = sTb[1056];
  for (int task = bid; task < total; task += nb) {
    int gi = 0;
    for (int i = 1; i < 16; ++i) if (sTb[1040 + i] <= task) gi = i;
    const int loc = task - sTb[1040 + gi];
    int j = 0;
    for (int i = 1; i < 64; ++i) if (sTb[gi * 64 + i] <= loc) j = i;
    while (j > 0 && ((cnt[gi * 64 + j] + 127) >> 7) == 0) --j;
    const int tile = loc - sTb[gi * 64 + j];
    const int b = gi >> 3, h = gi & 7;
    __syncthreads();
    moba_bias_table(p, L.sBias, h);
    __syncthreads();
    int lbase = 0;
    for (int i = 0; i < j; ++i) lbase += cnt[gi * 64 + i];
    const int n = cnt[gi * 64 + j];
    const int qi = tile * 128 + wave * 32 + (lane & 31);
    const int tsq = qi < n ? lists[(size_t)gi * S_ + lbase + qi] : -1;
    moba_block(p, L, b, h, tsq, j, 4, false, false);
  }
}

DI void phase_merge(const Params& p, int l, int bid, int nb, char* smem) {
  bf16_t* sA = (bf16_t*)smem; bf16_t* sB = sA + 128 * LDT;
  bf16_t* stash = sB + 128 * LDT;
  const int tid = tidx();
  const bf16_t* h = slab(p, 0);
  const bf16_t* wg = (const bf16_t*)(p.ws + O_WGATE); const bf16_t* pt = (const bf16_t*)(p.ws + O_PT);
  const float* bg = p.in[I_BGATE] + l * 3072;
  bf16_t* mg = slab(p, 2);
  for (int t = bid; t < 512 * 8; t += nb) {
    int tm, tn; tile_remap(t, 512, 8, tm, tn);
    f32x16 accm[1][2]; acc_zero<1>(accm);
    for (int br = 0; br < 3; ++br) {
      if ((SKIP_BR >> br) & 1) continue;
      const bf16_t* yb = slab(p, br == 0 ? 1 : (br == 1 ? 6 : 3));
      f32x16 acc[1][2]; acc_zero<1>(acc);
      gemm_core<1>(h + (size_t)tm * 64 * 1024, 1024, wg + (size_t)(br * 1024 + tn * 128) * 1024, 1024, 1024, sA, sB, acc);
      {
        const float* bgp = bg + br * 1024 + tn * 128;
        ACC_FOREACH(1, acc, { stash[((mi * 2 + ni) * 16 + i) * 256 + tid] = f2bf(sigmoidf_(v + bgp[c])); })
      }
      acc_zero<1>(acc);
      gemm_core<1>(yb + (size_t)tm * 64 * 1024, 1024, pt + (size_t)(br * 1024 + tn * 128) * 1024, 1024, 1024, sA, sB, acc);
      ACC_FOREACH(1, acc, { accm[mi][ni][i] += bf2f(stash[((mi * 2 + ni) * 16 + i) * 256 + tid]) * v; })
    }
    bf16_t* d = mg + (size_t)tm * 64 * 1024 + tn * 128;
    ACC_FOREACH(1, accm, { d[(size_t)r * 1024 + c] = f2bf(v); })
  }
}
DI void phase_wout(const Params& p, int l, int bid, int nb, char* smem) {
  bf16_t* sA = (bf16_t*)smem; bf16_t* sB = sA + 128 * LDT;
  const bf16_t* mg = slab(p, 2); const bf16_t* wo = (const bf16_t*)(p.ws + O_WOUT);
  const float* xin = l == 0 ? p.in[I_X] : p.out;
  for (int t = bid; t < 256 * 8; t += nb) {
    int tm, tn; tile_remap(t, 256, 8, tm, tn);
    f32x16 acc[2][2]; acc_zero<2>(acc);
    gemm_core_deep<2>(mg + (size_t)tm * 128 * 1024, 1024, wo + (size_t)tn * 128 * 1024, 1024, 1024, sA, sB, acc);
    const size_t o0 = (size_t)tm * 128 * 1024 + tn * 128;
    ACC_FOREACH(2, acc, { const size_t o = o0 + (size_t)r * 1024 + c; p.out[o] = xin[o] + v; })
  }
}

DI void phase_peer_prep(const Params& p, int l, int bid, int nb) {
  rmsnorm_phase(p.out, p.in[I_N2G] + l * 1024, slab(p, 0), bid, nb);
  conv_fp8(p.in[I_U] + (size_t)l * 16777216, (unsigned char*)slab(p, 1), 16777216, 64.f, bid, nb);
  conv_fp8(p.in[I_V] + (size_t)l * 16777216, (unsigned char*)slab(p, 1) + 16777216, 16777216, 16.f, bid, nb);
}
DI void phase_peer_q(const Params& p, int bid, int nb, char* smem) {
  bf16_t* sA = (bf16_t*)smem; bf16_t* sB = sA + 128 * LDT;
  const bf16_t* h2 = slab(p, 0); const bf16_t* wq = (const bf16_t*)(p.ws + O_WQ);
  bf16_t* q = slab(p, 2);
  for (int t = bid; t < 256 * 16; t += nb) {
    int tm, tn; tile_remap(t, 256, 16, tm, tn);
    f32x16 acc[2][2]; acc_zero<2>(acc);
    gemm_core_deep<2>(h2 + (size_t)tm * 128 * 1024, 1024, wq + (size_t)tn * 128 * 1024, 1024, 1024, sA, sB, acc);
    bf16_t* d = q + (size_t)tm * 128 * 2048 + tn * 128;
    ACC_FOREACH(2, acc, { d[(size_t)r * 2048 + c] = f2bf(v); })
  }
}
DI unsigned fkey(float f) { unsigned u = __float_as_uint(f); return (u & 0x80000000u) ? ~u : (u | 0x80000000u); }
DI void phase_peer_topk(const Params& p, int bid, int nb, char* smem, int rep) {
  bf16_t* sQ = (bf16_t*)smem;
  float* sS = (float*)smem;
  float* wsc = (float*)(smem + 66560);
  const int tid = tidx(), lane = tid & 63, wave = tid >> 6, wm = wave >> 1, wn = wave & 1, hh = lane >> 5, l31 = lane & 31;
  const bf16_t* q = slab(p, 2);
  const bf16_t* kb = (const bf16_t*)(p.ws + (wn == 0 ? O_K1 : O_K2));
  int* idx_out = (int*)slab(p, 4); float* gate_out = (float*)slab(p, 5);
  float* tv = wsc + wave * 384;
  const unsigned long long ltmask = (1ull << lane) - 1ull;
  for (int task = bid; task < 4096; task += nb) {
    const int hd = task & 7, tt = task >> 3;
    const size_t t0 = (size_t)tt * 64;
    __syncthreads();
#pragma unroll
    for (int j = 0; j < 8; ++j) {
      const int ci = tid + 256 * j, r = ci >> 5, c8 = (ci & 31) * 8;
      *(uint4*)(sQ + r * 264 + c8) = *(const uint4*)(q + (t0 + r) * 2048 + hd * 256 + c8);
    }
    __syncthreads();
    f32x16 acc[4];
#pragma unroll
    for (int ni = 0; ni < 4; ++ni)
#pragma unroll
      for (int i = 0; i < 16; ++i) acc[ni][i] = 0.f;
#pragma unroll
    for (int kk = 0; kk < 8; ++kk) {
      const bf16x8 af = *(const bf16x8*)(sQ + (wm * 32 + l31) * 264 + wn * 128 + kk * 16 + hh * 8);
#pragma unroll
      for (int ni = 0; ni < 4; ++ni) {
        const bf16x8 bf = *(const bf16x8*)(kb + (size_t)(ni * 32 + l31) * 128 + kk * 16 + hh * 8);
        acc[ni] = MFMA32(af, bf, acc[ni]);
      }
    }
    __syncthreads();
#pragma unroll
    for (int ni = 0; ni < 4; ++ni)
#pragma unroll
      for (int i = 0; i < 16; ++i) sS[(wm * 32 + crow(i, hh)) * 260 + wn * 128 + ni * 32 + l31] = acc[ni][i];
    __syncthreads();
#define WAVE_SYNC() do { __builtin_amdgcn_fence(__ATOMIC_RELEASE, "wavefront"); __builtin_amdgcn_wave_barrier(); __builtin_amdgcn_fence(__ATOMIC_ACQUIRE, "wavefront"); } while (0)
    for (int tk = 0; tk < 16; tk += 4) {
      float av[4][4]; unsigned ak[4][4]; unsigned thrA[4], thrB[4];
#pragma unroll
      for (int u = 0; u < 4; ++u) {
        const int r = wave * 16 + tk + u;
#pragma unroll
        for (int q = 0; q < 4; ++q) { av[u][q] = sS[r * 260 + q * 64 + lane]; ak[u][q] = fkey(av[u][q]); }
        thrA[u] = 0; thrB[u] = 0;
      }
      for (int bit = 31; bit >= 0; --bit) {
#pragma unroll
        for (int u = 0; u < 4; ++u) {
          const unsigned ca = thrA[u] | (1u << bit), cb = thrB[u] | (1u << bit);
          const int na = __popcll(__ballot(ak[u][0] >= ca)) + __popcll(__ballot(ak[u][1] >= ca));
          const int nb2 = __popcll(__ballot(ak[u][2] >= cb)) + __popcll(__ballot(ak[u][3] >= cb));
          thrA[u] = na >= 16 ? ca : thrA[u];
          thrB[u] = nb2 >= 16 ? cb : thrB[u];
        }
      }
#pragma unroll
      for (int u = 0; u < 4; ++u) {
        float* tvu = tv + u * 96; int* tiu = (int*)(tvu + 32);
        const unsigned long long q0 = __ballot(ak[u][0] >= thrA[u]), q1 = __ballot(ak[u][1] >= thrA[u]);
        const int p0 = __popcll(q0 & ltmask), p1 = __popcll(q0) + __popcll(q1 & ltmask);
        if (ak[u][0] >= thrA[u] && p0 < 16) { tvu[p0] = av[u][0]; tiu[p0] = lane; }
        if (ak[u][1] >= thrA[u] && p1 < 16) { tvu[p1] = av[u][1]; tiu[p1] = lane + 64; }
        const unsigned long long w0 = __ballot(ak[u][2] >= thrB[u]), w1 = __ballot(ak[u][3] >= thrB[u]);
        const int r0 = __popcll(w0 & ltmask), r1 = __popcll(w0) + __popcll(w1 & ltmask);
        if (ak[u][2] >= thrB[u] && r0 < 16) { tvu[16 + r0] = av[u][2]; tiu[16 + r0] = lane; }
        if (ak[u][3] >= thrB[u] && r1 < 16) { tvu[16 + r1] = av[u][3]; tiu[16 + r1] = lane + 64; }
      }
      WAVE_SYNC();
      float cv[4][4]; unsigned ck[4][4]; unsigned thr[4];
#pragma unroll
      for (int u = 0; u < 4; ++u) {
        const float* tvu = tv + u * 96;
#pragma unroll
        for (int q4 = 0; q4 < 4; ++q4) { const int c = lane + 64 * q4; cv[u][q4] = tvu[c >> 4] + tvu[16 + (c & 15)]; ck[u][q4] = fkey(cv[u][q4]); }
        thr[u] = 0;
      }
      for (int bit = 31; bit >= 0; --bit) {
#pragma unroll
        for (int u = 0; u < 4; ++u) {
          const unsigned cand = thr[u] | (1u << bit);
          const int c = __popcll(__ballot(ck[u][0] >= cand)) + __popcll(__ballot(ck[u][1] >= cand)) + __popcll(__ballot(ck[u][2] >= cand)) + __popcll(__ballot(ck[u][3] >= cand));
          thr[u] = c >= 16 ? cand : thr[u];
        }
      }
#pragma unroll
      for (int u = 0; u < 4; ++u) {
        float* tvu = tv + u * 96; const int* tiu = (const int*)(tvu + 32); float* fvu = tvu + 64; int* fiu = (int*)(tvu + 80);
        int basep = 0;
#pragma unroll
        for (int q4 = 0; q4 < 4; ++q4) {
          const unsigned long long bb = __ballot(ck[u][q4] >= thr[u]);
          const int pos = basep + __popcll(bb & ltmask);
          if (ck[u][q4] >= thr[u] && pos < 16) { const int c = lane + 64 * q4; fvu[pos] = cv[u][q4]; fiu[pos] = tiu[c >> 4] * 128 + tiu[16 + (c & 15)]; }
          basep += __popcll(bb);
        }
      }
      WAVE_SYNC();
      {
        const int u = lane >> 4, e16 = lane & 15;
        const float* fvu = tv + u * 96 + 64; const int* fiu = (const int*)(tv + u * 96 + 80);
        float mx = -3e38f;
#pragma unroll
        for (int e = 0; e < 16; ++e) mx = fmaxf(mx, fvu[e]);
        float sm = 0.f;
#pragma unroll
        for (int e = 0; e < 16; ++e) sm += __expf(fvu[e] - mx);
        const size_t o = ((t0 + wave * 16 + tk + u) * 8 + hd) * 16 + e16;
        idx_out[o] = fiu[e16];
        gate_out[o] = __expf(fvu[e16] - mx) / sm;
      }
      WAVE_SYNC();
    }
  }
}
DI void fp8x16_to_f32(const u32x4& v, float* f) {
#pragma unroll
  for (int j = 0; j < 4; ++j) {
    const f32x2 lo = __builtin_amdgcn_cvt_pk_f32_fp8((int)v[j], false), hi = __builtin_amdgcn_cvt_pk_f32_fp8((int)v[j], true);
    f[4 * j] = lo.x; f[4 * j + 1] = lo.y; f[4 * j + 2] = hi.x; f[4 * j + 3] = hi.y;
  }
}
DI void phase_peer_gather(const Params& p, int bid, int nb, char* smem) {
  const int tid = tidx(), lane = tid & 63, wave = tid >> 6;
  const bf16_t* h2 = slab(p, 0);
  const unsigned char* ub = (const unsigned char*)slab(p, 1); const unsigned char* vb = ub + 16777216;
  const int* idx = (const int*)slab(p, 4); const float* gate = (const float*)slab(p, 5);
  for (int t = bid * 4 + wave; t < T_; t += nb * 4) {
    float h[16];
    unpack8(*(const uint4*)(h2 + (size_t)t * 1024 + lane * 16), h);
    unpack8(*(const uint4*)(h2 + (size_t)t * 1024 + lane * 16 + 8), h + 8);
    const int ia = idx[(size_t)t * 128 + lane], ib = idx[(size_t)t * 128 + 64 + lane];
    float c_lo = 0.f, c_hi = 0.f;
#pragma unroll 1
    for (int g = 0; g < 8; ++g) {
      float part[16];
#pragma unroll
      for (int hf = 0; hf < 2; ++hf) {
        u32x4 rows[8];
#pragma unroll
        for (int j = 0; j < 8; ++j) {
          const int e = g * 16 + hf * 8 + j;
          const int id = __builtin_amdgcn_readlane(g < 4 ? ia : ib, e & 63);
          rows[j] = *(const u32x4*)(ub + (size_t)id * 1024 + lane * 16);
        }
#pragma unroll
        for (int j = 0; j < 8; ++j) {
          float f[16]; fp8x16_to_f32(rows[j], f);
          float a = 0.f;
#pragma unroll
          for (int i = 0; i < 16; ++i) a += h[i] * f[i];
          part[hf * 8 + j] = a;
        }
      }
#pragma unroll
      for (int n = 8, m = 32; n >= 1; n >>= 1, m >>= 1) {
        const bool up = (lane & m) != 0;
#pragma unroll
        for (int i = 0; i < n; ++i) {
          const float keep = up ? part[i + n] : part[i];
          const float send = up ? part[i] : part[i + n];
          part[i] = keep + __shfl_xor(send, m);
        }
      }
      float a = part[0];
      a += __shfl_xor(a, 2);
      a += __shfl_xor(a, 1);
      a *= (1.f / 64.f);
      const float ge = 0.5f * a * (1.f + erff(a * 0.7071067811865476f));
      const float cj = __shfl(ge, 4 * (lane & 15));
      const float cv = cj * gate[(size_t)t * 128 + g * 16 + (lane & 15)];
      const bool mine = (lane >> 4) == (g & 3);
      if (g < 4) c_lo = mine ? cv : c_lo; else c_hi = mine ? cv : c_hi;
    }
    float o[16];
#pragma unroll
    for (int i = 0; i < 16; ++i) o[i] = 0.f;
    {
      u32x4 cur[8], nxt[8];
#pragma unroll
      for (int j = 0; j < 8; ++j) {
        const int id = __builtin_amdgcn_readlane(ia, j);
        cur[j] = *(const u32x4*)(vb + (size_t)id * 1024 + lane * 16);
      }
#pragma unroll 1
      for (int g = 0; g < 16; ++g) {
        const int gn = g + 1 < 16 ? g + 1 : g;
#pragma unroll
        for (int j = 0; j < 8; ++j) {
          const int e = gn * 8 + j;
          const int id = __builtin_amdgcn_readlane(gn < 8 ? ia : ib, e & 63);
          nxt[j] = *(const u32x4*)(vb + (size_t)id * 1024 + lane * 16);
        }
#pragma unroll
        for (int j = 0; j < 8; ++j) {
          const int e = g * 8 + j;
          const float c = __builtin_bit_cast(float, __builtin_amdgcn_readlane(__builtin_bit_cast(int, g < 8 ? c_lo : c_hi), e & 63));
          float f[16]; fp8x16_to_f32(cur[j], f);
#pragma unroll
          for (int i = 0; i < 16; ++i) o[i] += c * f[i];
        }
#pragma unroll
        for (int j = 0; j < 8; ++j) cur[j] = nxt[j];
      }
    }
    float4* xo = (float4*)(p.out + (size_t)t * 1024 + lane * 16);
#pragma unroll
    for (int q = 0; q < 4; ++q) {
      float4 a = xo[q];
      a.x += o[4 * q] * (1.f / 16.f); a.y += o[4 * q + 1] * (1.f / 16.f); a.z += o[4 * q + 2] * (1.f / 16.f); a.w += o[4 * q + 3] * (1.f / 16.f);
      xo[q] = a;
    }
  }
}

constexpr int NPH = 26;
DI void run_phase(const Params& p, int lrep, int ph, int bid, int nb, char* smem) {
  const int l = lrep & 15, rep = lrep >> 4;
#ifdef ONLY_PH
  ph = ONLY_PH;
#endif
  switch (ph) {
    case 0: phase_prep(p, l, bid, nb, smem); break;
    case 1: {
      Route rt; rt.seg0 = 6; rt.packed = 4 | (5 << 4) | (6 << 8);
      gemm_in_phase(p, l, rt, 26, 48, 26, 0, bid, nb, smem);
    } break;
    case 2: phase_lora_prep(p, l, bid, nb); break;
    case 3: phase_lora_wa(p, l, bid, nb, smem); break;
    case 4: phase_rwkv_scan(p, l, bid, nb, smem); break;
    case 5: phase_rwkv_ln(p, l, bid, nb); break;
    case 6: phase_rwkv_g(p, l, bid, nb, smem); break;
    case 7: {
      Route rt; rt.seg0 = 0; rt.packed = 1 | (2 << 4) | (4 << 8);
      gemm_in_phase(p, l, rt, 25, 0, 24, 74, bid, nb, smem);
    } break;
    case 8: phase_ssd_conv(p, l, bid, nb); break;
    case 9: phase_ssd_states(p, l, bid, nb, smem); break;
    case 10: phase_ssd_scan(p, bid, nb); break;
    case 11: phase_ssd_out(p, l, bid, nb, smem); break;
    case 12: {
      Route rt; rt.seg0 = 3; rt.packed = 2 | (4 << 4) | (5 << 8);
      gemm_in_phase(p, l, rt, 24, 24, 24, 0, bid, nb, smem);
    } break;
    case 13: phase_moba_norm(p, l, bid, nb, smem); break;
    case 14: phase_moba_gate(p, bid, nb, smem); break;
    case 15: phase_moba_fill(p, bid, nb, smem); break;
    case 16: phase_moba_own(p, bid, nb, smem); break;
    case 17: phase_moba_past(p, 0, bid, nb, smem); break;
    case 18: phase_moba_past(p, 1, bid, nb, smem); break;
    case 19: phase_moba_past(p, 2, bid, nb, smem); break;
    case 20: phase_merge(p, l, bid, nb, smem); break;
    case 21: phase_wout(p, l, bid, nb, smem); break;
    case 22: phase_peer_prep(p, l, bid, nb); break;
    case 23: phase_peer_q(p, bid, nb, smem); break;
    case 24: phase_peer_topk(p, bid, nb, smem, rep); break;
    case 25: phase_peer_gather(p, bid, nb, smem); break;
  }
}

#if !MULTI
#define XB_TMO      128
#define XB_XCNT(j)  (256  + 64 * (j))
#define XB_XSUB(j)  (1280 + 64 * (j))
#define XB_XGEN(j)  (2304 + 64 * (j))
#define XB_TOP      3328
#define XB_TOPGEN   3392
#define XCD_BAR_WORDS 3456
#define XB_SPIN_CAP (1u << 22)
#define LAS __attribute__((address_space(3)))
DI unsigned xb_ld(unsigned* p)              { return __hip_atomic_load(p, __ATOMIC_RELAXED, __HIP_MEMORY_SCOPE_AGENT); }
DI unsigned xb_add(unsigned* p, unsigned v) { return __hip_atomic_fetch_add(p, v, __ATOMIC_RELAXED, __HIP_MEMORY_SCOPE_AGENT); }
DI unsigned xb_xcc_id() { return (unsigned)__builtin_amdgcn_s_getreg((3 << 11) | 20) & 0xFu; }
#define XB_SPIN(cond, bar) do { unsigned _sp = 0; while (cond) { __builtin_amdgcn_s_sleep(1); \
    if ((++_sp & 255u) == 0u) { if (xb_ld(&(bar)[XB_TMO])) break; if (_sp > XB_SPIN_CAP) { atomicAdd(&(bar)[XB_TMO], 1u); break; } } } } while (0)
struct XcdBarrier { unsigned* bar; unsigned x; volatile LAS unsigned* st; };
DI XcdBarrier xcd_barrier_post(unsigned* bar, volatile LAS unsigned* st) {
  XcdBarrier b; b.bar = bar; b.x = xb_xcc_id(); b.st = st;
  if (__builtin_amdgcn_workitem_id_x() == 0) (void)xb_add(&bar[XB_XCNT(b.x)], 1u);
  return b;
}
DI void xcd_barrier_complete(unsigned* bar, unsigned x, unsigned& nloc, unsigned& nx) {
  const unsigned G = gridDim.x * gridDim.y * gridDim.z;
  unsigned sum, cnt, mine, sp = 0u;
  for (;;) {
    sum = 0u; cnt = 0u; mine = 0u;
#pragma unroll
    for (unsigned j = 0; j < 16; ++j) { const unsigned c = xb_ld(&bar[XB_XCNT(j)]); sum += c; cnt += (c > 0u) ? 1u : 0u; mine = (j == x) ? c : mine; }
    if (sum == G) break;
    __builtin_amdgcn_s_sleep(1);
    if ((++sp & 255u) == 0u) { if (xb_ld(&bar[XB_TMO])) break; if (sp > XB_SPIN_CAP) { atomicAdd(&bar[XB_TMO], 1u); break; } }
  }
  nloc = mine > 0u ? mine : 1u; nx = cnt > 0u ? cnt : 1u;
}
DI void xcd_barrier(const XcdBarrier& b) {
  asm volatile("s_waitcnt vmcnt(0)" ::: "memory");
  __syncthreads();
  if (__builtin_amdgcn_workitem_id_x() == 0) {
    unsigned* bar = b.bar;
    __builtin_amdgcn_s_waitcnt(0);
    unsigned nloc = b.st[0], nx = b.st[1];
    if (nloc == 0u) { xcd_barrier_complete(bar, b.x, nloc, nx); b.st[0] = nloc; b.st[1] = nx; }
    const unsigned old = xb_add(&bar[XB_XSUB(b.x)], 1u);
    const unsigned gen = old / nloc;
    if (old + 1u == (gen + 1u) * nloc) {
      __builtin_amdgcn_fence(__ATOMIC_RELEASE, "agent");
      asm volatile("s_waitcnt vmcnt(0)" ::: "memory");
      const unsigned og = xb_add(&bar[XB_TOP], 1u);
      const unsigned tg = og / nx;
      if (og + 1u == (tg + 1u) * nx) xb_add(&bar[XB_TOPGEN], 1u);
      else XB_SPIN(xb_ld(&bar[XB_TOPGEN]) == tg, bar);
      __builtin_amdgcn_fence(__ATOMIC_ACQUIRE, "agent");
      xb_add(&bar[XB_XGEN(b.x)], 1u);
      asm volatile("s_waitcnt vmcnt(0)" ::: "memory");
    } else {
      XB_SPIN(xb_ld(&bar[XB_XGEN(b.x)]) == gen, bar);
      __builtin_amdgcn_fence(__ATOMIC_ACQUIRE, "agent");
      asm volatile("s_waitcnt vmcnt(0)" ::: "memory");
    }
  }
  __syncthreads();
}
__global__ void __launch_bounds__(256, 2) mega(Params p) {
  __shared__ __attribute__((aligned(16))) char smem[LDS_BYTES];
  __shared__ uint4 xb_words;
  cg::grid_group grid = cg::this_grid();
  if (__builtin_amdgcn_workitem_id_x() == 0) xb_words = make_uint4(0u, 0u, 0u, 0u);
  __syncthreads();
  XcdBarrier xb = xcd_barrier_post((unsigned*)(p.ws + O_BAR), (volatile LAS unsigned*)&xb_words);
  for (int it = 0; it < 2 * NPH; ++it) {
    int itv = it; asm volatile("" : "+v"(itv));
    const int its = __builtin_amdgcn_readfirstlane(itv);
    const int l = its / NPH, ph = its % NPH;
    int bv = blockIdx.x, nv = gridDim.x; asm volatile("" : "+v"(bv), "+v"(nv));
    const int nrep = ((REPMASK >> ph) & 1) ? 2 : 1;
    for (int r = 0; r < nrep; ++r) {
      run_phase(p, l + 16 * r, ph, __builtin_amdgcn_readfirstlane(bv), __builtin_amdgcn_readfirstlane(nv), smem);
      if (it == 0 && r == 0) grid.sync();
      else xcd_barrier(xb);
    }
  }
}
#else
__global__ void __launch_bounds__(256, 2) phase_kernel(Params p, int l, int ph) {
  __shared__ __attribute__((aligned(16))) char smem[LDS_BYTES];
  run_phase(p, l, ph, blockIdx.x, gridDim.x, smem);
}
#endif


#if DBG
DI int dbg_tok(int i) { return i == 0 ? 3 : (i == 1 ? 130 : (i == 2 ? 300 : 16384 + 511)); }
__global__ void __launch_bounds__(256) dbgA_kernel(Params p) {
  const int tid = tidx();
  for (size_t i = (size_t)blockIdx.x * 256 + tid; i < (size_t)T_ * 1024; i += (size_t)gridDim.x * 256) p.out[i] = p.in[I_X][i];
  if (blockIdx.x < 4) {
    const int t = dbg_tok(blockIdx.x);
    bf16_t* d = (bf16_t*)(p.ws + O_LISTS);
    for (int c = tid; c < 1024; c += 256) d[blockIdx.x * 1024 + c] = slab(p, 1)[(size_t)t * 1024 + c];
  }
}
__global__ void __launch_bounds__(256) dbgB_kernel(Params p, int l) {
  __shared__ float sred[256];
  const int tid = tidx();
  const int ti = blockIdx.x >> 2, g = blockIdx.x & 3;
  const int t = dbg_tok(ti), b = t >> 14, ts = t & (S_ - 1);
  const bf16_t* xs = slab(p, 5) + (size_t)b * S_ * 1024; const bf16_t* bc = slab(p, 6) + (size_t)b * S_ * 1024;
  const float* dt = (const float*)(p.ws + O_DT) + (size_t)b * S_ * 16;
  const bf16_t* zsave = (const bf16_t*)(p.ws + O_LISTS);
  const int ch = g * 256 + tid, head = ch >> 6;
  const float a = -__expf(p.in[I_ALOG][l * 16 + head]);
  float y = 0.f;
  for (int n = 0; n < (SSD_PROBE == 1 ? 0 : 128); ++n) {
    float h = 0.f;
    for (int s = 0; s <= ts; ++s) {
      const float d = dt[(size_t)s * 16 + head];
      h = h * __expf(d * a) + d * bf2f(bc[(size_t)s * 1024 + g * 128 + n]) * bf2f(xs[(size_t)s * 1024 + ch]);
    }
    y += bf2f(bc[(size_t)ts * 1024 + 512 + g * 128 + n]) * h;
  }
  y += p.in[I_DSKIP][l * 16 + head] * bf2f(xs[(size_t)ts * 1024 + ch]);
  y *= siluf_(bf2f(zsave[ti * 1024 + ch]));
  sred[tid] = y * y;
  __syncthreads();
  for (int o = 128; o > 0; o >>= 1) { if (tid < o) sred[tid] += sred[tid + o]; __syncthreads(); }
  const float rs = rsqrtf(sred[0] * (1.f / 256.f) + 1e-6f);
  __syncthreads();
  const float ref = DBG == 2 ? y : y * rs * p.in[I_SSDNG][l * 1024 + ch];
  const float mine = bf2f(slab(p, 1)[(size_t)t * 1024 + ch]);
  sred[tid] = fabsf(mine - ref);
  __syncthreads();
  for (int o = 128; o > 0; o >>= 1) { if (tid < o) sred[tid] = fmaxf(sred[tid], sred[tid + o]); __syncthreads(); }
  if (tid == 0) p.out[blockIdx.x] = 1000.f * sred[0] + 100.f;
}
#endif

#if DBG
__global__ void __launch_bounds__(256) dbgS_kernel(Params p, int l) {
  for (size_t i = (size_t)blockIdx.x * 256 + tidx(); i < (size_t)T_ * 1024; i += (size_t)gridDim.x * 256) {
    const int ch = (int)(i & 1023), head = ch >> 6;
    const float xv = bf2f(slab(p, 5)[i]);
    const float zv = bf2f(slab(p, 1)[i]);
    slab(p, 1)[i] = f2bf(xv * p.in[I_DSKIP][l * 16 + head] * siluf_(zv));
  }
}
#endif

extern "C" void kernel_launch(void* const* d_in, const int* in_sizes, int n_in, void* d_out, int out_size, void* d_ws, size_t ws_size,
                              hipStream_t stream) {
  Params p{};
  for (int i = 0; i < 35; ++i) p.in[i] = (const float*)d_in[i];
  p.out = (float*)d_out;
  p.ws = (char*)d_ws;
  if (ws_size < WS_END) { fprintf(stderr, "workspace too small\n"); return; }
#if MULTI
#if DBG
  for (int ph = 0; ph < 11; ++ph) hipLaunchKernelGGL(phase_kernel, dim3(512), dim3(256), 0, stream, p, 0, ph);
  hipLaunchKernelGGL(dbgA_kernel, dim3(512), dim3(256), 0, stream, p);
  hipLaunchKernelGGL(dbgS_kernel, dim3(512), dim3(256), 0, stream, p, 0);
  hipLaunchKernelGGL(dbgB_kernel, dim3(16), dim3(256), 0, stream, p, 0);
#else
  for (int l = 0; l < NLAYERS; ++l)
    for (int ph = 0; ph < (SKIP_PEER ? 22 : NPH); ++ph) hipLaunchKernelGGL(phase_kernel, dim3(512), dim3(256), 0, stream, p, l, ph);
#endif
#else
  static int grid_blocks = 0;
  if (!grid_blocks) {
    int dev = 0, cus = 0, per_cu = 0;
    (void)hipGetDevice(&dev);
    (void)hipDeviceGetAttribute(&cus, hipDeviceAttributeMultiprocessorCount, dev);
    (void)hipOccupancyMaxActiveBlocksPerMultiprocessor(&per_cu, mega, 256, 0);
    if (per_cu > 2) per_cu = 2;
    grid_blocks = cus * per_cu;
  }
  (void)hipMemsetAsync(p.ws + O_BAR, 0, 16384, stream);
  void* args[] = {&p};
  hipError_t e = hipLaunchCooperativeKernel((void*)mega, dim3(grid_blocks), dim3(256), args, 0, stream);
  if (e != hipSuccess) fprintf(stderr, "coop launch failed: %s (grid %d)\n", hipGetErrorString(e), grid_blocks);
#endif
}
```
